# Optimizing an MI355X kernel written in HIP

```python
import math
import jax, jax.numpy as jnp
from jax import lax
import numpy as np

D_MODEL = 1024
BATCH = 8
SEQ = 2048
DEPTH = 1
DEC_BATCH = 32
DEC_SEQ = 1
PAST_LEN = 16384
PAGE_SIZE = 128

PLE_DIM = 256
HEAD_DIM = 64
NSA_HEADS = 8
NSA_KV_GROUPS = 2
NSA_REP = NSA_HEADS // NSA_KV_GROUPS
NSA_WIDTH = NSA_HEADS * HEAD_DIM
NSA_KV_WIDTH = NSA_KV_GROUPS * HEAD_DIM
CMP_BLOCK = 32
CMP_STRIDE = 16
CMP_SEGS = CMP_BLOCK // CMP_STRIDE
CMP_HIDDEN = 2 * HEAD_DIM
SLC_BLOCK = 64
SLC_RATIO = SLC_BLOCK // CMP_STRIDE
SLC_TOPN = 16
WINDOW = 512
Q_BLOCK = 64
RET_HEADS = 4
RET_HEAD_DIM = 128
RET_WIDTH = RET_HEADS * RET_HEAD_DIM
RET_CHUNK = 128
ROPE_BASE = 10000.0
NUM_BUCKETS = 32
MAX_DISTANCE = 128
D_FF = ((8 * D_MODEL + 3 * 256 - 1) // (3 * 256)) * 256
SPLIT_SIZES = (NSA_WIDTH,) + (NSA_KV_WIDTH,) * 6 + (3 * NSA_HEADS,) + (RET_WIDTH,) * 4
SPLIT_CUTS = tuple(int(c) for c in np.cumsum(SPLIT_SIZES)[:-1])
IN_COLS = sum(SPLIT_SIZES)
EPS = 1e-6
NEG = -1e30
FORCE_SCORE = 1e4

kernel_name = 'hybrid_nsa_retention_decode_step'


def rms_norm(x, w):
    xf = x.astype(jnp.float32)
    y = xf * lax.rsqrt(jnp.mean(xf * xf, axis=-1, keepdims=True) + EPS)
    return (y * w.astype(jnp.float32)).astype(x.dtype)


def rel_bucket(dist):
    n = jnp.maximum(dist, 0)
    exact = NUM_BUCKETS // 2
    nf = jnp.maximum(n, exact).astype(jnp.float32)
    large = exact + (jnp.log(nf / exact) / math.log(MAX_DISTANCE / exact) * (NUM_BUCKETS - exact)).astype(jnp.int32)
    return jnp.where(n < exact, n, jnp.minimum(large, NUM_BUCKETS - 1))


def rotary(x, pos):
    half = x.shape[-1] // 2
    inv = ROPE_BASE ** (-jnp.arange(half, dtype=jnp.float32) / half)
    ang = pos.astype(jnp.float32)[:, None] * inv[None, :]
    cos, sin = jnp.cos(ang)[:, None, :], jnp.sin(ang)[:, None, :]
    xf = x.astype(jnp.float32)
    x1, x2 = xf[..., :half], xf[..., half:]
    return jnp.concatenate([x1 * cos - x2 * sin, x1 * sin + x2 * cos], axis=-1)


def ret_log_gamma():
    return jnp.log1p(-jnp.exp2(-5.0 - jnp.arange(RET_HEADS, dtype=jnp.float32)))


def retention_chunk(state, qc, kc, vc):
    C = qc.shape[1]
    lg = ret_log_gamma()
    n = jnp.arange(C)
    diff = n[:, None] - n[None, :]
    decay = jnp.where(diff >= 0, jnp.exp(jnp.maximum(diff, 0)[None] * lg[:, None, None]), 0.0)
    att = jnp.einsum('bnhd,bmhd->bhnm', qc, kc) * decay
    o = jnp.einsum('bhnm,bmhe->bnhe', att, vc)
    o = o + jnp.einsum('bnhd,bhde->bnhe', qc, state) * jnp.exp((n[:, None] + 1) * lg[None, :])[None, :, :, None]
    k_dec = kc * jnp.exp((C - 1 - n)[:, None] * lg[None, :])[None, :, :, None]
    new_state = jnp.exp(C * lg)[None, :, None, None] * state + jnp.einsum('bmhd,bmhe->bhde', k_dec, vc)
    return o, new_state


def ret_output(o, g, gn_w):
    B, T = o.shape[:2]
    mu = jnp.mean(o, axis=-1, keepdims=True)
    var = jnp.mean(jnp.square(o - mu), axis=-1, keepdims=True)
    on = ((o - mu) * lax.rsqrt(var + EPS)).reshape(B, T, RET_WIDTH) * gn_w.astype(jnp.float32)
    return (jax.nn.silu(g.astype(jnp.float32)) * on).astype(g.dtype)


def compress(k, pe, w1, w2):
    B, T, G, D = k.shape
    nc = (T - CMP_BLOCK) // CMP_STRIDE + 1
    nseg = nc + CMP_SEGS - 1
    seg = k[:, :nseg * CMP_STRIDE].reshape(B, nseg, CMP_STRIDE, G, D)
    w1r = w1.reshape(CMP_SEGS, CMP_STRIDE, D, CMP_HIDDEN)
    hid = pe.reshape(-1) @ w1
    for j in range(CMP_SEGS):
        hid = hid + jnp.einsum('bnsgd,sdh->bngh', seg[:, j:j + nc], w1r[j])
    return jax.nn.silu(hid) @ w2


def to_blocks(k):
    B, T, G, D = k.shape
    nsb = -(-T // SLC_BLOCK)
    k = jnp.pad(k, ((0, 0), (0, nsb * SLC_BLOCK - T), (0, 0), (0, 0)))
    return k.reshape(B, nsb, SLC_BLOCK, G, D).transpose(0, 3, 1, 2, 4)


def nsa_attend(q, q_pos, kc, vc, kb, vb, kw, vw, kw_pos, gates, rel_bias):
    B, Q = q.shape[:2]
    G, R = NSA_KV_GROUPS, NSA_REP
    f32 = jnp.float32
    nc = kc.shape[1]
    c_end = jnp.arange(nc) * CMP_STRIDE + (CMP_BLOCK - 1)
    dist_c = q_pos[:, None] - c_end[None, :]
    valid_c = dist_c >= 0
    bias_c = rel_bias[rel_bucket(dist_c)].reshape(Q, nc, G, R).transpose(2, 3, 0, 1).astype(f32)
    s_c = jnp.einsum('bqgrd,bcgd->bgrqc', q, kc).astype(f32) + bias_c
    p_c = jax.nn.softmax(jnp.where(valid_c, s_c, NEG), axis=-1) * valid_c
    o_c = jnp.einsum('bgrqc,bcgd->bqgrd', p_c.astype(vc.dtype), vc)
    nsb = kb.shape[2]
    imp = jnp.pad(p_c.sum(axis=2), ((0, 0), (0, 0), (0, 0), (1, SLC_RATIO * (nsb + 1) - 1 - nc)))
    row_w = jnp.array([0.5] + [1.0] * (SLC_RATIO - 1), f32)
    imp_s = (imp[..., :SLC_RATIO * nsb].reshape(B, G, Q, nsb, SLC_RATIO) @ row_w
             + 0.5 * imp[..., SLC_RATIO::SLC_RATIO][..., :nsb])
    blk = jnp.arange(nsb)[None, :]
    q_blk = (q_pos // SLC_BLOCK)[:, None]
    valid_b = blk <= q_blk
    forced = (blk == 0) | (blk == q_blk) | (blk == q_blk - 1)
    score = jnp.where(valid_b, jnp.where(forced, FORCE_SCORE, imp_s), -1.0)
    n_top = min(SLC_TOPN, nsb)
    _, idx = lax.top_k(score, n_top)
    bi = jnp.arange(B)[:, None, None, None]
    gi = jnp.arange(G)[None, :, None, None]
    k_sel = kb[bi, gi, idx].reshape(B, G, Q, n_top * SLC_BLOCK, HEAD_DIM)
    v_sel = vb[bi, gi, idx].reshape(B, G, Q, n_top * SLC_BLOCK, HEAD_DIM)
    k_pos = (idx[..., None] * SLC_BLOCK + jnp.arange(SLC_BLOCK)).reshape(B, G, Q, n_top * SLC_BLOCK)
    dist_s = q_pos[:, None] - k_pos
    valid_s = dist_s >= 0
    tb = rel_bias.reshape(NUM_BUCKETS, G, R).transpose(1, 0, 2)
    bias_s = jnp.moveaxis(tb[gi, rel_bucket(dist_s)], -1, 2).astype(f32)
    s_s = jnp.einsum('bqgrd,bgqkd->bgrqk', q, k_sel).astype(f32) + bias_s
    p_s = jax.nn.softmax(jnp.where(valid_s[:, :, None], s_s, NEG), axis=-1)
    o_s = jnp.einsum('bgrqk,bgqkd->bqgrd', p_s.astype(v_sel.dtype), v_sel)
    L = kw.shape[1]
    dist_w = q_pos[:, None] - kw_pos[None, :]
    valid_w = (dist_w >= 0) & (dist_w < WINDOW) & (kw_pos >= 0)[None, :]
    bias_w = rel_bias[rel_bucket(dist_w)].reshape(Q, L, G, R).transpose(2, 3, 0, 1).astype(f32)
    s_w = jnp.einsum('bqgrd,blgd->bgrql', q, kw).astype(f32) + bias_w
    p_w = jax.nn.softmax(jnp.where(valid_w, s_w, NEG), axis=-1)
    o_w = jnp.einsum('bgrql,blgd->bqgrd', p_w.astype(vw.dtype), vw)
    g = jax.nn.sigmoid(gates)
    o = g[..., 0:1] * o_c + g[..., 1:2] * o_s + g[..., 2:3] * o_w
    return o.reshape(B, Q, NSA_WIDTH)


def mixer_inputs(x, n1, w_in, qn, kn, pos):
    B, T, _ = x.shape
    proj = rms_norm(x, n1) @ w_in
    q, kc, vc, ks, vs, kw, vw, gt, rq, rk, rv, rg = jnp.split(proj, SPLIT_CUTS, axis=-1)
    kvs = (B, T, NSA_KV_GROUPS, HEAD_DIM)
    q = rms_norm(q.reshape(B, T, NSA_KV_GROUPS, NSA_REP, HEAD_DIM), qn) * HEAD_DIM ** -0.5
    ks = rms_norm(ks.reshape(kvs), kn)
    kw = rms_norm(kw.reshape(kvs), kn)
    gt = jnp.moveaxis(gt.reshape(B, T, 3, NSA_KV_GROUPS, NSA_REP), 2, -1)
    rs = (B, T, RET_HEADS, RET_HEAD_DIM)
    rq = rotary(rq.reshape(rs), pos)
    rk = rotary(rk.reshape(rs), pos) * RET_HEAD_DIM ** -0.5
    rv = rv.reshape(rs).astype(jnp.float32)
    return (q, kc.reshape(kvs), vc.reshape(kvs), ks, vs.reshape(kvs), kw, vw.reshape(kvs), gt, rq, rk, rv, rg)


def layer_finish(x, nsa, ret, w_out, n2, wg, wu, wd, p, wpg, wpp):
    h = x + jnp.concatenate([nsa, ret.astype(nsa.dtype)], axis=-1) @ w_out
    hn = rms_norm(h, n2)
    h = h + (jax.nn.silu(hn @ wg) * (hn @ wu)) @ wd
    return h + jax.nn.sigmoid(h @ wpg) * (p @ wpp)


def layer_prompt(x, p, lw, rel_bias):
    (n1, w_in, qn, kn, pe_k, w1_k, w2_k, pe_v, w1_v, w2_v, gn_w, w_out, n2, wg, wu, wd, wpg, wpp) = lw
    B, S, _ = x.shape
    pos = jnp.arange(S)
    q, kc, vc, ks, vs, kw, vw, gt, rq, rk, rv, rg = mixer_inputs(x, n1, w_in, qn, kn, pos)
    ckc = rms_norm(compress(kc, pe_k, w1_k, w2_k), kn)
    cvc = compress(vc, pe_v, w1_v, w2_v)
    kb, vb = to_blocks(ks), to_blocks(vs)
    pad_w = ((0, 0), (WINDOW, 0), (0, 0), (0, 0))
    kw_pad, vw_pad = jnp.pad(kw, pad_w), jnp.pad(vw, pad_w)

    def q_block(i):
        s0 = i * Q_BLOCK
        qb = lax.dynamic_slice_in_dim(q, s0, Q_BLOCK, axis=1)
        gb = lax.dynamic_slice_in_dim(gt, s0, Q_BLOCK, axis=1)
        kwb = lax.dynamic_slice_in_dim(kw_pad, s0, WINDOW + Q_BLOCK, axis=1)
        vwb = lax.dynamic_slice_in_dim(vw_pad, s0, WINDOW + Q_BLOCK, axis=1)
        q_pos = s0 + jnp.arange(Q_BLOCK)
        kw_pos = s0 - WINDOW + jnp.arange(WINDOW + Q_BLOCK)
        return nsa_attend(qb, q_pos, ckc, cvc, kb, vb, kwb, vwb, kw_pos, gb, rel_bias)

    nsa = lax.map(q_block, jnp.arange(S // Q_BLOCK))
    nsa = jnp.moveaxis(nsa, 0, 1).reshape(B, S, NSA_WIDTH)
    nch = S // RET_CHUNK

    def chunks(a):
        return jnp.moveaxis(a.reshape(B, nch, RET_CHUNK, RET_HEADS, RET_HEAD_DIM), 1, 0)

    def step(st, inp):
        o, st = retention_chunk(st, *inp)
        return st, o

    st0 = jnp.zeros((B, RET_HEADS, RET_HEAD_DIM, RET_HEAD_DIM), jnp.float32)
    st_fin, o = lax.scan(step, st0, (chunks(rq), chunks(rk), chunks(rv)))
    o = jnp.moveaxis(o, 0, 1).reshape(B, S, RET_HEADS, RET_HEAD_DIM)
    ret = ret_output(o, rg, gn_w)
    y = layer_finish(x, nsa, ret, w_out, n2, wg, wu, wd, p, wpg, wpp)
    w = min(WINDOW, S)
    return y, (kc, vc, ks, vs, kw[:, S - w:], vw[:, S - w:], st_fin.astype(x.dtype))


def layer_sample(x, p, caches, page_table, lw, rel_bias):
    (n1, w_in, qn, kn, pe_k, w1_k, w2_k, pe_v, w1_v, w2_v, gn_w, w_out, n2, wg, wu, wd, wpg, wpp) = lw
    c_ck, c_cv, c_sk, c_sv, c_wk, c_wv, st = caches
    B, T, _ = x.shape
    n_past = page_table.shape[1] * c_ck.shape[1]
    pos = n_past + jnp.arange(T)
    q, kc, vc, ks, vs, kw, vw, gt, rq, rk, rv, rg = mixer_inputs(x, n1, w_in, qn, kn, pos)

    def past(c, new):
        rows = c[page_table].reshape(B, n_past, NSA_KV_GROUPS, HEAD_DIM)
        return jnp.concatenate([rows, new.astype(rows.dtype)], axis=1)

    ckc = rms_norm(compress(past(c_ck, kc), pe_k, w1_k, w2_k), kn)
    cvc = compress(past(c_cv, vc), pe_v, w1_v, w2_v)
    kb, vb = to_blocks(past(c_sk, ks)), to_blocks(past(c_sv, vs))
    kw_all = jnp.concatenate([c_wk, kw.astype(c_wk.dtype)], axis=1)
    vw_all = jnp.concatenate([c_wv, vw.astype(c_wv.dtype)], axis=1)
    wbuf = c_wk.shape[1]
    kw_pos = n_past - wbuf + jnp.arange(wbuf + T)
    nsa = nsa_attend(q, pos, ckc, cvc, kb, vb, kw_all, vw_all, kw_pos, gt, rel_bias)
    o, st_new = retention_chunk(st.astype(jnp.float32), rq, rk, rv)
    ret = ret_output(o, rg, gn_w)
    y = layer_finish(x, nsa, ret, w_out, n2, wg, wu, wd, p, wpg, wpp)
    return y, (kc, vc, ks, vs, kw_all[:, T:], vw_all[:, T:], st_new.astype(st.dtype))


def setup_inputs(seed: int = 0) -> dict:
    key = jax.random.key(seed)
    ks = jax.random.split(key, 32)
    n_pages = PAST_LEN // PAGE_SIZE
    n_pool = (5 * DEC_BATCH * n_pages + 3) // 4
    w_buf = min(WINDOW, PAST_LEN)

    def nrm(i, shape, scale=1.0):
        return scale * jax.random.normal(ks[i], shape, jnp.float32)

    def gain(i, shape):
        return 1.0 + nrm(i, shape, 0.02)

    pool = (DEPTH, n_pool, PAGE_SIZE, NSA_KV_GROUPS, HEAD_DIM)
    win = (DEPTH, DEC_BATCH, w_buf, NSA_KV_GROUPS, HEAD_DIM)
    page_table = jax.random.permutation(ks[0], n_pool)[:DEC_BATCH * n_pages].reshape(DEC_BATCH, n_pages).astype(jnp.int32)
    cmp_in = CMP_BLOCK * HEAD_DIM
    return {
        'x_prompt': nrm(1, (BATCH, SEQ, D_MODEL)),
        'x_sample': nrm(2, (DEC_BATCH, DEC_SEQ, D_MODEL)),
        'cache_cmp_k': nrm(3, pool),
        'cache_cmp_v': nrm(4, pool),
        'cache_slc_k': nrm(5, pool),
        'cache_slc_v': nrm(6, pool),
        'cache_win_k': nrm(7, win),
        'cache_win_v': nrm(8, win),
        'state_ret': nrm(9, (DEPTH, DEC_BATCH, RET_HEADS, RET_HEAD_DIM, RET_HEAD_DIM), 0.3),
        'page_table': page_table,
        'p_prompt': nrm(10, (DEPTH, BATCH, SEQ, PLE_DIM)),
        'p_sample': nrm(11, (DEPTH, DEC_BATCH, DEC_SEQ, PLE_DIM)),
        'norm1_w': gain(12, (DEPTH, D_MODEL)),
        'w_in': nrm(13, (DEPTH, D_MODEL, IN_COLS), D_MODEL ** -0.5),
        'q_norm_w': gain(14, (DEPTH, HEAD_DIM)),
        'k_norm_w': gain(15, (DEPTH, HEAD_DIM)),
        'cmp_pe_k': nrm(16, (DEPTH, CMP_BLOCK, HEAD_DIM), 0.1),
        'cmp_w1_k': nrm(17, (DEPTH, cmp_in, CMP_HIDDEN), cmp_in ** -0.5),
        'cmp_w2_k': nrm(18, (DEPTH, CMP_HIDDEN, HEAD_DIM), CMP_HIDDEN ** -0.5),
        'cmp_pe_v': nrm(19, (DEPTH, CMP_BLOCK, HEAD_DIM), 0.1),
        'cmp_w1_v': nrm(20, (DEPTH, cmp_in, CMP_HIDDEN), cmp_in ** -0.5),
        'cmp_w2_v': nrm(21, (DEPTH, CMP_HIDDEN, HEAD_DIM), CMP_HIDDEN ** -0.5),
        'ret_gn_w': gain(22, (DEPTH, RET_WIDTH)),
        'w_out': nrm(23, (DEPTH, D_MODEL, D_MODEL), D_MODEL ** -0.5),
        'norm2_w': gain(24, (DEPTH, D_MODEL)),
        'w_gate': nrm(25, (DEPTH, D_MODEL, D_FF), D_MODEL ** -0.5),
        'w_up': nrm(26, (DEPTH, D_MODEL, D_FF), D_MODEL ** -0.5),
        'w_down': nrm(27, (DEPTH, D_FF, D_MODEL), D_FF ** -0.5),
        'w_ple_gate': nrm(28, (DEPTH, D_MODEL, D_MODEL), D_MODEL ** -0.5),
        'w_ple_proj': nrm(29, (DEPTH, PLE_DIM, D_MODEL), PLE_DIM ** -0.5),
        'rel_bias': nrm(30, (NUM_BUCKETS, NSA_HEADS), 0.5),
    }


def reference(x_prompt, x_sample, cache_cmp_k, cache_cmp_v, cache_slc_k, cache_slc_v,
              cache_win_k, cache_win_v, state_ret, page_table, p_prompt, p_sample,
              norm1_w, w_in, q_norm_w, k_norm_w, cmp_pe_k, cmp_w1_k, cmp_w2_k,
              cmp_pe_v, cmp_w1_v, cmp_w2_v, ret_gn_w, w_out, norm2_w, w_gate, w_up, w_down,
              w_ple_gate, w_ple_proj, rel_bias):
    h_p, h_s = x_prompt, x_sample
    new_p, new_s = [], []
    for i in range(DEPTH):
        lw = (norm1_w[i], w_in[i], q_norm_w[i], k_norm_w[i], cmp_pe_k[i], cmp_w1_k[i], cmp_w2_k[i],
              cmp_pe_v[i], cmp_w1_v[i], cmp_w2_v[i], ret_gn_w[i], w_out[i], norm2_w[i],
              w_gate[i], w_up[i], w_down[i], w_ple_gate[i], w_ple_proj[i])
        h_p, st_p = layer_prompt(h_p, p_prompt[i], lw, rel_bias)
        caches = (cache_cmp_k[i], cache_cmp_v[i], cache_slc_k[i], cache_slc_v[i],
                  cache_win_k[i], cache_win_v[i], state_ret[i])
        h_s, st_s = layer_sample(h_s, p_sample[i], caches, page_table, lw, rel_bias)
        new_p.append(st_p)
        new_s.append(st_s)
    p_cmp_k, p_cmp_v, p_slc_k, p_slc_v, p_win_k, p_win_v, p_ret = [jnp.stack(a) for a in zip(*new_p)]
    s_cmp_k, s_cmp_v, s_slc_k, s_slc_v, s_win_k, s_win_v, s_ret = [jnp.stack(a) for a in zip(*new_s)]
    return (h_p, h_s, p_cmp_k, p_cmp_v, p_slc_k, p_slc_v, p_win_k, p_win_v, p_ret,
            s_cmp_k, s_cmp_v, s_slc_k, s_slc_v, s_win_k, s_win_v, s_ret)
```

```cpp
#include <hip/hip_runtime.h>
#include <cstdio>
#include <cstdint>
#include <cstring>

#ifndef MK_PER_PHASE_LAUNCH
#define MK_PER_PHASE_LAUNCH 0
#endif

constexpr int DM = 1024, NB = 8, SEQ = 2048, DB = 32, PAST = 16384, PAGE = 128, NPAGES = 128;
constexpr int MP = NB * SEQ;
constexpr int MV = MP + DB;
constexpr int MR = 16640;
constexpr int INC = 3352, N1 = 3584, DFF = 2816, NGU = 5632, PLE = 256;
constexpr int NSEG_S = 1024, NSEG_P = 128;
constexpr int CROWS_S = DB * NSEG_S * 2;
constexpr int CROWS_P = NB * NSEG_P * 2;
constexpr int CROWS = CROWS_S + CROWS_P;
constexpr int NC_P = 127, NC_S = 1023;
constexpr float EPS = 1e-6f;
constexpr float LOG2E = 1.4426950408889634f;

constexpr size_t O_YP = 0, O_YS = O_YP + (size_t)MP * DM, O_PCK = O_YS + (size_t)DB * DM, O_PCV = O_PCK + (size_t)MP * 128, O_PSK = O_PCV + (size_t)MP * 128,
                 O_PSV = O_PSK + (size_t)MP * 128, O_PWK = O_PSV + (size_t)MP * 128, O_PWV = O_PWK + (size_t)NB * 512 * 128, O_PRET = O_PWV + (size_t)NB * 512 * 128,
                 O_SCK = O_PRET + (size_t)NB * 4 * 128 * 128, O_SCV = O_SCK + DB * 128, O_SSK = O_SCV + DB * 128, O_SSV = O_SSK + DB * 128, O_SWK = O_SSV + DB * 128,
                 O_SWV = O_SWK + (size_t)DB * 512 * 128, O_SRET = O_SWV + (size_t)DB * 512 * 128, O_END = O_SRET + (size_t)DB * 4 * 128 * 128;

constexpr size_t al256(size_t x) { return (x + 255) & ~(size_t)255; }
constexpr size_t WS_CTL = 0, CTL_BYTES = 16384;
constexpr size_t WS_W1 = WS_CTL + CTL_BYTES;
constexpr size_t WS_WO = WS_W1 + (size_t)N1 * DM * 2;
constexpr size_t WS_WGU = WS_WO + (size_t)DM * DM * 2;
constexpr size_t WS_WD = WS_WGU + (size_t)NGU * DM * 2;
constexpr size_t WS_WPG = WS_WD + (size_t)DM * DFF * 2;
constexpr size_t WS_WPP = WS_WPG + (size_t)DM * DM * 2;
constexpr size_t WS_W1C = WS_WPP + (size_t)DM * PLE * 2;
constexpr size_t WS_W2C = WS_W1C + (size_t)2 * 256 * 1024 * 2;
constexpr size_t WS_BIASC = WS_W2C + (size_t)2 * 64 * 128 * 2;
constexpr size_t WS_BTAB = WS_BIASC + 1024;
constexpr size_t WS_ROT = WS_BTAB + 4096;
constexpr size_t WS_SS1 = al256(WS_ROT + (size_t)2049 * 64 * 8);
constexpr size_t WS_SS2 = WS_SS1 + (size_t)MR * 4;
constexpr size_t WS_XB = al256(WS_SS2 + (size_t)MR * 4);
constexpr size_t WS_PB = WS_XB + (size_t)MR * DM * 2;
constexpr size_t WS_Q = WS_PB + (size_t)MR * PLE * 2;
constexpr size_t WS_KS = WS_Q + (size_t)MR * 512 * 2;
constexpr size_t WS_VS = WS_KS + (size_t)MR * 128 * 2;
constexpr size_t WS_KW = WS_VS + (size_t)MR * 128 * 2;
constexpr size_t WS_VW = WS_KW + (size_t)MR * 128 * 2;
constexpr size_t WS_RQ = WS_VW + (size_t)MR * 128 * 2;
constexpr size_t WS_RK = WS_RQ + (size_t)MR * 512 * 2;
constexpr size_t WS_RV = WS_RK + (size_t)MR * 512 * 2;
constexpr size_t WS_RG = WS_RV + (size_t)MR * 512 * 2;
constexpr size_t WS_GATE = WS_RG + (size_t)MR * 512 * 2;
constexpr size_t WS_CA = al256(WS_GATE + (size_t)MR * 24 * 4);
constexpr size_t WS_CP = WS_CA + (size_t)2 * CROWS * 1024 * 2;
constexpr size_t WS_CKCP = WS_CP + (size_t)2 * CROWS * 256 * 4;
constexpr size_t WS_CVCP = WS_CKCP + (size_t)NB * 128 * 128 * 2;
constexpr size_t WS_CKCS = WS_CVCP + (size_t)NB * 128 * 128 * 2;
constexpr size_t WS_CVCS = WS_CKCS + (size_t)DB * 1024 * 128 * 2;
constexpr size_t WS_KVT = WS_CVCS + (size_t)DB * 1024 * 128 * 2;
constexpr size_t WS_AO = WS_KVT + (size_t)NB * 4 * 16 * 16384 * 4;
constexpr size_t WS_H = WS_AO + (size_t)MR * DM * 2;
constexpr size_t WS_HB = WS_H + (size_t)MR * DM * 4;
constexpr size_t WS_ACT = WS_HB + (size_t)MR * DM * 2;
constexpr size_t WS_H2 = WS_ACT + (size_t)MR * DFF * 2;
constexpr size_t WS_H2B = WS_H2 + (size_t)MR * DM * 4;
constexpr size_t WS_VP = WS_H2B + (size_t)MR * DM * 2;
constexpr size_t WS_END = WS_VP + (size_t)MR * DM * 4;

typedef unsigned short bf16_t;
typedef short bf16x8 __attribute__((ext_vector_type(8)));
typedef short s16x4 __attribute__((ext_vector_type(4)));
typedef float f32x4 __attribute__((ext_vector_type(4)));
typedef float f32x16 __attribute__((ext_vector_type(16)));
typedef unsigned u32x4 __attribute__((ext_vector_type(4)));
typedef unsigned u32x2 __attribute__((ext_vector_type(2)));
typedef float f32x2_t __attribute__((ext_vector_type(2)));
typedef __bf16 bf16x2_t __attribute__((ext_vector_type(2)));
#define LAS __attribute__((address_space(3)))

__device__ __forceinline__ unsigned pk2(float lo, float hi) { f32x2_t v = {lo, hi}; bf16x2_t b = __builtin_convertvector(v, bf16x2_t); return __builtin_bit_cast(unsigned, b); }
__device__ __forceinline__ float bflo(unsigned w) { return __uint_as_float(w << 16); }
__device__ __forceinline__ float bfhi(unsigned w) { return __uint_as_float(w & 0xffff0000u); }
__device__ __forceinline__ float bf1(bf16_t b) { return __uint_as_float(((unsigned)b) << 16); }
__device__ __forceinline__ float sigmoidf_(float x) { return 1.f / (1.f + __expf(-x)); }
__device__ __forceinline__ float siluf_(float x) { return x / (1.f + __expf(-x)); }
__device__ __forceinline__ int crow(int r, int hi) { return (r & 3) + 8 * (r >> 2) + 4 * hi; }
__device__ __forceinline__ float xhalf_max(float v) { auto rr = __builtin_amdgcn_permlane32_swap(__float_as_uint(v), __float_as_uint(v), false, false); return fmaxf(__uint_as_float(rr[0]), __uint_as_float(rr[1])); }
__device__ __forceinline__ float xhalf_sum(float v) { auto rr = __builtin_amdgcn_permlane32_swap(__float_as_uint(v), __float_as_uint(v), false, false); return __uint_as_float(rr[0]) + __uint_as_float(rr[1]); }

struct Params {
    const float* in[31];
    const int* page_table;
    float* out;
    unsigned char* ws;
    int ph_lo, ph_hi;
};

#define XB_TMO      128
#define XB_XCNT(j)  (256  + 64 * (j))
#define XB_XSUB(j)  (1280 + 64 * (j))
#define XB_XGEN(j)  (2304 + 64 * (j))
#define XB_TOP      3328
#define XB_TOPGEN   3392
#define XCD_BAR_WORDS 3456
#define XB_SPIN_CAP (1u << 18)
__device__ __forceinline__ unsigned xb_ld(unsigned* p)              { return __hip_atomic_load(p, __ATOMIC_RELAXED, __HIP_MEMORY_SCOPE_AGENT); }
__device__ __forceinline__ unsigned xb_add(unsigned* p, unsigned v) { return __hip_atomic_fetch_add(p, v, __ATOMIC_RELAXED, __HIP_MEMORY_SCOPE_AGENT); }
__device__ __forceinline__ unsigned xb_xcc_id() { return (unsigned)__builtin_amdgcn_s_getreg((3 << 11) | 20) & 0xFu; }
#define XB_SPIN(cond, bar) do { unsigned _sp = 0; while (cond) { __builtin_amdgcn_s_sleep(1); \
    if ((++_sp & 255u) == 0u) { if (xb_ld(&(bar)[XB_TMO])) break; if (_sp > XB_SPIN_CAP) { atomicAdd(&(bar)[XB_TMO], 1u); break; } } } } while (0)
struct XcdBarrier { unsigned* bar; unsigned x; volatile LAS unsigned* st; };
__device__ __forceinline__ XcdBarrier xcd_barrier_post(unsigned* bar, volatile LAS unsigned* st) {
    XcdBarrier b; b.bar = bar; b.x = xb_xcc_id(); b.st = st;
    if (threadIdx.x == 0) (void)xb_add(&bar[XB_XCNT(b.x)], 1u);
    return b;
}
__device__ __forceinline__ void xcd_barrier_complete(unsigned* bar, unsigned x, unsigned& nloc, unsigned& nx) {
    const unsigned G = gridDim.x * gridDim.y * gridDim.z;
    unsigned sum, cnt, mine, sp = 0u;
    for (;;) {
        sum = 0u; cnt = 0u; mine = 0u;
#pragma unroll
        for (unsigned j = 0; j < 16; ++j) { const unsigned c = xb_ld(&bar[XB_XCNT(j)]); sum += c; cnt += (c > 0u) ? 1u : 0u; mine = (j == x) ? c : mine; }
        if (sum == G) break;
        __builtin_amdgcn_s_sleep(1);
        if ((++sp & 255u) == 0u) { if (xb_ld(&bar[XB_TMO])) break; if (sp > XB_SPIN_CAP) { atomicAdd(&bar[XB_TMO], 1u); break; } }
    }
    nloc = mine > 0u ? mine : 1u; nx = cnt > 0u ? cnt : 1u;
}
__device__ __forceinline__ void xcd_barrier(const XcdBarrier& b) {
    asm volatile("s_waitcnt vmcnt(0)" ::: "memory");
    __syncthreads();
    if (threadIdx.x == 0) {
        unsigned* bar = b.bar;
        __builtin_amdgcn_s_waitcnt(0);
        unsigned nloc = b.st[0], nx = b.st[1];
        if (nloc == 0u) { xcd_barrier_complete(bar, b.x, nloc, nx); b.st[0] = nloc; b.st[1] = nx; }
        const unsigned old = xb_add(&bar[XB_XSUB(b.x)], 1u);
        const unsigned gen = old / nloc;
        if (old + 1u == (gen + 1u) * nloc) {
            __builtin_amdgcn_fence(__ATOMIC_RELEASE, "agent");
            asm volatile("s_waitcnt vmcnt(0)" ::: "memory");
            const unsigned og = xb_add(&bar[XB_TOP], 1u);
            const unsigned tg = og / nx;
            if (og + 1u == (tg + 1u) * nx) xb_add(&bar[XB_TOPGEN], 1u);
            else XB_SPIN(xb_ld(&bar[XB_TOPGEN]) == tg, bar);
            __builtin_amdgcn_fence(__ATOMIC_ACQUIRE, "agent");
            xb_add(&bar[XB_XGEN(b.x)], 1u);
            asm volatile("s_waitcnt vmcnt(0)" ::: "memory");
        } else {
            XB_SPIN(xb_ld(&bar[XB_XGEN(b.x)]) == gen, bar);
            __builtin_amdgcn_fence(__ATOMIC_ACQUIRE, "agent");
            asm volatile("s_waitcnt vmcnt(0)" ::: "memory");
        }
    }
    __syncthreads();
}

namespace pg8 {
constexpr int BM = 256, BK = 64, HALF = 128, HTB = HALF * BK * 2, STAGE_BYTES = 8 * HTB, NXCD = 8, WGM = 8;
__host__ __device__ __forceinline__ int lds_byte(int r, int c) { const int st = (r >> 4) * 2 + (c >> 5), rr = r & 15, cc = c & 31, ob = rr * 64 + cc * 2; return st * 1024 + (ob ^ (((ob >> 9) & 1) << 5)); }
__host__ __device__ __forceinline__ void stage_rc(int b, int& R, int& C) { const int st = b / 1024, sb = b % 1024, swz = sb ^ (((sb >> 9) & 1) << 5); R = (st >> 1) * 16 + swz / 64; C = (st & 1) * 32 + (swz % 64) / 2; }
__host__ __device__ __forceinline__ int perm32(int rho) { const int n = rho >> 4, i = rho & 15; return 8 * (i >> 2) + 4 * n + (i & 3); }
struct Unit { int pm, pn; };
struct Gemm { const bf16_t* A; const bf16_t* Bt; int M, N, K; };
struct StaticOrder {
    int nM, nN, nwg, G, c;
    __host__ __device__ void init(int M, int N, int G_, int c_) { nM = M / BM; nN = N / BM; nwg = nM * nN; G = G_; c = c_; }
    __host__ __device__ bool next(int i, Unit& u) const {
        const long L = (long)i * G + c; if (L >= nwg) return false;
        int wgid = (int)L; { const int q = nwg / NXCD, r = nwg % NXCD, xcd = wgid % NXCD, off = wgid / NXCD; wgid = (xcd < r ? xcd * (q + 1) : r * (q + 1) + (xcd - r) * q) + off; }
        const int nig = WGM * nN, gid = wgid / nig, fm = gid * WGM, gsz = (nM - fm) < WGM ? (nM - fm) : WGM;
        u.pm = fm + ((wgid % nig) % gsz); u.pn = (wgid % nig) / gsz; return true;
    }
    __device__ __forceinline__ void a_ready(const Unit&) const {}
    __device__ __forceinline__ void done(const Unit&) const {}
};
template <class Epi, class Sched>
__device__ __forceinline__ void gemm_phase(LAS unsigned char* lds, const Gemm g, const Sched& S, const Epi& E) {
    const int tid = threadIdx.x, wid = __builtin_amdgcn_readfirstlane(tid >> 6), lane = tid & 63, wr = wid >> 2, wc = wid & 3, fr = lane & 15, fq = lane >> 4;
    const int K = g.K, nt = K / BK;
    unsigned voffA[2], voffB[2];
#pragma unroll
    for (int i = 0; i < 2; ++i) { int R, C; stage_rc(tid * 16 + i * 8192, R, C); const int Rb = Epi::PERM ? ((R & ~31) + perm32(R & 31)) : R;
        voffA[i] = (unsigned)(R * K + C) * 2u; voffB[i] = (unsigned)(Rb * K + C) * 2u; }
    const size_t kstep = (size_t)(BK * 2);
    const size_t hstep = (size_t)HALF * K * 2;
    const size_t tstep = 2 * hstep;
    const unsigned ldsw = (unsigned)wid * 1024u;
    const int aoff = lds_byte(wr * 64 + fr, fq * 8), boff = lds_byte(wc * 32 + fr, fq * 8);
#define PG8_SA(b, h) (((b) * 2 + (h)) * HTB)
#define PG8_SB(b, h) ((4 + (b) * 2 + (h)) * HTB)
#define PG8_STAGE(bufoff, gbase, voff) do { _Pragma("unroll") for (int _i = 0; _i < 2; ++_i) \
        __builtin_amdgcn_global_load_lds((const unsigned*)((const char*)(gbase) + (voff)[_i]), (LAS unsigned*)(lds + (bufoff) + ldsw + _i * 8192), 16, 0, 0); } while (0)
#define PG8_LDA(dst, b, h) do { _Pragma("unroll") for (int m = 0; m < 4; ++m) _Pragma("unroll") for (int k = 0; k < 2; ++k) dst[m][k] = *(const LAS bf16x8*)(lds + PG8_SA(b, h) + aoff + m * 2048 + k * 1024); } while (0)
#define PG8_LDB(dst, b, h) do { _Pragma("unroll") for (int n = 0; n < 2; ++n) _Pragma("unroll") for (int k = 0; k < 2; ++k) dst[n][k] = *(const LAS bf16x8*)(lds + PG8_SB(b, h) + boff + n * 2048 + k * 1024); } while (0)
#define PG8_MMA(ai, bj, At, Bt) do { __builtin_amdgcn_s_setprio(1); _Pragma("unroll") for (int m = 0; m < 4; ++m) _Pragma("unroll") for (int n = 0; n < 2; ++n) _Pragma("unroll") for (int k = 0; k < 2; ++k) \
        acc[ai][bj][m][n] = __builtin_amdgcn_mfma_f32_16x16x32_bf16(Bt[n][k], At[m][k], acc[ai][bj][m][n], 0, 0, 0); __builtin_amdgcn_s_setprio(0); } while (0)
#define PG8_WAIT_V(n) asm volatile("s_waitcnt vmcnt(" #n ")" ::: "memory")
#define PG8_WAIT_L(n) asm volatile("s_waitcnt lgkmcnt(" #n ")" ::: "memory")
#define PG8_BAR __builtin_amdgcn_s_barrier()
#define PG8_SCHED __builtin_amdgcn_sched_barrier(0)
    Unit cur, nxt; int ui = 0;
    if (!S.next(0, cur)) return;
    f32x4 acc[2][2][4][2];
#pragma unroll
    for (int a = 0; a < 2; ++a)
#pragma unroll
        for (int b = 0; b < 2; ++b)
#pragma unroll
            for (int m = 0; m < 4; ++m)
#pragma unroll
                for (int n = 0; n < 2; ++n) acc[a][b][m][n] = (f32x4){0.f, 0.f, 0.f, 0.f};
    bf16x8 At[4][2], B0[2][2], B1[2][2];
    const char* cA = (const char*)g.A + (size_t)cur.pm * tstep; const char* cB = (const char*)g.Bt + (size_t)cur.pn * tstep;
    S.a_ready(cur);
    PG8_STAGE(PG8_SB(0, 0), cB, voffB); PG8_STAGE(PG8_SA(0, 0), cA, voffA); PG8_STAGE(PG8_SB(0, 1), cB + hstep, voffB); PG8_STAGE(PG8_SA(0, 1), cA + hstep, voffA);
    if (wr == 1) PG8_BAR;
    PG8_WAIT_V(4); PG8_BAR;
    PG8_STAGE(PG8_SB(1, 0), cB + kstep, voffB); PG8_STAGE(PG8_SA(1, 0), cA + kstep, voffA); PG8_STAGE(PG8_SB(1, 1), cB + hstep + kstep, voffB);
    PG8_WAIT_V(6); PG8_BAR;
    for (;;) {
        const bool has_next = S.next(ui + 1, nxt);
        const char* nA = has_next ? (const char*)g.A + (size_t)nxt.pm * tstep : cA; const char* nB = has_next ? (const char*)g.Bt + (size_t)nxt.pn * tstep : cB;
        for (int t = 0; t < nt; t += 2) {
            const bool last = (t == nt - 2);
            const char* a1 = cA + (size_t)(t + 1) * kstep;
            const char* a2 = last ? nA : cA + (size_t)(t + 2) * kstep; const char* b2 = last ? nB : cB + (size_t)(t + 2) * kstep;
            const char* a3 = a2 + kstep; const char* b3 = b2 + kstep;
            if (last && has_next) S.a_ready(nxt);
            PG8_LDB(B0, 0, 0); PG8_SCHED; PG8_LDA(At, 0, 0); PG8_STAGE(PG8_SA(1, 1), a1 + hstep, voffA);
            PG8_WAIT_L(8); PG8_BAR; PG8_WAIT_L(0); PG8_MMA(0, 0, At, B0); PG8_BAR; PG8_SCHED;
            PG8_LDB(B1, 0, 1); PG8_STAGE(PG8_SB(0, 0), b2, voffB);
            PG8_BAR; PG8_WAIT_L(0); PG8_MMA(0, 1, At, B1); PG8_BAR;
            PG8_LDA(At, 0, 1); PG8_STAGE(PG8_SA(0, 0), a2, voffA);
            PG8_BAR; PG8_WAIT_L(0); PG8_MMA(1, 0, At, B0); PG8_BAR; PG8_SCHED;
            PG8_STAGE(PG8_SB(0, 1), b2 + hstep, voffB);
            PG8_WAIT_V(6); PG8_BAR; PG8_MMA(1, 1, At, B1); PG8_BAR;
            PG8_LDB(B0, 1, 0); PG8_SCHED; PG8_LDA(At, 1, 0); PG8_STAGE(PG8_SA(0, 1), a2 + hstep, voffA);
            PG8_WAIT_L(8); PG8_BAR; PG8_WAIT_L(0); PG8_MMA(0, 0, At, B0); PG8_BAR; PG8_SCHED;
            PG8_LDB(B1, 1, 1); PG8_STAGE(PG8_SB(1, 0), b3, voffB);
            PG8_BAR; PG8_WAIT_L(0); PG8_MMA(0, 1, At, B1); PG8_BAR;
            PG8_LDA(At, 1, 1); PG8_STAGE(PG8_SA(1, 0), a3, voffA);
            PG8_BAR; PG8_WAIT_L(0); PG8_MMA(1, 0, At, B0); PG8_BAR; PG8_SCHED;
            PG8_STAGE(PG8_SB(1, 1), b3 + hstep, voffB);
            PG8_WAIT_V(6); PG8_BAR; PG8_MMA(1, 1, At, B1); PG8_BAR;
        }
        E(acc, cur, wr, wc, fr, fq);
        if (!has_next) break;
#pragma unroll
        for (int a = 0; a < 2; ++a)
#pragma unroll
            for (int b = 0; b < 2; ++b)
#pragma unroll
                for (int m = 0; m < 4; ++m)
#pragma unroll
                    for (int n = 0; n < 2; ++n) acc[a][b][m][n] = (f32x4){0.f, 0.f, 0.f, 0.f};
        cur = nxt; cA = nA; cB = nB; ++ui;
    }
    PG8_WAIT_V(0);
    if (wr == 0) PG8_BAR;
    PG8_BAR;
#undef PG8_SA
#undef PG8_SB
#undef PG8_STAGE
#undef PG8_LDA
#undef PG8_LDB
#undef PG8_MMA
#undef PG8_WAIT_V
#undef PG8_WAIT_L
#undef PG8_BAR
#undef PG8_SCHED
}
}

typedef f32x4 Acc[2][2][4][2];
#define EPI_ROWS(...) _Pragma("unroll") for (int ai = 0; ai < 2; ++ai) _Pragma("unroll") for (int m = 0; m < 4; ++m) { const int row = u.pm * 256 + ai * 128 + wr * 64 + m * 16 + fr; __VA_ARGS__ }
__device__ __forceinline__ u32x4 pack8(const float* v) { u32x4 w; w.x = pk2(v[0], v[1]); w.y = pk2(v[2], v[3]); w.z = pk2(v[4], v[5]); w.w = pk2(v[6], v[7]); return w; }

template <int SET> struct EpiProj {
    static constexpr bool PERM = true;
    const float* ss1; const float* qn; const float* kn; const float* rot;
    bf16_t *Q, *CA, *KS, *VS, *KW, *VW, *RQ, *RK, *RV, *RG; float* GATE; float* out;
    __device__ __forceinline__ void operator()(const Acc& acc, const pg8::Unit& u, int wr, int wc, int fr, int fq) const {
        const int pn = u.pn, c8 = 8 * fq;
        if (SET == 0 && (pn < 2 || pn == 3)) {
            const float* nw = (pn < 2) ? qn : kn; const float post = (pn < 2) ? 0.125f * LOG2E : 1.f;
            EPI_ROWS(
                const float s1 = ss1[row]; float v[2][8]; float ss = 0.f;
                _Pragma("unroll") for (int bj = 0; bj < 2; ++bj) _Pragma("unroll") for (int e = 0; e < 8; ++e) { v[bj][e] = acc[ai][bj][m][e >> 2][e & 3] * s1; ss += v[bj][e] * v[bj][e]; }
                ss += __shfl_xor(ss, 16); ss += __shfl_xor(ss, 32);
                const float rs = rsqrtf(ss * (1.f / 64.f) + EPS) * post;
                _Pragma("unroll") for (int bj = 0; bj < 2; ++bj) {
                    const int d0 = 32 * bj + c8;
                    const f32x4 w0 = *(const f32x4*)(nw + d0), w1 = *(const f32x4*)(nw + d0 + 4);
                    _Pragma("unroll") for (int e = 0; e < 4; ++e) { v[bj][e] *= rs * w0[e]; v[bj][4 + e] *= rs * w1[e]; }
                    if (pn < 2) { *(u32x4*)(Q + (size_t)row * 512 + (pn * 4 + wc) * 64 + d0) = pack8(v[bj]); }
                    else {
                        const int col = (wc & 1) * 64 + d0;
                        if (wc < 2) {
                            *(u32x4*)(KS + (size_t)row * 128 + col) = pack8(v[bj]);
                            float* o = row < MP ? out + O_PSK + (size_t)row * 128 + col : out + O_SSK + (size_t)(row - MP) * 128 + col;
                            if (row < MV) { *(f32x4*)o = (f32x4){v[bj][0], v[bj][1], v[bj][2], v[bj][3]}; *(f32x4*)(o + 4) = (f32x4){v[bj][4], v[bj][5], v[bj][6], v[bj][7]}; }
                        } else {
                            *(u32x4*)(KW + (size_t)row * 128 + col) = pack8(v[bj]);
                            float* o = nullptr; const int t = row & 2047;
                            if (row < MP) { if (t >= 1536) o = out + O_PWK + ((size_t)(row >> 11) * 512 + (t - 1536)) * 128 + col; }
                            else if (row < MV) o = out + O_SWK + ((size_t)(row - MP) * 512 + 511) * 128 + col;
                            if (o) { *(f32x4*)o = (f32x4){v[bj][0], v[bj][1], v[bj][2], v[bj][3]}; *(f32x4*)(o + 4) = (f32x4){v[bj][4], v[bj][5], v[bj][6], v[bj][7]}; }
                        }
                    }
                }
            )
        } else if (SET == 1 && (pn == 2 || pn == 4)) {
            EPI_ROWS(
                const float s1 = ss1[row];
                _Pragma("unroll") for (int bj = 0; bj < 2; ++bj) {
                    float v[8]; _Pragma("unroll") for (int e = 0; e < 8; ++e) v[e] = acc[ai][bj][m][e >> 2][e & 3] * s1;
                    const int col = 32 * wc + c8;
                    float* o = nullptr;
                    if (pn == 2) {
                        if (row < MP) { const int b = row >> 11, t = row & 2047, g = col >> 6, d = col & 63;
                            *(u32x4*)(CA + ((size_t)bj * CROWS + CROWS_S + ((b * 128 + (t >> 4)) * 2 + g)) * 1024 + (t & 15) * 64 + d) = pack8(v);
                            o = out + (bj ? O_PCV : O_PCK) + (size_t)row * 128 + col; }
                        else if (row < MV) o = out + (bj ? O_SCV : O_SCK) + (size_t)(row - MP) * 128 + col;
                    } else if (bj == 0) {
                        *(u32x4*)(VS + (size_t)row * 128 + col) = pack8(v);
                        if (row < MP) o = out + O_PSV + (size_t)row * 128 + col; else if (row < MV) o = out + O_SSV + (size_t)(row - MP) * 128 + col;
                    } else {
                        *(u32x4*)(VW + (size_t)row * 128 + col) = pack8(v);
                        const int t = row & 2047;
                        if (row < MP) { if (t >= 1536) o = out + O_PWV + ((size_t)(row >> 11) * 512 + (t - 1536)) * 128 + col; }
                        else if (row < MV) o = out + O_SWV + ((size_t)(row - MP) * 512 + 511) * 128 + col;
                    }
                    if (o) { *(f32x4*)o = (f32x4){v[0], v[1], v[2], v[3]}; *(f32x4*)(o + 4) = (f32x4){v[4], v[5], v[6], v[7]}; }
                }
            )
        } else if (SET == 0) {
            const int isk = (pn >= 7) ? 1 : 0, head = ((pn - 5) & 1) * 2 + (wc >> 1), j0 = 32 * (wc & 1) + c8;
            bf16_t* dst = isk ? RK : RQ; const float post = isk ? 0.08838834764831845f : 1.f;
            EPI_ROWS(
                const float s1 = ss1[row] * post; const int pidx = row < MP ? (row & 2047) : 2048;
                const float* rp = rot + ((size_t)pidx * 64 + j0) * 2;
                float y1[8], y2[8];
                _Pragma("unroll") for (int e2 = 0; e2 < 4; ++e2) { const f32x4 cs = *(const f32x4*)(rp + 4 * e2);
                    _Pragma("unroll") for (int t = 0; t < 2; ++t) { const int e = 2 * e2 + t; const float x1 = acc[ai][0][m][e >> 2][e & 3] * s1, x2 = acc[ai][1][m][e >> 2][e & 3] * s1, c = cs[2 * t], s = cs[2 * t + 1];
                        y1[e] = x1 * c - x2 * s; y2[e] = x1 * s + x2 * c; } }
                *(u32x4*)(dst + (size_t)row * 512 + head * 128 + j0) = pack8(y1);
                *(u32x4*)(dst + (size_t)row * 512 + head * 128 + 64 + j0) = pack8(y2);
            )
        } else if (SET == 1 && pn <= 12) {
            const int isg = pn >= 11; bf16_t* dst = isg ? RG : RV; const int cb = ((pn - 9) & 1) * 256;
            EPI_ROWS(
                const float s1 = ss1[row];
                _Pragma("unroll") for (int bj = 0; bj < 2; ++bj) { float v[8];
                    _Pragma("unroll") for (int e = 0; e < 8; ++e) { const float x = acc[ai][bj][m][e >> 2][e & 3] * s1; v[e] = isg ? siluf_(x) : x; }
                    *(u32x4*)(dst + (size_t)row * 512 + cb + 128 * bj + 32 * wc + c8) = pack8(v); }
            )
        } else if (SET == 1) {
            if (wc == 0 && fq < 3) {
                EPI_ROWS(
                    const float s1 = ss1[row]; float v[8];
                    _Pragma("unroll") for (int e = 0; e < 8; ++e) v[e] = sigmoidf_(acc[ai][0][m][e >> 2][e & 3] * s1);
                    float* o = GATE + (size_t)row * 24 + c8;
                    *(f32x4*)o = (f32x4){v[0], v[1], v[2], v[3]}; *(f32x4*)(o + 4) = (f32x4){v[4], v[5], v[6], v[7]};
                )
            }
        }
    }
};

struct SubsetOrder : pg8::StaticOrder {
    int set;
    __device__ __forceinline__ bool next(int i, pg8::Unit& u) const { if (!pg8::StaticOrder::next(i, u)) return false; const int k = u.pn;
        u.pn = set == 0 ? (k < 2 ? k : (k == 2 ? 3 : k + 2)) : (k == 0 ? 2 : (k == 1 ? 4 : k + 7)); return true; }
};
struct EpiF32 {
    static constexpr bool PERM = true;
    float* C; int ld;
    __device__ __forceinline__ void operator()(const Acc& acc, const pg8::Unit& u, int wr, int wc, int fr, int fq) const {
        EPI_ROWS(
            _Pragma("unroll") for (int bj = 0; bj < 2; ++bj) { float* o = C + (size_t)row * ld + u.pn * 256 + 128 * bj + 32 * wc + 8 * fq;
                *(f32x4*)o = acc[ai][bj][m][0]; *(f32x4*)(o + 4) = acc[ai][bj][m][1]; }
        )
    }
};
struct EpiCmp {
    static constexpr bool PERM = true;
    float* C;
    __device__ __forceinline__ void operator()(const Acc& acc, const pg8::Unit& u, int wr, int wc, int fr, int fq) const {
        EPI_ROWS(
            _Pragma("unroll") for (int bj = 0; bj < 2; ++bj) { float* o = C + (size_t)row * 256 + 128 * bj + 32 * wc + 8 * fq;
                *(f32x4*)o = acc[ai][bj][m][0]; *(f32x4*)(o + 4) = acc[ai][bj][m][1]; }
        )
    }
};
struct CmpOrder {
    int G, c;
    __device__ __forceinline__ bool next(int i, pg8::Unit& u) const { const int L = i * G + c; if (L >= 2 * (CROWS / 256)) return false; u.pm = L; u.pn = L / (CROWS / 256); return true; }
    __device__ __forceinline__ void a_ready(const pg8::Unit&) const {}
    __device__ __forceinline__ void done(const pg8::Unit&) const {}
};

struct EpiOut {
    static constexpr bool PERM = true;
    const float* xp; const float* xs; float* H; bf16_t* HB; float* SS2;
    __device__ __forceinline__ void operator()(const Acc& acc, const pg8::Unit& u, int wr, int wc, int fr, int fq) const {
        EPI_ROWS(
            float ss = 0.f;
            _Pragma("unroll") for (int bj = 0; bj < 2; ++bj) { const int col = u.pn * 256 + 128 * bj + 32 * wc + 8 * fq; float v[8];
                f32x4 x0 = (f32x4){0.f, 0.f, 0.f, 0.f}, x1 = x0;
                if (row < MV) { const float* xr = row < MP ? xp + (size_t)row * DM + col : xs + (size_t)(row - MP) * DM + col; x0 = *(const f32x4*)xr; x1 = *(const f32x4*)(xr + 4); }
                _Pragma("unroll") for (int e = 0; e < 4; ++e) { v[e] = acc[ai][bj][m][0][e] + x0[e]; v[4 + e] = acc[ai][bj][m][1][e] + x1[e]; }
                _Pragma("unroll") for (int e = 0; e < 8; ++e) ss += v[e] * v[e];
                float* o = H + (size_t)row * DM + col; *(f32x4*)o = (f32x4){v[0], v[1], v[2], v[3]}; *(f32x4*)(o + 4) = (f32x4){v[4], v[5], v[6], v[7]};
                *(u32x4*)(HB + (size_t)row * DM + col) = pack8(v); }
            ss += __shfl_xor(ss, 16); ss += __shfl_xor(ss, 32);
            if (fq == 0 && row < MV) atomicAdd(SS2 + row, ss);
        )
    }
};
struct EpiGU {
    static constexpr bool PERM = true;
    const float* SS2; bf16_t* ACT;
    __device__ __forceinline__ void operator()(const Acc& acc, const pg8::Unit& u, int wr, int wc, int fr, int fq) const {
        EPI_ROWS(
            const float s2 = rsqrtf(SS2[row] * (1.f / 1024.f) + EPS); float v[8];
            _Pragma("unroll") for (int e = 0; e < 8; ++e) { const float gt = acc[ai][0][m][e >> 2][e & 3] * s2, up = acc[ai][1][m][e >> 2][e & 3] * s2; v[e] = siluf_(gt) * up; }
            *(u32x4*)(ACT + (size_t)row * DFF + u.pn * 128 + 32 * wc + 8 * fq) = pack8(v);
        )
    }
};
struct EpiDown {
    static constexpr bool PERM = true;
    const float* H; float* H2; bf16_t* H2B;
    __device__ __forceinline__ void operator()(const Acc& acc, const pg8::Unit& u, int wr, int wc, int fr, int fq) const {
        EPI_ROWS(
            _Pragma("unroll") for (int bj = 0; bj < 2; ++bj) { const size_t off = (size_t)row * DM + u.pn * 256 + 128 * bj + 32 * wc + 8 * fq; float v[8];
                const f32x4 h0 = *(const f32x4*)(H + off), h1 = *(const f32x4*)(H + off + 4);
                _Pragma("unroll") for (int e = 0; e < 4; ++e) { v[e] = acc[ai][bj][m][0][e] + h0[e]; v[4 + e] = acc[ai][bj][m][1][e] + h1[e]; }
                *(f32x4*)(H2 + off) = (f32x4){v[0], v[1], v[2], v[3]}; *(f32x4*)(H2 + off + 4) = (f32x4){v[4], v[5], v[6], v[7]};
                *(u32x4*)(H2B + off) = pack8(v); }
        )
    }
};
struct EpiFinal {
    static constexpr bool PERM = true;
    const float* H2; const float* VP; float* out;
    __device__ __forceinline__ void operator()(const Acc& acc, const pg8::Unit& u, int wr, int wc, int fr, int fq) const {
        EPI_ROWS(
            if (row < MV) {
                _Pragma("unroll") for (int bj = 0; bj < 2; ++bj) { const int col = u.pn * 256 + 128 * bj + 32 * wc + 8 * fq; const size_t off = (size_t)row * DM + col; float v[8];
                    const f32x4 h0 = *(const f32x4*)(H2 + off), h1 = *(const f32x4*)(H2 + off + 4), p0 = *(const f32x4*)(VP + off), p1 = *(const f32x4*)(VP + off + 4);
                    _Pragma("unroll") for (int e = 0; e < 4; ++e) { v[e] = h0[e] + sigmoidf_(acc[ai][bj][m][0][e]) * p0[e]; v[4 + e] = h1[e] + sigmoidf_(acc[ai][bj][m][1][e]) * p1[e]; }
                    float* o = row < MP ? out + O_YP + off : out + O_YS + (size_t)(row - MP) * DM + col;
                    *(f32x4*)o = (f32x4){v[0], v[1], v[2], v[3]}; *(f32x4*)(o + 4) = (f32x4){v[4], v[5], v[6], v[7]}; }
            }
        )
    }
};

__device__ __forceinline__ int rel_bucket(int dist) {
    const int n = dist < 0 ? 0 : dist;
    if (n < 16) return n;
    const int large = 16 + (int)(logf((float)n / 16.f) / 2.0794415416798357f * 16.f);
    return large < 31 ? large : 31;
}
struct WSrc { const float* src; int ld, vt; const float* ks; };
__device__ __forceinline__ WSrc wsrc(const Params& p, int wid, int n0) {
    WSrc w; w.vt = 32; w.ks = nullptr;
    if (wid == 0) {
        const int tile = n0 >> 8, c = n0 & 255, bj = c >> 7, wc = (c >> 5) & 3; int col;
        if (tile < 2) col = (tile * 4 + wc) * 64 + 32 * bj;
        else if (tile == 2) col = 512 + c;
        else if (tile == 3) col = (wc < 2 ? 768 : 1024) + (wc & 1) * 64 + 32 * bj;
        else if (tile == 4) col = (bj ? 1152 : 896) + (c & 127);
        else if (tile <= 8) col = (tile >= 7 ? 1816 : 1304) + ((((tile - 5) & 1) * 2 + (wc >> 1)) * 128) + 64 * bj + 32 * (wc & 1);
        else if (tile <= 10) col = 2328 + (tile - 9) * 256 + c;
        else if (tile <= 12) col = 2840 + (tile - 11) * 256 + c;
        else { col = 1280; w.vt = (c == 0) ? 24 : 0; }
        w.src = p.in[13] + col; w.ld = INC; w.ks = p.in[12];
    } else if (wid == 1) { w.src = p.in[23] + n0; w.ld = DM; }
    else if (wid == 2) { const int pn = n0 >> 8, bj = (n0 >> 7) & 1, c7 = n0 & 127; w.src = (bj ? p.in[26] : p.in[25]) + pn * 128 + c7; w.ld = DFF; w.ks = p.in[24]; }
    else if (wid == 3) { w.src = p.in[27] + n0; w.ld = DM; }
    else if (wid == 4) { w.src = p.in[28] + n0; w.ld = DM; }
    else if (wid == 5) { w.src = p.in[29] + n0; w.ld = DM; }
    else if (wid == 6 || wid == 7) { const int j = n0 >> 7, h0 = n0 & 127; w.src = p.in[wid == 6 ? 17 : 20] + (size_t)j * 1024 * 128 + h0; w.ld = 128; }
    else { w.src = p.in[wid == 8 ? 18 : 21] + n0; w.ld = 64; }
    return w;
}
__device__ __forceinline__ void phase_prologue(const Params& p, unsigned char* lds) {
    const int tid = threadIdx.x, lane = tid & 63, wid = tid >> 6, G = gridDim.x, bid = blockIdx.x;
    unsigned char* ws = p.ws;
    {
        const int tn[10] = {112, 32, 176, 32, 32, 32, 8, 8, 2, 2}, tk[10] = {16, 16, 16, 44, 16, 4, 16, 16, 2, 2};
        const size_t dsto[10] = {WS_W1, WS_WO, WS_WGU, WS_WD, WS_WPG, WS_WPP, WS_W1C, WS_W1C + (size_t)256 * 1024 * 2, WS_W2C, WS_W2C + (size_t)64 * 128 * 2};
        int total = 0;
#pragma unroll
        for (int i = 0; i < 10; ++i) total += tn[i] * tk[i];
        float* tl = (float*)lds;
        for (int t = bid; t < total; t += G) {
            int wsel = 0, rem = t;
#pragma unroll
            for (int i = 0; i < 9; ++i) { if (wsel == i && rem >= tn[i] * tk[i]) { rem -= tn[i] * tk[i]; wsel = i + 1; } }
            int tkk = 16, K = 1024; size_t doff = 0;
#pragma unroll
            for (int i = 0; i < 10; ++i) if (wsel == i) { tkk = tk[i]; doff = dsto[i]; }
            K = tkk * 64;
            const int n0 = (rem / tkk) * 32, k0 = (rem % tkk) * 64;
            const WSrc w = wsrc(p, wsel, n0);
#pragma unroll
            for (int it = 0; it < 4; ++it) { const int kk = it * 16 + (tid >> 5), tt = tid & 31; float v = 0.f;
                if (tt < w.vt) { v = w.src[(size_t)(k0 + kk) * w.ld + tt]; if (w.ks) v *= w.ks[k0 + kk]; }
                tl[kk * 33 + tt] = v; }
            __syncthreads();
            { const int nt = tid >> 4, kq = (tid & 15) * 4;
              u32x2 o; o.x = pk2(tl[(kq + 0) * 33 + nt], tl[(kq + 1) * 33 + nt]); o.y = pk2(tl[(kq + 2) * 33 + nt], tl[(kq + 3) * 33 + nt]);
              *(u32x2*)((bf16_t*)(ws + doff) + (size_t)(n0 + nt) * K + k0 + kq) = o; }
            __syncthreads();
        }
    }
    {
        bf16_t* XB = (bf16_t*)(ws + WS_XB); float* SS1 = (float*)(ws + WS_SS1); bf16_t* PB = (bf16_t*)(ws + WS_PB);
        for (int row = bid * 8 + wid; row < MR; row += G * 8) {
            const float* xr = row < MP ? p.in[0] + (size_t)row * DM : p.in[1] + (size_t)(row - MP) * DM;
            const float* pr = row < MP ? p.in[10] + (size_t)row * PLE : p.in[11] + (size_t)(row - MP) * PLE;
            f32x4 v[4]; float ss = 0.f;
#pragma unroll
            for (int i = 0; i < 4; ++i) { v[i] = row < MV ? *(const f32x4*)(xr + i * 256 + lane * 4) : (f32x4){0.f, 0.f, 0.f, 0.f}; ss += v[i][0] * v[i][0] + v[i][1] * v[i][1] + v[i][2] * v[i][2] + v[i][3] * v[i][3]; }
#pragma unroll
            for (int o = 1; o < 64; o <<= 1) ss += __shfl_xor(ss, o);
#pragma unroll
            for (int i = 0; i < 4; ++i) { u32x2 o; o.x = pk2(v[i][0], v[i][1]); o.y = pk2(v[i][2], v[i][3]); *(u32x2*)(XB + (size_t)row * DM + i * 256 + lane * 4) = o; }
            if (lane == 0) SS1[row] = rsqrtf(ss * (1.f / 1024.f) + EPS);
            const f32x4 pv = row < MV ? *(const f32x4*)(pr + lane * 4) : (f32x4){0.f, 0.f, 0.f, 0.f};
            u32x2 o; o.x = pk2(pv[0], pv[1]); o.y = pk2(pv[2], pv[3]); *(u32x2*)(PB + (size_t)row * PLE + lane * 4) = o;
        }
    }
    const int gtid = bid * 512 + tid, gsz = G * 512;
    {
        float* rot = (float*)(ws + WS_ROT);
        for (int idx = gtid; idx < 2049 * 64; idx += gsz) { const int pidx = idx >> 6, j = idx & 63; const float pos = pidx < 2048 ? (float)pidx : 16384.f;
            const float inv = powf(10000.f, -(float)j / 64.f); const float ang = pos * inv; const double a = (double)ang;
            rot[(size_t)idx * 2] = (float)cos(a); rot[(size_t)idx * 2 + 1] = (float)sin(a); }
        float* btab = (float*)(ws + WS_BTAB);
        for (int idx = gtid; idx < 8 * 128; idx += gsz) { const int head = idx >> 7, dist = idx & 127; btab[idx] = p.in[30][rel_bucket(dist) * 8 + head] * LOG2E; }
        float* SS2 = (float*)(ws + WS_SS2);
        for (int idx = gtid; idx < MR; idx += gsz) SS2[idx] = 0.f;
        float* bc = (float*)(ws + WS_BIASC);
        for (int idx = gtid; idx < 256; idx += gsz) { const int c = idx >> 7, h = idx & 127; const float* pe = p.in[c ? 19 : 16]; const float* w1 = p.in[c ? 20 : 17]; float a = 0.f;
            for (int k = 0; k < 2048; ++k) a += pe[k] * w1[(size_t)k * 128 + h];
            bc[idx] = a; }
    }
    {
        bf16_t* CA = (bf16_t*)(ws + WS_CA);
        const int total = 2 * DB * PAST * 32;
        for (int idx0 = gtid; idx0 < total; idx0 += 4 * gsz) {
            f32x4 v[4]; size_t dst[4]; bool ok[4];
#pragma unroll
            for (int q = 0; q < 4; ++q) { const int idx = idx0 + q * gsz; ok[q] = idx < total; const int ii = ok[q] ? idx : 0;
                const int c4 = (ii & 31) * 4, tok = (ii >> 5) & (PAST - 1), b = (ii >> 19) & 31, c = ii >> 24;
                const int page = p.page_table[b * NPAGES + (tok >> 7)];
                v[q] = *(const f32x4*)(p.in[2 + c] + ((size_t)page * PAGE + (tok & 127)) * 128 + c4);
                const int seg = tok >> 4, s = tok & 15, g = c4 >> 6, d = c4 & 63;
                dst[q] = ((size_t)c * CROWS + (size_t)(b * 1024 + seg) * 2 + g) * 1024 + s * 64 + d; }
#pragma unroll
            for (int q = 0; q < 4; ++q) if (ok[q]) { u32x2 o; o.x = pk2(v[q][0], v[q][1]); o.y = pk2(v[q][2], v[q][3]); *(u32x2*)(CA + dst[q]) = o; }
        }
    }
    {
        const int total = 2 * DB * 511 * 32;
        for (int idx = gtid; idx < total; idx += gsz) { const int c4 = (idx & 31) * 4; int r = idx >> 5; const int j = r % 511; r /= 511; const int b = r & 31, c = r >> 5;
            const f32x4 v = *(const f32x4*)(p.in[6 + c] + ((size_t)b * 512 + j + 1) * 128 + c4);
            *(f32x4*)(p.out + (c ? O_SWV : O_SWK) + ((size_t)b * 512 + j) * 128 + c4) = v; }
    }
}

__device__ __forceinline__ s16x4 tr16(const unsigned char* p) { typedef short v4i16_t __attribute__((ext_vector_type(4))); return __builtin_bit_cast(s16x4, __builtin_amdgcn_ds_read_tr16_b64_v4i16((LAS v4i16_t*)p)); }
__device__ __forceinline__ bf16x8 cat8(s16x4 lo, s16x4 hi) { return (bf16x8){lo[0], lo[1], lo[2], lo[3], hi[0], hi[1], hi[2], hi[3]}; }
constexpr int RSTR = 272;
__device__ __forceinline__ float ret_lgam(int h) { return log2f(1.f - exp2f(-5.f - (float)h)); }
__device__ __forceinline__ bf16x8 tr_frag(const unsigned char* tile, int row0, int cb, int lane) {
    const int hi = lane >> 5;
    const unsigned char* a = tile + (size_t)(row0 + 4 * hi + ((lane & 15) >> 2)) * RSTR + (cb * 32 + 16 * ((lane >> 4) & 1) + 4 * (lane & 3)) * 2;
    return cat8(tr16(a), tr16(a + 8 * RSTR));
}
__device__ __forceinline__ void stage128(unsigned char* dst, const bf16_t* src, int tid, bool decay, float lg) {
    const int r = tid >> 2, q4 = tid & 3;
    float sc = decay ? exp2f((float)(127 - r) * lg) : 1.f;
#pragma unroll
    for (int i = 0; i < 4; ++i) { const int col = q4 * 32 + i * 8; u32x4 v = *(const u32x4*)(src + (size_t)r * 512 + col);
        if (decay) { v.x = pk2(bflo(v.x) * sc, bfhi(v.x) * sc); v.y = pk2(bflo(v.y) * sc, bfhi(v.y) * sc); v.z = pk2(bflo(v.z) * sc, bfhi(v.z) * sc); v.w = pk2(bflo(v.w) * sc, bfhi(v.w) * sc); }
        *(u32x4*)(dst + (size_t)r * RSTR + col * 2) = v; }
}
__device__ __forceinline__ void ret_r1_unit(const Params& p, unsigned char* lds, int b, int h, int c) {
    const int tid = threadIdx.x, lane = tid & 63, w = __builtin_amdgcn_readfirstlane(tid >> 6), r32 = lane & 31, hi = lane >> 5;
    const size_t row0 = (size_t)b * SEQ + c * 128;
    const float lg = ret_lgam(h);
    unsigned char* Kt = lds; unsigned char* Vt = lds + 128 * RSTR;
    stage128(Kt, (const bf16_t*)(p.ws + WS_RK) + row0 * 512 + h * 128, tid, true, lg);
    stage128(Vt, (const bf16_t*)(p.ws + WS_RV) + row0 * 512 + h * 128, tid, false, 0.f);
    __syncthreads();
    const int eb = w & 3, dp = w >> 2;
    f32x16 acc[2]; acc[0] = f32x16{}; acc[1] = f32x16{};
#pragma unroll
    for (int s = 0; s < 8; ++s) {
        const bf16x8 vf = tr_frag(Vt, 16 * s, eb, lane);
#pragma unroll
        for (int di = 0; di < 2; ++di) { const bf16x8 kf = tr_frag(Kt, 16 * s, 2 * dp + di, lane); acc[di] = __builtin_amdgcn_mfma_f32_32x32x16_bf16(vf, kf, acc[di], 0, 0, 0); }
    }
    float* KVT = (float*)(p.ws + WS_KVT) + ((size_t)((b * 4 + h) * 16 + c)) * 16384;
#pragma unroll
    for (int di = 0; di < 2; ++di)
#pragma unroll
        for (int r = 0; r < 16; ++r) KVT[(size_t)(32 * eb + crow(r, hi)) * 128 + 32 * (2 * dp + di) + r32] = acc[di][r];
    __syncthreads();
}
__device__ __forceinline__ void ret_r2_unit(const Params& p, unsigned char* lds, int b, int h, int c) {
    const int tid = threadIdx.x, lane = tid & 63, w = __builtin_amdgcn_readfirstlane(tid >> 6), r32 = lane & 31, hi = lane >> 5;
    const size_t row0 = (size_t)b * SEQ + c * 128;
    const float lg = ret_lgam(h);
    unsigned char* Qt = lds; unsigned char* Kt = lds + 128 * RSTR; unsigned char* Vt = lds + 2 * 128 * RSTR; float* st = (float*)(lds + 3 * 128 * RSTR);
    stage128(Qt, (const bf16_t*)(p.ws + WS_RQ) + row0 * 512 + h * 128, tid, false, 0.f);
    stage128(Kt, (const bf16_t*)(p.ws + WS_RK) + row0 * 512 + h * 128, tid, false, 0.f);
    stage128(Vt, (const bf16_t*)(p.ws + WS_RV) + row0 * 512 + h * 128, tid, false, 0.f);
    __syncthreads();
    const int eb = w & 3, ps = w >> 2;
    bf16x8 sf[8];
    if (c > 0) {
        const float* KV0 = (const float*)(p.ws + WS_KVT) + ((size_t)((b * 4 + h) * 16)) * 16384 + (size_t)(32 * eb + r32) * 128 + 8 * hi;
#pragma unroll
        for (int s = 0; s < 8; ++s) {
            float a[8];
#pragma unroll
            for (int e = 0; e < 8; ++e) a[e] = 0.f;
            for (int j = 0; j < c; ++j) { const float wj = exp2f(128.f * (float)(c - 1 - j) * lg); const float* src = KV0 + (size_t)j * 16384 + 16 * s;
                const f32x4 x0 = *(const f32x4*)src, x1 = *(const f32x4*)(src + 4);
#pragma unroll
                for (int e = 0; e < 4; ++e) { a[e] += wj * x0[e]; a[4 + e] += wj * x1[e]; } }
            const u32x4 pk = pack8(a); sf[s] = __builtin_bit_cast(bf16x8, pk);
        }
    }
    f32x16 accs[2];
#pragma unroll
    for (int ni = 0; ni < 2; ++ni) {
        const int nb = ps ? (1 + ni) : (ni ? 3 : 0);
        const int n = 32 * nb + r32;
        bf16x8 qf[8];
#pragma unroll
        for (int s = 0; s < 8; ++s) qf[s] = *(const bf16x8*)(Qt + (size_t)n * RSTR + (16 * s + 8 * hi) * 2);
        f32x16 acc = f32x16{};
        if (c > 0) {
#pragma unroll
            for (int s = 0; s < 8; ++s) acc = __builtin_amdgcn_mfma_f32_32x32x16_bf16(sf[s], qf[s], acc, 0, 0, 0);
            const float dn = exp2f((float)(n + 1) * lg);
#pragma unroll
            for (int r = 0; r < 16; ++r) acc[r] *= dn;
        }
        for (int mb = 0; mb <= nb; ++mb) {
            f32x16 x = f32x16{};
#pragma unroll
            for (int s = 0; s < 8; ++s) { const bf16x8 kf = *(const bf16x8*)(Kt + (size_t)(32 * mb + r32) * RSTR + (16 * s + 8 * hi) * 2); x = __builtin_amdgcn_mfma_f32_32x32x16_bf16(kf, qf[s], x, 0, 0, 0); }
            float pv[16];
#pragma unroll
            for (int r = 0; r < 16; ++r) { const int dm = n - (32 * mb + crow(r, hi)); pv[r] = dm >= 0 ? x[r] * exp2f((float)dm * lg) : 0.f; }
#pragma unroll
            for (int s2 = 0; s2 < 2; ++s2) { const u32x4 pk = pack8(pv + 8 * s2); const bf16x8 vf = tr_frag(Vt, 32 * mb + 16 * s2, eb, lane);
                acc = __builtin_amdgcn_mfma_f32_32x32x16_bf16(vf, __builtin_bit_cast(bf16x8, pk), acc, 0, 0, 0); }
        }
        float s1 = 0.f, s2 = 0.f;
#pragma unroll
        for (int r = 0; r < 16; ++r) { s1 += acc[r]; s2 += acc[r] * acc[r]; }
        s1 = xhalf_sum(s1); s2 = xhalf_sum(s2);
        if (hi == 0) { st[(eb * 128 + n) * 2] = s1; st[(eb * 128 + n) * 2 + 1] = s2; }
        accs[ni] = acc;
    }
    __syncthreads();
    const float* gn = p.in[22] + h * 128; const bf16_t* RG = (const bf16_t*)(p.ws + WS_RG); bf16_t* AO = (bf16_t*)(p.ws + WS_AO);
#pragma unroll
    for (int ni = 0; ni < 2; ++ni) {
        const int nb = ps ? (1 + ni) : (ni ? 3 : 0); const int n = 32 * nb + r32;
        float s1 = 0.f, s2 = 0.f;
#pragma unroll
        for (int q = 0; q < 4; ++q) { s1 += st[(q * 128 + n) * 2]; s2 += st[(q * 128 + n) * 2 + 1]; }
        const float mu = s1 * (1.f / 128.f), var = s2 * (1.f / 128.f) - mu * mu, rs = rsqrtf(var + EPS);
        const size_t row = row0 + n;
#pragma unroll
        for (int a = 0; a < 4; ++a) { const int e0 = 32 * eb + 8 * a + 4 * hi;
            const f32x4 gw = *(const f32x4*)(gn + e0); const u32x2 gg = *(const u32x2*)(RG + row * 512 + h * 128 + e0);
            const float g0 = bflo(gg.x), g1 = bfhi(gg.x), g2 = bflo(gg.y), g3 = bfhi(gg.y);
            u32x2 o; o.x = pk2((accs[ni][4 * a] - mu) * rs * gw[0] * g0, (accs[ni][4 * a + 1] - mu) * rs * gw[1] * g1);
            o.y = pk2((accs[ni][4 * a + 2] - mu) * rs * gw[2] * g2, (accs[ni][4 * a + 3] - mu) * rs * gw[3] * g3);
            *(u32x2*)(AO + row * 1024 + 512 + h * 128 + e0) = o; }
    }
    __syncthreads();
}
__device__ __forceinline__ void ret_sample_unit(const Params& p, unsigned char* lds, int b, int h) {
    const int tid = threadIdx.x;
    float* qv = (float*)lds; float* kv = qv + 128; float* vv = kv + 128; float* part = vv + 128; float* red = part + 512;
    const size_t row = (size_t)MP + b;
    if (tid < 384) { const int which = tid >> 7, d = tid & 127; const bf16_t* src = (const bf16_t*)(p.ws + (which == 0 ? WS_RQ : which == 1 ? WS_RK : WS_RV)) + row * 512 + h * 128 + d; qv[tid] = bf1(*src); }
    __syncthreads();
    const float gam = 1.f - exp2f(-5.f - (float)h);
    const int dq = tid >> 7, e = tid & 127;
    const float* st = p.in[8] + ((size_t)(b * 4 + h)) * 16384; float* so = p.out + O_SRET + ((size_t)(b * 4 + h)) * 16384;
    float acc = 0.f, qk = 0.f; const float ve = vv[e];
#pragma unroll 4
    for (int i = 0; i < 32; ++i) { const int d = dq + 4 * i; const float s = st[d * 128 + e]; acc += qv[d] * s; so[d * 128 + e] = gam * s + kv[d] * ve; }
#pragma unroll 4
    for (int d = 0; d < 128; ++d) qk += qv[d] * kv[d];
    part[dq * 128 + e] = acc;
    __syncthreads();
    float o = 0.f;
    if (tid < 128) { o = qk * ve + gam * (part[e] + part[128 + e] + part[256 + e] + part[384 + e]); }
    float s1 = tid < 128 ? o : 0.f, s2 = tid < 128 ? o * o : 0.f;
#pragma unroll
    for (int of = 1; of < 64; of <<= 1) { s1 += __shfl_xor(s1, of); s2 += __shfl_xor(s2, of); }
    if ((tid & 63) == 0 && tid < 128) { red[(tid >> 6) * 2] = s1; red[(tid >> 6) * 2 + 1] = s2; }
    __syncthreads();
    if (tid < 128) { const float t1 = red[0] + red[2], t2 = red[1] + red[3]; const float mu = t1 * (1.f / 128.f), var = t2 * (1.f / 128.f) - mu * mu, rs = rsqrtf(var + EPS);
        const float g = bf1(((const bf16_t*)(p.ws + WS_RG))[row * 512 + h * 128 + e]);
        const unsigned pk = pk2((o - mu) * rs * p.in[22][h * 128 + e] * g, 0.f);
        ((bf16_t*)(p.ws + WS_AO))[row * 1024 + 512 + h * 128 + e] = (bf16_t)(pk & 0xffffu); }
    __syncthreads();
}

__device__ __forceinline__ void compress2_task(const Params& p, int c, int task, int lane) {
    const int r32 = lane & 31, hi = lane >> 5;
    const int R = task * 32 + r32;
    const float* P0 = (const float*)(p.ws + WS_CP) + ((size_t)c * CROWS + R) * 256;
    const int R2 = (R + 2 < CROWS) ? R + 2 : CROWS - 1;
    const float* P1 = (const float*)(p.ws + WS_CP) + ((size_t)c * CROWS + R2) * 256 + 128;
    const float* bc = (const float*)(p.ws + WS_BIASC) + c * 128;
    const bf16_t* W2 = (const bf16_t*)(p.ws + WS_W2C) + (size_t)c * 64 * 128;
    f32x16 acc[2]; acc[0] = f32x16{}; acc[1] = f32x16{};
#pragma unroll
    for (int s = 0; s < 8; ++s) {
        const int k0 = 16 * s + 8 * hi; float hv[8];
#pragma unroll
        for (int q = 0; q < 2; ++q) { const f32x4 a = *(const f32x4*)(P0 + k0 + 4 * q), b = *(const f32x4*)(P1 + k0 + 4 * q), bb = *(const f32x4*)(bc + k0 + 4 * q);
#pragma unroll
            for (int e = 0; e < 4; ++e) hv[4 * q + e] = siluf_(a[e] + b[e] + bb[e]); }
        const u32x4 pk = pack8(hv); const bf16x8 hf = __builtin_bit_cast(bf16x8, pk);
#pragma unroll
        for (int eb = 0; eb < 2; ++eb) { const bf16x8 wf = *(const bf16x8*)(W2 + (size_t)(32 * eb + r32) * 128 + k0); acc[eb] = __builtin_amdgcn_mfma_f32_32x32x16_bf16(wf, hf, acc[eb], 0, 0, 0); }
    }
    float rs = 1.f;
    if (c == 0) { float ss = 0.f;
#pragma unroll
        for (int eb = 0; eb < 2; ++eb)
#pragma unroll
            for (int r = 0; r < 16; ++r) ss += acc[eb][r] * acc[eb][r];
        ss = xhalf_sum(ss); rs = rsqrtf(ss * (1.f / 64.f) + EPS); }
    bool valid; bf16_t* dst;
    if (R < CROWS_S) { valid = ((R >> 1) & 1023) < NC_S; dst = (bf16_t*)(p.ws + (c ? WS_CVCS : WS_CKCS)) + (size_t)R * 64; }
    else { const int Rp = R - CROWS_S; valid = ((Rp >> 1) & 127) < NC_P; dst = (bf16_t*)(p.ws + (c ? WS_CVCP : WS_CKCP)) + (size_t)Rp * 64; }
    if (valid) {
#pragma unroll
        for (int eb = 0; eb < 2; ++eb)
#pragma unroll
            for (int a = 0; a < 4; ++a) { const int e0 = 32 * eb + 8 * a + 4 * hi; float v[4];
#pragma unroll
                for (int e = 0; e < 4; ++e) { v[e] = acc[eb][4 * a + e] * rs; if (c == 0) v[e] *= p.in[15][e0 + e]; }
                u32x2 o; o.x = pk2(v[0], v[1]); o.y = pk2(v[2], v[3]); *(u32x2*)(dst + e0) = o; }
    }
}
__device__ __forceinline__ void pret_job(const Params& p) {
    const int gtid = blockIdx.x * 512 + threadIdx.x, gsz = gridDim.x * 512;
    for (int idx = gtid; idx < NB * 4 * 16384; idx += gsz) { const int d = idx & 127, e = (idx >> 7) & 127, bh = idx >> 14; const float lg = ret_lgam(bh & 3);
        const float* src = (const float*)(p.ws + WS_KVT) + (size_t)bh * 16 * 16384 + e * 128 + d; float a = 0.f;
#pragma unroll
        for (int j = 0; j < 16; ++j) a += exp2f(128.f * (float)(15 - j) * lg) * src[(size_t)j * 16384];
        p.out[O_PRET + (size_t)bh * 16384 + d * 128 + e] = a; }
}

constexpr int AT_K = 0, AT_V = 16384, AT_IMP = 32768, AT_IMPS = AT_IMP + 64 * 129 * 4, AT_MASK = AT_IMPS + 64 * 33 * 4, AT_BTAB = AT_MASK + 256, AT_END = AT_BTAB + 2048;
struct KVregs { u32x4 k, v; };
__device__ __forceinline__ KVregs kv_load(const bf16_t* Kg, const bf16_t* Vg, size_t rowbase, int rmax, int ld, int colg, int tid) {
    KVregs r; { int key = tid & 63; if (key > rmax) key = rmax; r.k = *(const u32x4*)(Kg + (rowbase + key) * ld + colg + (tid >> 6) * 8); }
    { int row = (tid >> 2) & 63; if (row > rmax) row = rmax; r.v = *(const u32x4*)(Vg + (rowbase + row) * ld + colg + (tid >> 8) * 32 + (tid & 3) * 8); }
    return r;
}
__device__ __forceinline__ void kv_store(unsigned char* Kb, unsigned char* Vb, const KVregs& r, int tid) {
    *(u32x4*)(Kb + (tid >> 6) * 1024 + (tid & 63) * 16) = r.k;
    *(u32x4*)(Vb + (tid >> 8) * 4096 + ((tid >> 2) & 63) * 64 + (tid & 3) * 16) = r.v;
}
__device__ __forceinline__ f32x16 qk_sub(const unsigned char* Kb, const bf16x8* qr, int sub, int r32, int hi) {
    f32x16 s = f32x16{};
#pragma unroll
    for (int d0 = 0; d0 < 4; ++d0) { const bf16x8 kf = *(const bf16x8*)(Kb + d0 * 2048 + hi * 1024 + (sub * 32 + r32) * 16); s = __builtin_amdgcn_mfma_f32_32x32x16_bf16(kf, qr[d0], s, 0, 0, 0); }
    return s;
}
__device__ __forceinline__ void pv_sub(f32x16* o, const unsigned char* Vb, const float* pv, int sub, int lane) {
    const int hi = lane >> 5;
    const unsigned char* vb = Vb + ((lane >> 4) & 1) * 32 + (lane & 3) * 8 + (4 * hi + ((lane & 15) >> 2)) * 64;
#pragma unroll
    for (int s2 = 0; s2 < 2; ++s2) { const u32x4 pk = pack8(pv + 8 * s2); const bf16x8 pf = __builtin_bit_cast(bf16x8, pk);
#pragma unroll
        for (int eb = 0; eb < 2; ++eb) { const unsigned char* a = vb + eb * 4096 + (2 * sub + s2) * 1024; const bf16x8 vf = cat8(tr16(a), tr16(a + 512));
            o[eb] = __builtin_amdgcn_mfma_f32_32x32x16_bf16(vf, pf, o[eb], 0, 0, 0); } }
}
__device__ __forceinline__ void attn_tile(const unsigned char* Kb, const unsigned char* Vb, const bf16x8* qr, const float* bt, int kp0, int qpos, bool isw, bool sel, float& m, float& l, f32x16* o, int lane) {
    const int r32 = lane & 31, hi = lane >> 5;
#pragma unroll 1
    for (int sub = 0; sub < 2; ++sub) {
        const int dist0 = qpos - kp0 - 32 * sub - 4 * hi;
        unsigned vm = 0;
#pragma unroll
        for (int r = 0; r < 16; ++r) { const int dist = dist0 - ((r & 3) + 8 * (r >> 2)); const bool ok = isw ? (dist >= 0 && dist < 512) : (sel && dist >= 0); vm |= ok ? (1u << r) : 0u; }
        if (__ballot(vm != 0) == 0ull) continue;
        f32x16 s = qk_sub(Kb, qr, sub, r32, hi);
        float mx = -1e30f;
#pragma unroll
        for (int r = 0; r < 16; ++r) { const int dist = dist0 - ((r & 3) + 8 * (r >> 2)); const int di = dist < 0 ? 0 : (dist > 127 ? 127 : dist);
            const float bv = bt[di]; const float sv = ((vm >> r) & 1u) ? s[r] + bv : -1e30f; s[r] = sv; mx = fmaxf(mx, sv); }
        mx = xhalf_max(mx);
        const float mn = fmaxf(m, mx), alpha = exp2f(m - mn);
        float pv[16]; float ps = 0.f;
#pragma unroll
        for (int r = 0; r < 16; ++r) { const float e = exp2f(s[r] - mn); pv[r] = ((vm >> r) & 1u) ? e : 0.f; ps += pv[r]; }
        l = l * alpha + ps; m = mn;
#pragma unroll
        for (int r = 0; r < 16; ++r) { o[0][r] *= alpha; o[1][r] *= alpha; }
        pv_sub(o, Vb, pv, sub, lane);
    }
}
__device__ __forceinline__ void attn_prompt_unit(const Params& p, unsigned char* lds, int b, int g, int i) {
    const int tid = threadIdx.x, lane = tid & 63, w = __builtin_amdgcn_readfirstlane(tid >> 6), r32 = lane & 31, hi = lane >> 5;
    const int hr = w >> 1, ql = (w & 1) * 32 + r32, qpos = 64 * i + ql, head = g * 4 + hr;
    const size_t row = (size_t)b * SEQ + qpos;
    float* imp = (float*)(lds + AT_IMP); float* imps = (float*)(lds + AT_IMPS); unsigned* mask = (unsigned*)(lds + AT_MASK); float* btab = (float*)(lds + AT_BTAB);
    const bf16_t* Qg = (const bf16_t*)(p.ws + WS_Q);
    for (int x = tid; x < 64 * 129; x += 512) imp[x] = 0.f;
    if (tid < 64) mask[tid] = (i < 16) ? 0xFFFFFFFFu : ((1u << 0) | (1u << i) | (1u << (i - 1)));
    btab[tid] = ((const float*)(p.ws + WS_BTAB))[(g * 4) * 128 + tid];
    bf16x8 qr[4];
#pragma unroll
    for (int d0 = 0; d0 < 4; ++d0) qr[d0] = *(const bf16x8*)(Qg + row * 512 + head * 64 + d0 * 16 + hi * 8);
    const float* gp = (const float*)(p.ws + WS_GATE) + row * 24 + head;
    const float g0 = gp[0], g1 = gp[8], g2 = gp[16];
    const float* bt = btab + hr * 128;
    f32x16 ot[2]; ot[0] = f32x16{}; ot[1] = f32x16{};
    unsigned char* Kb0 = lds + AT_K; unsigned char* Vb0 = lds + AT_V;
    {
        const bf16_t* CK = (const bf16_t*)(p.ws + WS_CKCP); const bf16_t* CV = (const bf16_t*)(p.ws + WS_CVCP);
#pragma unroll
        for (int t = 0; t < 2; ++t) { const KVregs kv = kv_load(CK, CV, (size_t)b * 128 + 64 * t, t ? 62 : 63, 128, g * 64, tid); kv_store(Kb0 + t * 8192, Vb0 + t * 8192, kv, tid); }
        __syncthreads();
        auto cmp_scores = [&](int t4) -> f32x16 {
            f32x16 sv = qk_sub(Kb0 + (t4 >> 1) * 8192, qr, t4 & 1, r32, hi);
#pragma unroll
            for (int r = 0; r < 16; ++r) { const int c = 32 * t4 + crow(r, hi); const int dist = qpos - (16 * c + 31); const int di = dist < 0 ? 0 : (dist > 127 ? 127 : dist);
                const float bv = bt[di]; sv[r] = (dist >= 0 && c < NC_P) ? sv[r] + bv : -1e30f; }
            return sv; };
        float mx = -1e30f;
#pragma unroll 1
        for (int t4 = 0; t4 < 4; ++t4) { const f32x16 sv = cmp_scores(t4);
#pragma unroll
            for (int r = 0; r < 16; ++r) mx = fmaxf(mx, sv[r]); }
        mx = xhalf_max(mx);
        float ps = 0.f;
#pragma unroll 1
        for (int t4 = 0; t4 < 4; ++t4) { const f32x16 sv = cmp_scores(t4);
#pragma unroll
            for (int r = 0; r < 16; ++r) ps += sv[r] > -1e29f ? exp2f(sv[r] - mx) : 0.f; }
        ps = xhalf_sum(ps);
        const float inv = ps > 0.f ? 1.f / ps : 0.f;
#pragma unroll 1
        for (int t4 = 0; t4 < 4; ++t4) { const f32x16 sv = cmp_scores(t4);
            float pv[16];
#pragma unroll
            for (int r = 0; r < 16; ++r) { const float pn = sv[r] > -1e29f ? exp2f(sv[r] - mx) * inv : 0.f; if (i >= 16 && pn > 0.f) atomicAdd(&imp[ql * 129 + 32 * t4 + crow(r, hi)], pn); pv[r] = pn * g0; }
            pv_sub(ot, Vb0 + (t4 >> 1) * 8192, pv, t4 & 1, lane);
        }
    }
    __syncthreads();
    if (i >= 16) {
        const int q = tid >> 3, jj = tid & 7, jmax = i - 2;
        for (int j = 1 + jj; j <= jmax; j += 8) { const float* ip = imp + q * 129 + 4 * j;
            imps[q * 33 + j] = 0.5f * ip[-1] + ip[0] + ip[1] + ip[2] + 0.5f * ip[3]; }
        __syncthreads();
        for (int j = 1 + jj; j <= jmax; j += 8) { const float vj = imps[q * 33 + j]; int cnt = 0;
            for (int k = 1; k <= jmax; ++k) { const float vk = imps[q * 33 + k]; cnt += (vk > vj || (vk == vj && k < j)) ? 1 : 0; }
            if (cnt < 13) atomicOr(&mask[q], 1u << j); }
        __syncthreads();
    }
    const unsigned selm = mask[ql];
    {
        const bf16_t* KSg = (const bf16_t*)(p.ws + WS_KS); const bf16_t* VSg = (const bf16_t*)(p.ws + WS_VS);
        const bf16_t* KWg = (const bf16_t*)(p.ws + WS_KW); const bf16_t* VWg = (const bf16_t*)(p.ws + WS_VW);
        const int nts = i + 1, t0w = i > 8 ? i - 8 : 0, NT = nts + (i - t0w + 1);
        float m = -1e30f, l = 0.f; f32x16 o[2]; o[0] = f32x16{}; o[1] = f32x16{};
        { const KVregs kv = kv_load(KSg, VSg, (size_t)b * SEQ, 63, 128, g * 64, tid); kv_store(Kb0, Vb0, kv, tid); }
#pragma unroll 1
        for (int t = 0; t < NT; ++t) {
            __syncthreads();
            KVregs nx; const bool more = t + 1 < NT;
            if (more) { const int tn = t + 1; const bool wn = tn >= nts; const int jn = wn ? t0w + tn - nts : tn;
                nx = kv_load(wn ? KWg : KSg, wn ? VWg : VSg, (size_t)b * SEQ + 64 * jn, 63, 128, g * 64, tid); }
            const bool isw = t >= nts; const int j = isw ? t0w + t - nts : t;
            if (t == nts) { l = xhalf_sum(l); const float sc = l > 0.f ? g1 / l : 0.f;
#pragma unroll
                for (int r = 0; r < 16; ++r) { ot[0][r] += sc * o[0][r]; ot[1][r] += sc * o[1][r]; o[0][r] = 0.f; o[1][r] = 0.f; }
                m = -1e30f; l = 0.f; }
            attn_tile(Kb0 + (t & 1) * 8192, Vb0 + (t & 1) * 8192, qr, bt, 64 * j, qpos, isw, (selm >> (j & 31)) & 1u, m, l, o, lane);
            if (more) kv_store(Kb0 + ((t + 1) & 1) * 8192, Vb0 + ((t + 1) & 1) * 8192, nx, tid);
        }
        l = xhalf_sum(l); const float sc = l > 0.f ? g2 / l : 0.f;
#pragma unroll
        for (int r = 0; r < 16; ++r) { ot[0][r] += sc * o[0][r]; ot[1][r] += sc * o[1][r]; }
    }
    bf16_t* AO = (bf16_t*)(p.ws + WS_AO) + row * 1024 + head * 64;
#pragma unroll
    for (int eb = 0; eb < 2; ++eb)
#pragma unroll
        for (int a = 0; a < 4; ++a) { u32x2 ov; ov.x = pk2(ot[eb][4 * a], ot[eb][4 * a + 1]); ov.y = pk2(ot[eb][4 * a + 2], ot[eb][4 * a + 3]); *(u32x2*)(AO + 32 * eb + 8 * a + 4 * hi) = ov; }
    __syncthreads();
}

constexpr int SA_Q = 0, SA_SC = 256, SA_IMP = SA_SC + 4096, SA_IMPS = SA_IMP + 1024, SA_SEL = SA_IMPS + 256, SA_ML = SA_SEL + 16, SA_OB = SA_ML + 8, SA_OT = SA_OB + 512, SA_END = SA_OT + 256;
__device__ __forceinline__ void dot4_f32(const float* key, const float* q, float* a) {
#pragma unroll 2
    for (int d = 0; d < 64; d += 4) { const f32x4 kv = *(const f32x4*)(key + d);
#pragma unroll
        for (int r = 0; r < 4; ++r) { const f32x4 qv = *(const f32x4*)(q + r * 64 + d); a[r] += kv[0] * qv[0] + kv[1] * qv[1] + kv[2] * qv[2] + kv[3] * qv[3]; } }
}
__device__ __forceinline__ void dot4_bf16(const bf16_t* key, const float* q, float* a) {
#pragma unroll 2
    for (int d = 0; d < 64; d += 8) { const u32x4 kw = *(const u32x4*)(key + d); const float kf[8] = {bflo(kw.x), bfhi(kw.x), bflo(kw.y), bfhi(kw.y), bflo(kw.z), bfhi(kw.z), bflo(kw.w), bfhi(kw.w)};
#pragma unroll
        for (int r = 0; r < 4; ++r) { const f32x4 q0 = *(const f32x4*)(q + r * 64 + d), q1 = *(const f32x4*)(q + r * 64 + d + 4);
            a[r] += kf[0] * q0[0] + kf[1] * q0[1] + kf[2] * q0[2] + kf[3] * q0[3] + kf[4] * q1[0] + kf[5] * q1[1] + kf[6] * q1[2] + kf[7] * q1[3]; } }
}
struct Slot { const float* kf; const float* vf; const bf16_t* kb; const bf16_t* vb; int dist; bool valid; };
template <int BR>
__device__ __forceinline__ Slot sa_slot(const Params& p, int b, int g, int slot, const int* sel, const int* selb) {
    Slot s; s.kf = nullptr; s.vf = nullptr; s.kb = nullptr; s.vb = nullptr; s.valid = true; s.dist = 0;
    const size_t row = (size_t)MP + b;
    if (BR == 0) { const size_t off = ((size_t)(b * 1024 + slot) * 2 + g) * 64; s.kb = (const bf16_t*)(p.ws + WS_CKCS) + off; s.vb = (const bf16_t*)(p.ws + WS_CVCS) + off; s.dist = PAST - (16 * slot + 31); }
    else if (BR == 1) { const int blk = sel[slot >> 6], kk = slot & 63, pos = 64 * blk + kk;
        if (blk == 256) { s.valid = (kk == 0); s.kb = (const bf16_t*)(p.ws + WS_KS) + row * 128 + g * 64; s.vb = (const bf16_t*)(p.ws + WS_VS) + row * 128 + g * 64; s.dist = 0; }
        else { const size_t off = (size_t)selb[slot >> 6] + (size_t)kk * 128; s.kf = p.in[4] + off; s.vf = p.in[5] + off; s.dist = PAST - pos; } }
    else { const int j = slot + 1;
        if (j == 512) { s.kb = (const bf16_t*)(p.ws + WS_KW) + row * 128 + g * 64; s.vb = (const bf16_t*)(p.ws + WS_VW) + row * 128 + g * 64; s.dist = 0; }
        else { const size_t off = (((size_t)b * 512 + j) * 2 + g) * 64; s.kf = p.in[6] + off; s.vf = p.in[7] + off; s.dist = 512 - j; } }
    return s;
}
template <int BR>
__device__ __forceinline__ void sa_branch(const Params& p, float* L, int b, int g, int nslots, const float* btg, const float* gates  ) {
    const int tid = threadIdx.x, lane = tid & 63, w = tid >> 6;
    float* q = L + SA_Q; float* sc = L + SA_SC; float* ml = L + SA_ML; float* ob = L + SA_OB; float* ot = L + SA_OT; const int* sel = (const int*)(L + SA_SEL);
    for (int slot = tid; slot < nslots; slot += 512) {
        const Slot s = sa_slot<BR>(p, b, g, slot, sel, (const int*)(L + SA_IMPS)); float a[4] = {0.f, 0.f, 0.f, 0.f};
        if (s.valid) { if (s.kf) dot4_f32(s.kf, q, a); else dot4_bf16(s.kb, q, a); }
        const int di = s.dist > 127 ? 127 : s.dist;
#pragma unroll
        for (int r = 0; r < 4; ++r) sc[r * 1024 + slot] = s.valid ? a[r] + btg[r * 128 + di] : -1e30f;
    }
    __syncthreads();
    if (w < 4) { float mx = -1e30f;
        for (int s = lane; s < nslots; s += 64) mx = fmaxf(mx, sc[w * 1024 + s]);
#pragma unroll
        for (int of = 1; of < 64; of <<= 1) mx = fmaxf(mx, __shfl_xor(mx, of));
        float sum = 0.f;
        for (int s = lane; s < nslots; s += 64) { const float v = sc[w * 1024 + s]; const float e = v > -1e29f ? exp2f(v - mx) : 0.f; sc[w * 1024 + s] = e; sum += e; }
#pragma unroll
        for (int of = 1; of < 64; of <<= 1) sum += __shfl_xor(sum, of);
        const float inv = sum > 0.f ? 1.f / sum : 0.f;
        for (int s = lane; s < nslots; s += 64) sc[w * 1024 + s] *= inv;
    }
    __syncthreads();
    { const int half = tid >> 8, r = (tid >> 6) & 3, e = tid & 63; float acc = 0.f; const float* pr = sc + r * 1024;
      const size_t row = (size_t)MP + b;
      if (BR == 0) { const bf16_t* vb = (const bf16_t*)(p.ws + WS_CVCS) + ((size_t)(b * 1024) * 2 + g) * 64 + e;
          const int s0 = half ? 512 : 0, s1 = half ? nslots : 512;
#pragma unroll 8
          for (int slot = s0; slot < s1; ++slot) acc += pr[slot] * bf1(vb[(size_t)slot * 128]); }
      else if (BR == 2) { const float* vf = p.in[7] + (((size_t)b * 512 + 1) * 2 + g) * 64 + e;
          const int s0 = half ? 256 : 0, s1 = half ? 511 : 256;
#pragma unroll 8
          for (int slot = s0; slot < s1; ++slot) acc += pr[slot] * vf[(size_t)slot * 128];
          if (half) acc += pr[511] * bf1(((const bf16_t*)(p.ws + WS_VW))[row * 128 + g * 64 + e]); }
      else { const int* selb = (const int*)(L + SA_IMPS);
          for (int si = half * 8; si < half * 8 + 8; ++si) {
              if (sel[si] == 256) acc += pr[si * 64] * bf1(((const bf16_t*)(p.ws + WS_VS))[row * 128 + g * 64 + e]);
              else { const float* vf = p.in[5] + (size_t)selb[si] + e;
#pragma unroll 8
                  for (int kk = 0; kk < 64; ++kk) acc += pr[si * 64 + kk] * vf[(size_t)kk * 128]; } } }
      ob[(half * 4 + r) * 64 + e] = acc; }
    __syncthreads();
    if (tid < 256) { const int r = tid >> 6; ot[tid] += gates[r] * (ob[tid] + ob[256 + tid]); }
    __syncthreads();
    (void)ml;
}
__device__ __forceinline__ void attn_sample_unit(const Params& p, unsigned char* lds, int b, int g) {
    const int tid = threadIdx.x;
    float* L = (float*)lds; float* q = L + SA_Q; float* sc = L + SA_SC; float* imp = L + SA_IMP; float* imps = L + SA_IMPS; int* sel = (int*)(L + SA_SEL); float* ot = L + SA_OT; float* gsh = L + SA_ML;
    const size_t row = (size_t)MP + b;
    if (tid < 256) { q[tid] = bf1(((const bf16_t*)(p.ws + WS_Q))[row * 512 + g * 256 + tid]); ot[tid] = 0.f; }
    __syncthreads();
    const float* btg = (const float*)(p.ws + WS_BTAB) + (g * 4) * 128;
    const float* GT = (const float*)(p.ws + WS_GATE) + row * 24 + g * 4;
    sa_branch<0>(p, L, b, g, NC_S, btg, GT);
    for (int c = tid; c < NC_S; c += 512) imp[c] = sc[c] + sc[1024 + c] + sc[2048 + c] + sc[3072 + c];
    __syncthreads();
    if (tid >= 1 && tid <= 254) { const int j = tid; imps[j] = 0.5f * imp[4 * j - 1] + imp[4 * j] + imp[4 * j + 1] + imp[4 * j + 2] + 0.5f * imp[4 * j + 3]; }
    if (tid == 0) { sel[0] = 0; sel[1] = 255; sel[2] = 256; }
    __syncthreads();
    if (tid >= 1 && tid <= 254) { const float vj = imps[tid]; int cnt = 0;
        for (int k = 1; k <= 254; ++k) { const float vk = imps[k]; cnt += (vk > vj || (vk == vj && k < tid)) ? 1 : 0; }
        if (cnt < 13) sel[3 + cnt] = tid; }
    __syncthreads();
    if (tid < 16) { const int blk = sel[tid]; int off = 0;
        if (blk < 256) { const int page = p.page_table[b * NPAGES + (blk >> 1)]; off = ((page * PAGE + (blk & 1) * 64) * 2 + g) * 64; }
        ((int*)imps)[tid] = off; }
    __syncthreads();
    sa_branch<1>(p, L, b, g, 1024, btg, GT + 8);
    sa_branch<2>(p, L, b, g, 512, btg, GT + 16);
    if (tid < 256) { const unsigned pk = pk2(ot[tid], 0.f); ((bf16_t*)(p.ws + WS_AO))[row * 1024 + g * 256 + tid] = (bf16_t)(pk & 0xffffu); }
    __syncthreads();
    (void)gsh;
}

constexpr int LDS_BYTES = pg8::STAGE_BYTES + 256;
constexpr int NPHASE = 9;
__global__ void __launch_bounds__(512, 2) nsa_ret_fwd(Params p) {
    extern __shared__ __attribute__((aligned(16))) unsigned char lds[];
    const int tid = threadIdx.x, bid = blockIdx.x, G = gridDim.x;
    const int wv = __builtin_amdgcn_readfirstlane(tid >> 6);
    unsigned char* ws = p.ws;
    if (tid < 4) ((LAS unsigned*)(lds + pg8::STAGE_BYTES))[tid] = 0u;
    __syncthreads();
    const bool fused = (p.ph_hi - p.ph_lo) > 1;
    XcdBarrier bar; bar.bar = (unsigned*)(ws + WS_CTL); bar.x = 0; bar.st = (volatile LAS unsigned*)(lds + pg8::STAGE_BYTES);
    if (fused) bar = xcd_barrier_post((unsigned*)(ws + WS_CTL), (volatile LAS unsigned*)(lds + pg8::STAGE_BYTES));
#ifdef ONLY_PHASE
#define PH_ON(k) ((k) == ONLY_PHASE && p.ph_lo <= (k) && (k) < p.ph_hi)
#else
#define PH_ON(k) (p.ph_lo <= (k) && (k) < p.ph_hi)
#endif
#define SEAM(k) do { if (PH_ON(k) && PH_ON((k) + 1)) xcd_barrier(bar); } while (0)
    if (PH_ON(0)) phase_prologue(p, lds);
    SEAM(0);
    if (PH_ON(1)) {
        pg8::Gemm g{(const bf16_t*)(ws + WS_XB), (const bf16_t*)(ws + WS_W1), MR, N1, DM};
        {   SubsetOrder S; S.init(MR, 7 * 256, G, bid); S.set = 0;
            EpiProj<0> E; E.ss1 = (const float*)(ws + WS_SS1); E.qn = p.in[14]; E.kn = p.in[15]; E.rot = (const float*)(ws + WS_ROT);
            E.Q = (bf16_t*)(ws + WS_Q); E.CA = (bf16_t*)(ws + WS_CA); E.KS = (bf16_t*)(ws + WS_KS); E.VS = (bf16_t*)(ws + WS_VS); E.KW = (bf16_t*)(ws + WS_KW); E.VW = (bf16_t*)(ws + WS_VW);
            E.RQ = (bf16_t*)(ws + WS_RQ); E.RK = (bf16_t*)(ws + WS_RK); E.RV = (bf16_t*)(ws + WS_RV); E.RG = (bf16_t*)(ws + WS_RG); E.GATE = (float*)(ws + WS_GATE); E.out = p.out;
            pg8::gemm_phase((LAS unsigned char*)lds, g, S, E); }
        {   SubsetOrder S; S.init(MR, 7 * 256, G, bid); S.set = 1;
            EpiProj<1> E; E.ss1 = (const float*)(ws + WS_SS1); E.qn = p.in[14]; E.kn = p.in[15]; E.rot = (const float*)(ws + WS_ROT);
            E.Q = (bf16_t*)(ws + WS_Q); E.CA = (bf16_t*)(ws + WS_CA); E.KS = (bf16_t*)(ws + WS_KS); E.VS = (bf16_t*)(ws + WS_VS); E.KW = (bf16_t*)(ws + WS_KW); E.VW = (bf16_t*)(ws + WS_VW);
            E.RQ = (bf16_t*)(ws + WS_RQ); E.RK = (bf16_t*)(ws + WS_RK); E.RV = (bf16_t*)(ws + WS_RV); E.RG = (bf16_t*)(ws + WS_RG); E.GATE = (float*)(ws + WS_GATE); E.out = p.out;
            pg8::gemm_phase((LAS unsigned char*)lds, g, S, E); }
    }
    SEAM(1);
    if (PH_ON(2)) {
#ifndef NO_P2A
        { pg8::Gemm g{(const bf16_t*)(ws + WS_CA), (const bf16_t*)(ws + WS_W1C), 2 * CROWS, 256, 1024};
          CmpOrder S; S.G = G; S.c = bid; EpiCmp E; E.C = (float*)(ws + WS_CP);
          pg8::gemm_phase((LAS unsigned char*)lds, g, S, E); }
#endif
        __syncthreads();
#ifndef NO_P2B
        for (int u = bid; u < NB * 4 * 16; u += G) ret_r1_unit(p, lds, u >> 6, (u >> 4) & 3, u & 15);
#endif
#ifndef NO_P2C
        for (int u = bid; u < DB * 4; u += G) ret_sample_unit(p, lds, u >> 2, u & 3);
#endif
    }
    SEAM(2);
    if (PH_ON(3)) {
        for (int u = bid; u < NB * 4 * 16; u += G) ret_r2_unit(p, lds, u >> 6, (u >> 4) & 3, u & 15);
        constexpr int NT = CROWS / 32;
        for (int t = bid * 8 + wv; t < 2 * NT; t += G * 8) compress2_task(p, t / NT, t % NT, tid & 63);
        pret_job(p);
    }
    SEAM(3);
    if (PH_ON(4)) {
#ifndef NO_P4A
        for (int v = bid; v < 256; v += G) { const int bg = v >> 4, s = v & 15;
            attn_prompt_unit(p, lds, bg >> 1, bg & 1, s);
            attn_prompt_unit(p, lds, bg >> 1, bg & 1, 31 - s); }
#endif
#ifndef NO_P4B
        for (int u = bid; u < DB * 2; u += G) attn_sample_unit(p, lds, u >> 1, u & 1);
#endif
    }
    SEAM(4);
    if (PH_ON(5)) {
        pg8::Gemm g{(const bf16_t*)(ws + WS_AO), (const bf16_t*)(ws + WS_WO), MR, DM, DM};
        pg8::StaticOrder S; S.init(MR, DM, G, bid);
        EpiOut E; E.xp = p.in[0]; E.xs = p.in[1]; E.H = (float*)(ws + WS_H); E.HB = (bf16_t*)(ws + WS_HB); E.SS2 = (float*)(ws + WS_SS2);
        pg8::gemm_phase((LAS unsigned char*)lds, g, S, E);
    }
    SEAM(5);
    if (PH_ON(6)) {
        pg8::Gemm g{(const bf16_t*)(ws + WS_HB), (const bf16_t*)(ws + WS_WGU), MR, NGU, DM};
        pg8::StaticOrder S; S.init(MR, NGU, G, bid);
        EpiGU E; E.SS2 = (const float*)(ws + WS_SS2); E.ACT = (bf16_t*)(ws + WS_ACT);
        pg8::gemm_phase((LAS unsigned char*)lds, g, S, E);
    }
    SEAM(6);
    if (PH_ON(7)) {
        { pg8::Gemm g{(const bf16_t*)(ws + WS_ACT), (const bf16_t*)(ws + WS_WD), MR, DM, DFF};
          pg8::StaticOrder S; S.init(MR, DM, G, bid);
          EpiDown E; E.H = (const float*)(ws + WS_H); E.H2 = (float*)(ws + WS_H2); E.H2B = (bf16_t*)(ws + WS_H2B);
          pg8::gemm_phase((LAS unsigned char*)lds, g, S, E); }
        { pg8::Gemm g{(const bf16_t*)(ws + WS_PB), (const bf16_t*)(ws + WS_WPP), MR, DM, PLE};
          pg8::StaticOrder S; S.init(MR, DM, G, bid);
          EpiF32 E; E.C = (float*)(ws + WS_VP); E.ld = DM;
          pg8::gemm_phase((LAS unsigned char*)lds, g, S, E); }
    }
    SEAM(7);
    if (PH_ON(8)) {
        pg8::Gemm g{(const bf16_t*)(ws + WS_H2B), (const bf16_t*)(ws + WS_WPG), MR, DM, DM};
        pg8::StaticOrder S; S.init(MR, DM, G, bid);
        EpiFinal E; E.H2 = (const float*)(ws + WS_H2); E.VP = (const float*)(ws + WS_VP); E.out = p.out;
        pg8::gemm_phase((LAS unsigned char*)lds, g, S, E);
    }
}

extern "C" void kernel_launch(void* const* d_in, const int* in_sizes, int n_in, void* d_out, int out_size, void* d_ws, size_t ws_size, hipStream_t stream) {
    static int grid = 0;
    if (grid == 0) {
        if (n_in != 31 || (size_t)out_size != O_END || ws_size < WS_END) { fprintf(stderr, "kernel_launch: unexpected shapes: n_in %d out %d ws %zu (need %zu)\n", n_in, out_size, ws_size, (size_t)WS_END); grid = -1; return; }
        int dev = 0, cus = 0;
        if (hipGetDevice(&dev) != hipSuccess || hipDeviceGetAttribute(&cus, hipDeviceAttributeMultiprocessorCount, dev) != hipSuccess) { grid = -1; return; }
        if (hipFuncSetAttribute((const void*)nsa_ret_fwd, hipFuncAttributeMaxDynamicSharedMemorySize, LDS_BYTES) != hipSuccess) { fprintf(stderr, "kernel_launch: hipFuncSetAttribute failed\n"); grid = -1; return; }
        int per_cu = 0;
        if (hipOccupancyMaxActiveBlocksPerMultiprocessor(&per_cu, (const void*)nsa_ret_fwd, 512, LDS_BYTES) != hipSuccess || per_cu < 1) { fprintf(stderr, "kernel_launch: occupancy query says %d blocks per CU\n", per_cu); }
        (void)hipGetLastError();
        grid = cus;
    }
    if (grid < 0) return;
    (void)hipMemsetAsync((char*)d_ws + WS_CTL, 0, CTL_BYTES, stream);
    Params p; memset(&p, 0, sizeof(p));
    for (int i = 0; i < 31; ++i) p.in[i] = (const float*)d_in[i];
    p.page_table = (const int*)d_in[9]; p.out = (float*)d_out; p.ws = (unsigned char*)d_ws;
#if MK_PER_PHASE_LAUNCH
    for (int ph = 0; ph < NPHASE; ++ph) { p.ph_lo = ph; p.ph_hi = ph + 1; hipLaunchKernelGGL(nsa_ret_fwd, dim3(grid), dim3(512), LDS_BYTES, stream, p); }
#else
    p.ph_lo = 0; p.ph_hi = NPHASE; hipLaunchKernelGGL(nsa_ret_fwd, dim3(grid), dim3(512), LDS_BYTES, stream, p);
#endif
}
```

```cpp
#include <hip/hip_runtime.h>
#include <cstdio>
#include <cstdint>
#include <cstring>

#ifndef MK_PER_PHASE_LAUNCH
#define MK_PER_PHASE_LAUNCH 0
#endif

constexpr int DM = 1024, NB = 8, SEQ = 2048, DB = 32, PAST = 16384, PAGE = 128, NPAGES = 128;
constexpr int MP = NB * SEQ;
constexpr int MV = MP + DB;
constexpr int MR = 16640;
constexpr int INC = 3352, N1 = 3584, DFF = 2816, NGU = 5632, PLE = 256;
constexpr int NSEG_S = 1024, NSEG_P = 128;
constexpr int CROWS_S = DB * NSEG_S * 2;
constexpr int CROWS_P = NB * NSEG_P * 2;
constexpr int CROWS = CROWS_S + CROWS_P;
constexpr int NC_P = 127, NC_S = 1023;
constexpr float EPS = 1e-6f;
constexpr float LOG2E = 1.4426950408889634f;

constexpr size_t O_YP = 0, O_YS = O_YP + (size_t)MP * DM, O_PCK = O_YS + (size_t)DB * DM, O_PCV = O_PCK + (size_t)MP * 128, O_PSK = O_PCV + (size_t)MP * 128,
                 O_PSV = O_PSK + (size_t)MP * 128, O_PWK = O_PSV + (size_t)MP * 128, O_PWV = O_PWK + (size_t)NB * 512 * 128, O_PRET = O_PWV + (size_t)NB * 512 * 128,
                 O_SCK = O_PRET + (size_t)NB * 4 * 128 * 128, O_SCV = O_SCK + DB * 128, O_SSK = O_SCV + DB * 128, O_SSV = O_SSK + DB * 128, O_SWK = O_SSV + DB * 128,
                 O_SWV = O_SWK + (size_t)DB * 512 * 128, O_SRET = O_SWV + (size_t)DB * 512 * 128, O_END = O_SRET + (size_t)DB * 4 * 128 * 128;

constexpr size_t al256(size_t x) { return (x + 255) & ~(size_t)255; }
constexpr size_t WS_CTL = 0, CTL_BYTES = 16384;
constexpr size_t WS_W1 = WS_CTL + CTL_BYTES;
constexpr size_t WS_WO = WS_W1 + (size_t)N1 * DM * 2;
constexpr size_t WS_WGU = WS_WO + (size_t)DM * DM * 2;
constexpr size_t WS_WD = WS_WGU + (size_t)NGU * DM * 2;
constexpr size_t WS_WPG = WS_WD + (size_t)DM * DFF * 2;
constexpr size_t WS_WPP = WS_WPG + (size_t)DM * DM * 2;
constexpr size_t WS_W1C = WS_WPP + (size_t)DM * PLE * 2;
constexpr size_t WS_W2C = WS_W1C + (size_t)2 * 256 * 1024 * 2;
constexpr size_t WS_BIASC = WS_CTL + 14336;
constexpr size_t WS_QUEUE = WS_CTL + 15360;
constexpr size_t WS_BTAB = WS_W2C + (size_t)2 * 64 * 128 * 2;
constexpr size_t WS_ROT = WS_BTAB + 4096;
constexpr size_t WS_SS1 = al256(WS_ROT + (size_t)2049 * 64 * 8);
constexpr size_t WS_SS2 = WS_SS1 + (size_t)MR * 4;
constexpr size_t WS_XB = al256(WS_SS2 + (size_t)MR * 4);
constexpr size_t WS_PB = WS_XB + (size_t)MR * DM * 2;
constexpr size_t WS_Q = WS_PB + (size_t)MR * PLE * 2;
constexpr size_t WS_KS = WS_Q + (size_t)MR * 512 * 2;
constexpr size_t WS_VS = WS_KS + (size_t)MR * 128 * 2;
constexpr size_t WS_KW = WS_VS + (size_t)MR * 128 * 2;
constexpr size_t WS_VW = WS_KW + (size_t)MR * 128 * 2;
constexpr size_t WS_RQ = WS_VW + (size_t)MR * 128 * 2;
constexpr size_t WS_RK = WS_RQ + (size_t)MR * 512 * 2;
constexpr size_t WS_RV = WS_RK + (size_t)MR * 512 * 2;
constexpr size_t WS_RG = WS_RV + (size_t)MR * 512 * 2;
constexpr size_t WS_GATE = WS_RG + (size_t)MR * 512 * 2;
constexpr size_t WS_CA = al256(WS_GATE + (size_t)MR * 24 * 4);
constexpr size_t WS_CP = WS_CA + (size_t)2 * CROWS * 1024 * 2;
constexpr size_t WS_CKCP = WS_CP + (size_t)2 * CROWS * 256 * 4;
constexpr size_t WS_CVCP = WS_CKCP + (size_t)NB * 128 * 128 * 2;
constexpr size_t WS_CKCS = WS_CVCP + (size_t)NB * 128 * 128 * 2;
constexpr size_t WS_CVCS = WS_CKCS + (size_t)DB * 1024 * 128 * 2;
constexpr size_t WS_KVT = WS_CVCS + (size_t)DB * 1024 * 128 * 2;
constexpr size_t WS_AO = WS_KVT + (size_t)NB * 4 * 16 * 16384 * 4;
constexpr size_t WS_H = WS_AO + (size_t)MR * DM * 2;
constexpr size_t WS_HB = WS_H + (size_t)MR * DM * 4;
constexpr size_t WS_ACT = WS_HB + (size_t)MR * DM * 2;
constexpr size_t WS_H2 = WS_ACT + (size_t)MR * DFF * 2;
constexpr size_t WS_H2B = WS_H2 + (size_t)MR * DM * 4;
constexpr size_t WS_VP = WS_H2B + (size_t)MR * DM * 2;
constexpr size_t WS_END = WS_VP + (size_t)MR * DM * 4;

typedef unsigned short bf16_t;
typedef short bf16x8 __attribute__((ext_vector_type(8)));
typedef short s16x4 __attribute__((ext_vector_type(4)));
typedef float f32x4 __attribute__((ext_vector_type(4)));
typedef float f32x16 __attribute__((ext_vector_type(16)));
typedef unsigned u32x4 __attribute__((ext_vector_type(4)));
typedef unsigned u32x2 __attribute__((ext_vector_type(2)));
typedef float f32x2_t __attribute__((ext_vector_type(2)));
typedef __bf16 bf16x2_t __attribute__((ext_vector_type(2)));
#define LAS __attribute__((address_space(3)))

__device__ __forceinline__ unsigned pk2(float lo, float hi) { f32x2_t v = {lo, hi}; bf16x2_t b = __builtin_convertvector(v, bf16x2_t); return __builtin_bit_cast(unsigned, b); }
__device__ __forceinline__ float bflo(unsigned w) { return __uint_as_float(w << 16); }
__device__ __forceinline__ float bfhi(unsigned w) { return __uint_as_float(w & 0xffff0000u); }
__device__ __forceinline__ float bf1(bf16_t b) { return __uint_as_float(((unsigned)b) << 16); }
__device__ __forceinline__ float sigmoidf_(float x) { return 1.f / (1.f + __expf(-x)); }
__device__ __forceinline__ float siluf_(float x) { return x / (1.f + __expf(-x)); }
__device__ __forceinline__ int crow(int r, int hi) { return (r & 3) + 8 * (r >> 2) + 4 * hi; }
__device__ __forceinline__ float xhalf_max(float v) { auto rr = __builtin_amdgcn_permlane32_swap(__float_as_uint(v), __float_as_uint(v), false, false); return fmaxf(__uint_as_float(rr[0]), __uint_as_float(rr[1])); }
__device__ __forceinline__ float xhalf_sum(float v) { auto rr = __builtin_amdgcn_permlane32_swap(__float_as_uint(v), __float_as_uint(v), false, false); return __uint_as_float(rr[0]) + __uint_as_float(rr[1]); }

struct Params {
    const float* in[31];
    const int* page_table;
    float* out;
    unsigned char* ws;
    int ph_lo, ph_hi;
};

#define XB_TMO      128
#define XB_XCNT(j)  (256  + 64 * (j))
#define XB_XSUB(j)  (1280 + 64 * (j))
#define XB_XGEN(j)  (2304 + 64 * (j))
#define XB_TOP      3328
#define XB_TOPGEN   3392
#define XCD_BAR_WORDS 3456
#define XB_SPIN_CAP (1u << 18)
__device__ __forceinline__ unsigned xb_ld(unsigned* p)              { return __hip_atomic_load(p, __ATOMIC_RELAXED, __HIP_MEMORY_SCOPE_AGENT); }
__device__ __forceinline__ unsigned xb_add(unsigned* p, unsigned v) { return __hip_atomic_fetch_add(p, v, __ATOMIC_RELAXED, __HIP_MEMORY_SCOPE_AGENT); }
__device__ __forceinline__ unsigned xb_xcc_id() { return (unsigned)__builtin_amdgcn_s_getreg((3 << 11) | 20) & 0xFu; }
#define XB_SPIN(cond, bar) do { unsigned _sp = 0; while (cond) { __builtin_amdgcn_s_sleep(1); \
    if ((++_sp & 255u) == 0u) { if (xb_ld(&(bar)[XB_TMO])) break; if (_sp > XB_SPIN_CAP) { atomicAdd(&(bar)[XB_TMO], 1u); break; } } } } while (0)
struct XcdBarrier { unsigned* bar; unsigned x; volatile LAS unsigned* st; };
__device__ __forceinline__ XcdBarrier xcd_barrier_post(unsigned* bar, volatile LAS unsigned* st) {
    XcdBarrier b; b.bar = bar; b.x = xb_xcc_id(); b.st = st;
    if (threadIdx.x == 0) (void)xb_add(&bar[XB_XCNT(b.x)], 1u);
    return b;
}
__device__ __forceinline__ void xcd_barrier_complete(unsigned* bar, unsigned x, unsigned& nloc, unsigned& nx) {
    const unsigned G = gridDim.x * gridDim.y * gridDim.z;
    unsigned sum, cnt, mine, sp = 0u;
    for (;;) {
        sum = 0u; cnt = 0u; mine = 0u;
#pragma unroll
        for (unsigned j = 0; j < 16; ++j) { const unsigned c = xb_ld(&bar[XB_XCNT(j)]); sum += c; cnt += (c > 0u) ? 1u : 0u; mine = (j == x) ? c : mine; }
        if (sum == G) break;
        __builtin_amdgcn_s_sleep(1);
        if ((++sp & 255u) == 0u) { if (xb_ld(&bar[XB_TMO])) break; if (sp > XB_SPIN_CAP) { atomicAdd(&bar[XB_TMO], 1u); break; } }
    }
    nloc = mine > 0u ? mine : 1u; nx = cnt > 0u ? cnt : 1u;
}
__device__ __forceinline__ void xcd_barrier(const XcdBarrier& b) {
    asm volatile("s_waitcnt vmcnt(0)" ::: "memory");
    __syncthreads();
    if (threadIdx.x == 0) {
        unsigned* bar = b.bar;
        __builtin_amdgcn_s_waitcnt(0);
        unsigned nloc = b.st[0], nx = b.st[1];
        if (nloc == 0u) { xcd_barrier_complete(bar, b.x, nloc, nx); b.st[0] = nloc; b.st[1] = nx; }
        const unsigned old = xb_add(&bar[XB_XSUB(b.x)], 1u);
        const unsigned gen = old / nloc;
        if (old + 1u == (gen + 1u) * nloc) {
            __builtin_amdgcn_fence(__ATOMIC_RELEASE, "agent");
            asm volatile("s_waitcnt vmcnt(0)" ::: "memory");
            const unsigned og = xb_add(&bar[XB_TOP], 1u);
            const unsigned tg = og / nx;
            if (og + 1u == (tg + 1u) * nx) xb_add(&bar[XB_TOPGEN], 1u);
            else XB_SPIN(xb_ld(&bar[XB_TOPGEN]) == tg, bar);
            __builtin_amdgcn_fence(__ATOMIC_ACQUIRE, "agent");
            xb_add(&bar[XB_XGEN(b.x)], 1u);
            asm volatile("s_waitcnt vmcnt(0)" ::: "memory");
        } else {
            XB_SPIN(xb_ld(&bar[XB_XGEN(b.x)]) == gen, bar);
            __builtin_amdgcn_fence(__ATOMIC_ACQUIRE, "agent");
            asm volatile("s_waitcnt vmcnt(0)" ::: "memory");
        }
    }
    __syncthreads();
}

namespace pg8 {
constexpr int BM = 256, BK = 64, HALF = 128, HTB = HALF * BK * 2, STAGE_BYTES = 8 * HTB, NXCD = 8, WGM = 8;
__host__ __device__ __forceinline__ int lds_byte(int r, int c) { const int st = (r >> 4) * 2 + (c >> 5), rr = r & 15, cc = c & 31, ob = rr * 64 + cc * 2; return st * 1024 + (ob ^ (((ob >> 9) & 1) << 5)); }
__host__ __device__ __forceinline__ void stage_rc(int b, int& R, int& C) { const int st = b / 1024, sb = b % 1024, swz = sb ^ (((sb >> 9) & 1) << 5); R = (st >> 1) * 16 + swz / 64; C = (st & 1) * 32 + (swz % 64) / 2; }
__host__ __device__ __forceinline__ int perm32(int rho) { const int n = rho >> 4, i = rho & 15; return 8 * (i >> 2) + 4 * n + (i & 3); }
struct Unit { int pm, pn; };
struct Gemm { const bf16_t* A; const bf16_t* Bt; int M, N, K; };
struct StaticOrder {
    int nM, nN, nwg, G, c;
    __host__ __device__ void init(int M, int N, int G_, int c_) { nM = M / BM; nN = N / BM; nwg = nM * nN; G = G_; c = c_; }
    __host__ __device__ bool next(int i, Unit& u) const {
        const long L = (long)i * G + c; if (L >= nwg) return false;
        int wgid = (int)L; { const int q = nwg / NXCD, r = nwg % NXCD, xcd = wgid % NXCD, off = wgid / NXCD; wgid = (xcd < r ? xcd * (q + 1) : r * (q + 1) + (xcd - r) * q) + off; }
        const int nig = WGM * nN, gid = wgid / nig, fm = gid * WGM, gsz = (nM - fm) < WGM ? (nM - fm) : WGM;
        u.pm = fm + ((wgid % nig) % gsz); u.pn = (wgid % nig) / gsz; return true;
    }
    __device__ __forceinline__ void a_ready(const Unit&) const {}
    __device__ __forceinline__ void done(const Unit&) const {}
};
template <class Epi, class Sched>
__device__ __forceinline__ void gemm_phase(LAS unsigned char* lds, const Gemm g, const Sched& S, const Epi& E) {
    const int tid = threadIdx.x, wid = __builtin_amdgcn_readfirstlane(tid >> 6), lane = tid & 63, wr = wid >> 2, wc = wid & 3, fr = lane & 15, fq = lane >> 4;
    const int K = g.K, nt = K / BK;
    unsigned voffA[2], voffB[2];
#pragma unroll
    for (int i = 0; i < 2; ++i) { int R, C; stage_rc(tid * 16 + i * 8192, R, C); const int Rb = Epi::PERM ? ((R & ~31) + perm32(R & 31)) : R;
        voffA[i] = (unsigned)(R * K + C) * 2u; voffB[i] = (unsigned)(Rb * K + C) * 2u; }
    const size_t kstep = (size_t)(BK * 2);
    const size_t hstep = (size_t)HALF * K * 2;
    const size_t tstep = 2 * hstep;
    const unsigned ldsw = (unsigned)wid * 1024u;
    const int aoff = lds_byte(wr * 64 + fr, fq * 8), boff = lds_byte(wc * 32 + fr, fq * 8);
#define PG8_SA(b, h) (((b) * 2 + (h)) * HTB)
#define PG8_SB(b, h) ((4 + (b) * 2 + (h)) * HTB)
#define PG8_STAGE(bufoff, gbase, voff) do { _Pragma("unroll") for (int _i = 0; _i < 2; ++_i) \
        __builtin_amdgcn_global_load_lds((const unsigned*)((const char*)(gbase) + (voff)[_i]), (LAS unsigned*)(lds + (bufoff) + ldsw + _i * 8192), 16, 0, 0); } while (0)
#define PG8_LDA(dst, b, h) do { _Pragma("unroll") for (int m = 0; m < 4; ++m) _Pragma("unroll") for (int k = 0; k < 2; ++k) dst[m][k] = *(const LAS bf16x8*)(lds + PG8_SA(b, h) + aoff + m * 2048 + k * 1024); } while (0)
#define PG8_LDB(dst, b, h) do { _Pragma("unroll") for (int n = 0; n < 2; ++n) _Pragma("unroll") for (int k = 0; k < 2; ++k) dst[n][k] = *(const LAS bf16x8*)(lds + PG8_SB(b, h) + boff + n * 2048 + k * 1024); } while (0)
#define PG8_MMA(ai, bj, At, Bt) do { __builtin_amdgcn_s_setprio(1); _Pragma("unroll") for (int m = 0; m < 4; ++m) _Pragma("unroll") for (int n = 0; n < 2; ++n) _Pragma("unroll") for (int k = 0; k < 2; ++k) \
        acc[ai][bj][m][n] = __builtin_amdgcn_mfma_f32_16x16x32_bf16(Bt[n][k], At[m][k], acc[ai][bj][m][n], 0, 0, 0); __builtin_amdgcn_s_setprio(0); } while (0)
#define PG8_WAIT_V(n) asm volatile("s_waitcnt vmcnt(" #n ")" ::: "memory")
#define PG8_WAIT_L(n) asm volatile("s_waitcnt lgkmcnt(" #n ")" ::: "memory")
#define PG8_BAR __builtin_amdgcn_s_barrier()
#define PG8_SCHED __builtin_amdgcn_sched_barrier(0)
    Unit cur, nxt; int ui = 0;
    if (!S.next(0, cur)) return;
    f32x4 acc[2][2][4][2];
#pragma unroll
    for (int a = 0; a < 2; ++a)
#pragma unroll
        for (int b = 0; b < 2; ++b)
#pragma unroll
            for (int m = 0; m < 4; ++m)
#pragma unroll
                for (int n = 0; n < 2; ++n) acc[a][b][m][n] = (f32x4){0.f, 0.f, 0.f, 0.f};
    bf16x8 At[4][2], B0[2][2], B1[2][2];
    const char* cA = (const char*)g.A + (size_t)cur.pm * tstep; const char* cB = (const char*)g.Bt + (size_t)cur.pn * tstep;
    S.a_ready(cur);
    PG8_STAGE(PG8_SB(0, 0), cB, voffB); PG8_STAGE(PG8_SA(0, 0), cA, voffA); PG8_STAGE(PG8_SB(0, 1), cB + hstep, voffB); PG8_STAGE(PG8_SA(0, 1), cA + hstep, voffA);
    if (wr == 1) PG8_BAR;
    PG8_WAIT_V(4); PG8_BAR;
    PG8_STAGE(PG8_SB(1, 0), cB + kstep, voffB); PG8_STAGE(PG8_SA(1, 0), cA + kstep, voffA); PG8_STAGE(PG8_SB(1, 1), cB + hstep + kstep, voffB);
    PG8_WAIT_V(6); PG8_BAR;
    for (;;) {
        const bool has_next = S.next(ui + 1, nxt);
        const char* nA = has_next ? (const char*)g.A + (size_t)nxt.pm * tstep : cA; const char* nB = has_next ? (const char*)g.Bt + (size_t)nxt.pn * tstep : cB;
        for (int t = 0; t < nt; t += 2) {
            const bool last = (t == nt - 2);
            const char* a1 = cA + (size_t)(t + 1) * kstep;
            const char* a2 = last ? nA : cA + (size_t)(t + 2) * kstep; const char* b2 = last ? nB : cB + (size_t)(t + 2) * kstep;
            const char* a3 = a2 + kstep; const char* b3 = b2 + kstep;
            if (last && has_next) S.a_ready(nxt);
            PG8_LDB(B0, 0, 0); PG8_SCHED; PG8_LDA(At, 0, 0); PG8_STAGE(PG8_SA(1, 1), a1 + hstep, voffA);
            PG8_WAIT_L(8); PG8_BAR; PG8_WAIT_L(0); PG8_MMA(0, 0, At, B0); PG8_BAR; PG8_SCHED;
            PG8_LDB(B1, 0, 1); PG8_STAGE(PG8_SB(0, 0), b2, voffB);
            PG8_BAR; PG8_WAIT_L(0); PG8_MMA(0, 1, At, B1); PG8_BAR;
            PG8_LDA(At, 0, 1); PG8_STAGE(PG8_SA(0, 0), a2, voffA);
            PG8_BAR; PG8_WAIT_L(0); PG8_MMA(1, 0, At, B0); PG8_BAR; PG8_SCHED;
            PG8_STAGE(PG8_SB(0, 1), b2 + hstep, voffB);
            PG8_WAIT_V(6); PG8_BAR; PG8_MMA(1, 1, At, B1); PG8_BAR;
            PG8_LDB(B0, 1, 0); PG8_SCHED; PG8_LDA(At, 1, 0); PG8_STAGE(PG8_SA(0, 1), a2 + hstep, voffA);
            PG8_WAIT_L(8); PG8_BAR; PG8_WAIT_L(0); PG8_MMA(0, 0, At, B0); PG8_BAR; PG8_SCHED;
            PG8_LDB(B1, 1, 1); PG8_STAGE(PG8_SB(1, 0), b3, voffB);
            PG8_BAR; PG8_WAIT_L(0); PG8_MMA(0, 1, At, B1); PG8_BAR;
            PG8_LDA(At, 1, 1); PG8_STAGE(PG8_SA(1, 0), a3, voffA);
            PG8_BAR; PG8_WAIT_L(0); PG8_MMA(1, 0, At, B0); PG8_BAR; PG8_SCHED;
            PG8_STAGE(PG8_SB(1, 1), b3 + hstep, voffB);
            PG8_WAIT_V(6); PG8_BAR; PG8_MMA(1, 1, At, B1); PG8_BAR;
        }
        E(acc, cur, wr, wc, fr, fq);
        if (!has_next) break;
#pragma unroll
        for (int a = 0; a < 2; ++a)
#pragma unroll
            for (int b = 0; b < 2; ++b)
#pragma unroll
                for (int m = 0; m < 4; ++m)
#pragma unroll
                    for (int n = 0; n < 2; ++n) acc[a][b][m][n] = (f32x4){0.f, 0.f, 0.f, 0.f};
        cur = nxt; cA = nA; cB = nB; ++ui;
    }
    PG8_WAIT_V(0);
    if (wr == 0) PG8_BAR;
    PG8_BAR;
#undef PG8_SA
#undef PG8_SB
#undef PG8_STAGE
#undef PG8_LDA
#undef PG8_LDB
#undef PG8_MMA
#undef PG8_WAIT_V
#undef PG8_WAIT_L
#undef PG8_BAR
#undef PG8_SCHED
}
}

typedef f32x4 Acc[2][2][4][2];
#define EPI_ROWS(...) _Pragma("unroll") for (int ai = 0; ai < 2; ++ai) _Pragma("unroll") for (int m = 0; m < 4; ++m) { const int row = u.pm * 256 + ai * 128 + wr * 64 + m * 16 + fr; __VA_ARGS__ }
__device__ __forceinline__ u32x4 pack8(const float* v) { u32x4 w; w.x = pk2(v[0], v[1]); w.y = pk2(v[2], v[3]); w.z = pk2(v[4], v[5]); w.w = pk2(v[6], v[7]); return w; }

template <int SET> struct EpiProj {
    static constexpr bool PERM = true;
    const float* ss1; const float* qn; const float* kn; const float* rot;
    bf16_t *Q, *CA, *KS, *VS, *KW, *VW, *RQ, *RK, *RV, *RG; float* GATE; float* out;
    __device__ __forceinline__ void operator()(const Acc& acc, const pg8::Unit& u, int wr, int wc, int fr, int fq) const {
        const int pn = u.pn, c8 = 8 * fq;
        if (SET == 0 && (pn < 2 || pn == 3)) {
            const float* nw = (pn < 2) ? qn : kn; const float post = (pn < 2) ? 0.125f * LOG2E : 1.f;
            EPI_ROWS(
                const float s1 = ss1[row]; float v[2][8]; float ss = 0.f;
                _Pragma("unroll") for (int bj = 0; bj < 2; ++bj) _Pragma("unroll") for (int e = 0; e < 8; ++e) { v[bj][e] = acc[ai][bj][m][e >> 2][e & 3] * s1; ss += v[bj][e] * v[bj][e]; }
                ss += __shfl_xor(ss, 16); ss += __shfl_xor(ss, 32);
                const float rs = rsqrtf(ss * (1.f / 64.f) + EPS) * post;
                _Pragma("unroll") for (int bj = 0; bj < 2; ++bj) {
                    const int d0 = 32 * bj + c8;
                    const f32x4 w0 = *(const f32x4*)(nw + d0), w1 = *(const f32x4*)(nw + d0 + 4);
                    _Pragma("unroll") for (int e = 0; e < 4; ++e) { v[bj][e] *= rs * w0[e]; v[bj][4 + e] *= rs * w1[e]; }
                    if (pn < 2) { *(u32x4*)(Q + (size_t)row * 512 + (pn * 4 + wc) * 64 + d0) = pack8(v[bj]); }
                    else {
                        const int col = (wc & 1) * 64 + d0;
                        if (wc < 2) {
                            *(u32x4*)(KS + (size_t)row * 128 + col) = pack8(v[bj]);
                            float* o = row < MP ? out + O_PSK + (size_t)row * 128 + col : out + O_SSK + (size_t)(row - MP) * 128 + col;
                            if (row < MV) { *(f32x4*)o = (f32x4){v[bj][0], v[bj][1], v[bj][2], v[bj][3]}; *(f32x4*)(o + 4) = (f32x4){v[bj][4], v[bj][5], v[bj][6], v[bj][7]}; }
                        } else {
                            *(u32x4*)(KW + (size_t)row * 128 + col) = pack8(v[bj]);
                            float* o = nullptr; const int t = row & 2047;
                            if (row < MP) { if (t >= 1536) o = out + O_PWK + ((size_t)(row >> 11) * 512 + (t - 1536)) * 128 + col; }
                            else if (row < MV) o = out + O_SWK + ((size_t)(row - MP) * 512 + 511) * 128 + col;
                            if (o) { *(f32x4*)o = (f32x4){v[bj][0], v[bj][1], v[bj][2], v[bj][3]}; *(f32x4*)(o + 4) = (f32x4){v[bj][4], v[bj][5], v[bj][6], v[bj][7]}; }
                        }
                    }
                }
            )
        } else if (SET == 1 && (pn == 2 || pn == 4)) {
            EPI_ROWS(
                const float s1 = ss1[row];
                _Pragma("unroll") for (int bj = 0; bj < 2; ++bj) {
                    float v[8]; _Pragma("unroll") for (int e = 0; e < 8; ++e) v[e] = acc[ai][bj][m][e >> 2][e & 3] * s1;
                    const int col = 32 * wc + c8;
                    float* o = nullptr;
                    if (pn == 2) {
                        if (row < MP) { const int b = row >> 11, t = row & 2047, g = col >> 6, d = col & 63;
                            *(u32x4*)(CA + ((size_t)bj * CROWS + CROWS_S + ((b * 128 + (t >> 4)) * 2 + g)) * 1024 + (t & 15) * 64 + d) = pack8(v);
                            o = out + (bj ? O_PCV : O_PCK) + (size_t)row * 128 + col; }
                        else if (row < MV) o = out + (bj ? O_SCV : O_SCK) + (size_t)(row - MP) * 128 + col;
                    } else if (bj == 0) {
                        *(u32x4*)(VS + (size_t)row * 128 + col) = pack8(v);
                        if (row < MP) o = out + O_PSV + (size_t)row * 128 + col; else if (row < MV) o = out + O_SSV + (size_t)(row - MP) * 128 + col;
                    } else {
                        *(u32x4*)(VW + (size_t)row * 128 + col) = pack8(v);
                        const int t = row & 2047;
                        if (row < MP) { if (t >= 1536) o = out + O_PWV + ((size_t)(row >> 11) * 512 + (t - 1536)) * 128 + col; }
                        else if (row < MV) o = out + O_SWV + ((size_t)(row - MP) * 512 + 511) * 128 + col;
                    }
                    if (o) { *(f32x4*)o = (f32x4){v[0], v[1], v[2], v[3]}; *(f32x4*)(o + 4) = (f32x4){v[4], v[5], v[6], v[7]}; }
                }
            )
        } else if (SET == 0) {
            const int isk = (pn >= 7) ? 1 : 0, head = ((pn - 5) & 1) * 2 + (wc >> 1), j0 = 32 * (wc & 1) + c8;
            bf16_t* dst = isk ? RK : RQ; const float post = isk ? 0.08838834764831845f : 1.f;
            EPI_ROWS(
                const float s1 = ss1[row] * post; const int pidx = row < MP ? (row & 2047) : 2048;
                const float* rp = rot + ((size_t)pidx * 64 + j0) * 2;
                float y1[8], y2[8];
                _Pragma("unroll") for (int e2 = 0; e2 < 4; ++e2) { const f32x4 cs = *(const f32x4*)(rp + 4 * e2);
                    _Pragma("unroll") for (int t = 0; t < 2; ++t) { const int e = 2 * e2 + t; const float x1 = acc[ai][0][m][e >> 2][e & 3] * s1, x2 = acc[ai][1][m][e >> 2][e & 3] * s1, c = cs[2 * t], s = cs[2 * t + 1];
                        y1[e] = x1 * c - x2 * s; y2[e] = x1 * s + x2 * c; } }
                *(u32x4*)(dst + (size_t)row * 512 + head * 128 + j0) = pack8(y1);
                *(u32x4*)(dst + (size_t)row * 512 + head * 128 + 64 + j0) = pack8(y2);
            )
        } else if (SET == 1 && pn <= 12) {
            const int isg = pn >= 11; bf16_t* dst = isg ? RG : RV; const int cb = ((pn - 9) & 1) * 256;
            EPI_ROWS(
                const float s1 = ss1[row];
                _Pragma("unroll") for (int bj = 0; bj < 2; ++bj) { float v[8];
                    _Pragma("unroll") for (int e = 0; e < 8; ++e) { const float x = acc[ai][bj][m][e >> 2][e & 3] * s1; v[e] = isg ? siluf_(x) : x; }
                    *(u32x4*)(dst + (size_t)row * 512 + cb + 128 * bj + 32 * wc + c8) = pack8(v); }
            )
        } else if (SET == 1) {
            if (wc == 0 && fq < 3) {
                EPI_ROWS(
                    const float s1 = ss1[row]; float v[8];
                    _Pragma("unroll") for (int e = 0; e < 8; ++e) v[e] = sigmoidf_(acc[ai][0][m][e >> 2][e & 3] * s1);
                    float* o = GATE + (size_t)row * 24 + c8;
                    *(f32x4*)o = (f32x4){v[0], v[1], v[2], v[3]}; *(f32x4*)(o + 4) = (f32x4){v[4], v[5], v[6], v[7]};
                )
            }
        }
    }
};

struct SubsetOrder : pg8::StaticOrder {
    int set;
    __device__ __forceinline__ bool next(int i, pg8::Unit& u) const { if (!pg8::StaticOrder::next(i, u)) return false; const int k = u.pn;
        u.pn = set == 0 ? (k < 2 ? k : (k == 2 ? 3 : k + 2)) : (k == 0 ? 2 : (k == 1 ? 4 : k + 7)); return true; }
};
struct EpiF32 {
    static constexpr bool PERM = true;
    float* C; int ld;
    __device__ __forceinline__ void operator()(const Acc& acc, const pg8::Unit& u, int wr, int wc, int fr, int fq) const {
        EPI_ROWS(
            _Pragma("unroll") for (int bj = 0; bj < 2; ++bj) { float* o = C + (size_t)row * ld + u.pn * 256 + 128 * bj + 32 * wc + 8 * fq;
                *(f32x4*)o = acc[ai][bj][m][0]; *(f32x4*)(o + 4) = acc[ai][bj][m][1]; }
        )
    }
};
struct EpiCmp {
    static constexpr bool PERM = true;
    float* C;
    __device__ __forceinline__ void operator()(const Acc& acc, const pg8::Unit& u, int wr, int wc, int fr, int fq) const {
        EPI_ROWS(
            _Pragma("unroll") for (int bj = 0; bj < 2; ++bj) { float* o = C + (size_t)row * 256 + 128 * bj + 32 * wc + 8 * fq;
                *(f32x4*)o = acc[ai][bj][m][0]; *(f32x4*)(o + 4) = acc[ai][bj][m][1]; }
        )
    }
};
struct CmpOrder {
    int G, c;
    __device__ __forceinline__ bool next(int i, pg8::Unit& u) const { const int L = i * G + c; if (L >= 2 * (CROWS / 256)) return false; u.pm = L; u.pn = L / (CROWS / 256); return true; }
    __device__ __forceinline__ void a_ready(const pg8::Unit&) const {}
    __device__ __forceinline__ void done(const pg8::Unit&) const {}
};

struct EpiOut {
    static constexpr bool PERM = true;
    const float* xp; const float* xs; float* H; bf16_t* HB; float* SS2;
    __device__ __forceinline__ void operator()(const Acc& acc, const pg8::Unit& u, int wr, int wc, int fr, int fq) const {
        EPI_ROWS(
            float ss = 0.f;
            _Pragma("unroll") for (int bj = 0; bj < 2; ++bj) { const int col = u.pn * 256 + 128 * bj + 32 * wc + 8 * fq; float v[8];
                f32x4 x0 = (f32x4){0.f, 0.f, 0.f, 0.f}, x1 = x0;
                if (row < MV) { const float* xr = row < MP ? xp + (size_t)row * DM + col : xs + (size_t)(row - MP) * DM + col; x0 = *(const f32x4*)xr; x1 = *(const f32x4*)(xr + 4); }
                _Pragma("unroll") for (int e = 0; e < 4; ++e) { v[e] = acc[ai][bj][m][0][e] + x0[e]; v[4 + e] = acc[ai][bj][m][1][e] + x1[e]; }
                _Pragma("unroll") for (int e = 0; e < 8; ++e) ss += v[e] * v[e];
                float* o = H + (size_t)row * DM + col; *(f32x4*)o = (f32x4){v[0], v[1], v[2], v[3]}; *(f32x4*)(o + 4) = (f32x4){v[4], v[5], v[6], v[7]};
                *(u32x4*)(HB + (size_t)row * DM + col) = pack8(v); }
            ss += __shfl_xor(ss, 16); ss += __shfl_xor(ss, 32);
            if (fq == 0 && row < MV) atomicAdd(SS2 + row, ss);
        )
    }
};
struct EpiGU {
    static constexpr bool PERM = true;
    const float* SS2; bf16_t* ACT;
    __device__ __forceinline__ void operator()(const Acc& acc, const pg8::Unit& u, int wr, int wc, int fr, int fq) const {
        EPI_ROWS(
            const float s2 = rsqrtf(SS2[row] * (1.f / 1024.f) + EPS); float v[8];
            _Pragma("unroll") for (int e = 0; e < 8; ++e) { const float gt = acc[ai][0][m][e >> 2][e & 3] * s2, up = acc[ai][1][m][e >> 2][e & 3] * s2; v[e] = siluf_(gt) * up; }
            *(u32x4*)(ACT + (size_t)row * DFF + u.pn * 128 + 32 * wc + 8 * fq) = pack8(v);
        )
    }
};
struct EpiDown {
    static constexpr bool PERM = true;
    const float* H; float* H2; bf16_t* H2B;
    __device__ __forceinline__ void operator()(const Acc& acc, const pg8::Unit& u, int wr, int wc, int fr, int fq) const {
        EPI_ROWS(
            _Pragma("unroll") for (int bj = 0; bj < 2; ++bj) { const size_t off = (size_t)row * DM + u.pn * 256 + 128 * bj + 32 * wc + 8 * fq; float v[8];
                const f32x4 h0 = *(const f32x4*)(H + off), h1 = *(const f32x4*)(H + off + 4);
                _Pragma("unroll") for (int e = 0; e < 4; ++e) { v[e] = acc[ai][bj][m][0][e] + h0[e]; v[4 + e] = acc[ai][bj][m][1][e] + h1[e]; }
                *(f32x4*)(H2 + off) = (f32x4){v[0], v[1], v[2], v[3]}; *(f32x4*)(H2 + off + 4) = (f32x4){v[4], v[5], v[6], v[7]};
                *(u32x4*)(H2B + off) = pack8(v); }
        )
    }
};
struct EpiFinal {
    static constexpr bool PERM = true;
    const float* H2; const float* VP; float* out;
    __device__ __forceinline__ void operator()(const Acc& acc, const pg8::Unit& u, int wr, int wc, int fr, int fq) const {
        EPI_ROWS(
            if (row < MV) {
                _Pragma("unroll") for (int bj = 0; bj < 2; ++bj) { const int col = u.pn * 256 + 128 * bj + 32 * wc + 8 * fq; const size_t off = (size_t)row * DM + col; float v[8];
                    const f32x4 h0 = *(const f32x4*)(H2 + off), h1 = *(const f32x4*)(H2 + off + 4), p0 = *(const f32x4*)(VP + off), p1 = *(const f32x4*)(VP + off + 4);
                    _Pragma("unroll") for (int e = 0; e < 4; ++e) { v[e] = h0[e] + sigmoidf_(acc[ai][bj][m][0][e]) * p0[e]; v[4 + e] = h1[e] + sigmoidf_(acc[ai][bj][m][1][e]) * p1[e]; }
                    float* o = row < MP ? out + O_YP + off : out + O_YS + (size_t)(row - MP) * DM + col;
                    *(f32x4*)o = (f32x4){v[0], v[1], v[2], v[3]}; *(f32x4*)(o + 4) = (f32x4){v[4], v[5], v[6], v[7]}; }
            }
        )
    }
};

__device__ __forceinline__ int rel_bucket(int dist) {
    const int n = dist < 0 ? 0 : dist;
    if (n < 16) return n;
    const int large = 16 + (int)(logf((float)n / 16.f) / 2.0794415416798357f * 16.f);
    return large < 31 ? large : 31;
}
struct WSrc { const float* src; int ld, vt; const float* ks; };
__device__ __forceinline__ WSrc wsrc(const Params& p, int wid, int n0) {
    WSrc w; w.vt = 32; w.ks = nullptr;
    if (wid == 0) {
        const int tile = n0 >> 8, c = n0 & 255, bj = c >> 7, wc = (c >> 5) & 3; int col;
        if (tile < 2) col = (tile * 4 + wc) * 64 + 32 * bj;
        else if (tile == 2) col = 512 + c;
        else if (tile == 3) col = (wc < 2 ? 768 : 1024) + (wc & 1) * 64 + 32 * bj;
        else if (tile == 4) col = (bj ? 1152 : 896) + (c & 127);
        else if (tile <= 8) col = (tile >= 7 ? 1816 : 1304) + ((((tile - 5) & 1) * 2 + (wc >> 1)) * 128) + 64 * bj + 32 * (wc & 1);
        else if (tile <= 10) col = 2328 + (tile - 9) * 256 + c;
        else if (tile <= 12) col = 2840 + (tile - 11) * 256 + c;
        else { col = 1280; w.vt = (c == 0) ? 24 : 0; }
        w.src = p.in[13] + col; w.ld = INC; w.ks = p.in[12];
    } else if (wid == 1) { w.src = p.in[23] + n0; w.ld = DM; }
    else if (wid == 2) { const int pn = n0 >> 8, bj = (n0 >> 7) & 1, c7 = n0 & 127; w.src = (bj ? p.in[26] : p.in[25]) + pn * 128 + c7; w.ld = DFF; w.ks = p.in[24]; }
    else if (wid == 3) { w.src = p.in[27] + n0; w.ld = DM; }
    else if (wid == 4) { w.src = p.in[28] + n0; w.ld = DM; }
    else if (wid == 5) { w.src = p.in[29] + n0; w.ld = DM; }
    else if (wid == 6 || wid == 7) { const int j = n0 >> 7, h0 = n0 & 127; w.src = p.in[wid == 6 ? 17 : 20] + (size_t)j * 1024 * 128 + h0; w.ld = 128; }
    else { w.src = p.in[wid == 8 ? 18 : 21] + n0; w.ld = 64; }
    return w;
}
__device__ __forceinline__ void phase_prologue(const Params& p, unsigned char* lds) {
    const int tid = threadIdx.x, lane = tid & 63, wid = tid >> 6, G = gridDim.x, bid = blockIdx.x;
    unsigned char* ws = p.ws;
    {
        const int tn[10] = {112, 32, 176, 32, 32, 32, 8, 8, 2, 2}, tk[10] = {16, 16, 16, 44, 16, 4, 16, 16, 2, 2};
        const size_t dsto[10] = {WS_W1, WS_WO, WS_WGU, WS_WD, WS_WPG, WS_WPP, WS_W1C, WS_W1C + (size_t)256 * 1024 * 2, WS_W2C, WS_W2C + (size_t)64 * 128 * 2};
        int total = 0;
#pragma unroll
        for (int i = 0; i < 10; ++i) total += tn[i] * tk[i];
        float* tl = (float*)lds;
        int total4 = 0;
#pragma unroll
        for (int i = 0; i < 10; ++i) total4 += ((tn[i] + 3) / 4) * tk[i];
        for (int t = bid; t < total4; t += G) {
            int wsel = 0, rem = t;
#pragma unroll
            for (int i = 0; i < 9; ++i) { const int cnt = ((tn[i] + 3) / 4) * tk[i]; if (wsel == i && rem >= cnt) { rem -= cnt; wsel = i + 1; } }
            int tkk = 16, tnn = 4; size_t doff = 0;
#pragma unroll
            for (int i = 0; i < 10; ++i) if (wsel == i) { tkk = tk[i]; tnn = tn[i]; doff = dsto[i]; }
            const int K = tkk * 64;
            const int n0 = (rem / tkk) * 128, k0 = (rem % tkk) * 64;
            const int nch = (tnn - n0 / 32) < 4 ? (tnn - n0 / 32) : 4;
            float v[4][4];
#pragma unroll
            for (int ch = 0; ch < 4; ++ch) { if (ch < nch) { const WSrc w = wsrc(p, wsel, n0 + 32 * ch);
#pragma unroll
                for (int it = 0; it < 4; ++it) { const int kk = it * 16 + (tid >> 5), tt = tid & 31; float x = 0.f;
                    if (tt < w.vt) { x = w.src[(size_t)(k0 + kk) * w.ld + tt]; if (w.ks) x *= w.ks[k0 + kk]; }
                    v[ch][it] = x; } } }
#pragma unroll
            for (int ch = 0; ch < 4; ++ch) if (ch < nch) {
#pragma unroll
                for (int it = 0; it < 4; ++it) tl[ch * 2112 + (it * 16 + (tid >> 5)) * 33 + (tid & 31)] = v[ch][it]; }
            __syncthreads();
#pragma unroll
            for (int ch = 0; ch < 4; ++ch) if (ch < nch) { const int nt = tid >> 4, kq = (tid & 15) * 4; const float* tc = tl + ch * 2112;
              u32x2 o; o.x = pk2(tc[(kq + 0) * 33 + nt], tc[(kq + 1) * 33 + nt]); o.y = pk2(tc[(kq + 2) * 33 + nt], tc[(kq + 3) * 33 + nt]);
              *(u32x2*)((bf16_t*)(ws + doff) + (size_t)(n0 + 32 * ch + nt) * K + k0 + kq) = o; }
            __syncthreads();
        }
    }
    {
        bf16_t* XB = (bf16_t*)(ws + WS_XB); float* SS1 = (float*)(ws + WS_SS1); bf16_t* PB = (bf16_t*)(ws + WS_PB);
        for (int row = bid * 8 + wid; row < MR; row += G * 8) {
            const float* xr = row < MP ? p.in[0] + (size_t)row * DM : p.in[1] + (size_t)(row - MP) * DM;
            const float* pr = row < MP ? p.in[10] + (size_t)row * PLE : p.in[11] + (size_t)(row - MP) * PLE;
            f32x4 v[4]; float ss = 0.f;
#pragma unroll
            for (int i = 0; i < 4; ++i) { v[i] = row < MV ? *(const f32x4*)(xr + i * 256 + lane * 4) : (f32x4){0.f, 0.f, 0.f, 0.f}; ss += v[i][0] * v[i][0] + v[i][1] * v[i][1] + v[i][2] * v[i][2] + v[i][3] * v[i][3]; }
#pragma unroll
            for (int o = 1; o < 64; o <<= 1) ss += __shfl_xor(ss, o);
#pragma unroll
            for (int i = 0; i < 4; ++i) { u32x2 o; o.x = pk2(v[i][0], v[i][1]); o.y = pk2(v[i][2], v[i][3]); *(u32x2*)(XB + (size_t)row * DM + i * 256 + lane * 4) = o; }
            if (lane == 0) SS1[row] = rsqrtf(ss * (1.f / 1024.f) + EPS);
            const f32x4 pv = row < MV ? *(const f32x4*)(pr + lane * 4) : (f32x4){0.f, 0.f, 0.f, 0.f};
            u32x2 o; o.x = pk2(pv[0], pv[1]); o.y = pk2(pv[2], pv[3]); *(u32x2*)(PB + (size_t)row * PLE + lane * 4) = o;
        }
    }
    const int gtid = bid * 512 + tid, gsz = G * 512;
    {
        float* rot = (float*)(ws + WS_ROT);
        for (int idx = gtid; idx < 2049 * 64; idx += gsz) { const int pidx = idx >> 6, j = idx & 63; const float pos = pidx < 2048 ? (float)pidx : 16384.f;
            const float inv = powf(10000.f, -(float)j / 64.f); const float ang = pos * inv; const double a = (double)ang;
            rot[(size_t)idx * 2] = (float)cos(a); rot[(size_t)idx * 2 + 1] = (float)sin(a); }
        float* btab = (float*)(ws + WS_BTAB);
        for (int idx = gtid; idx < 8 * 128; idx += gsz) { const int head = idx >> 7, dist = idx & 127; btab[idx] = p.in[30][rel_bucket(dist) * 8 + head] * LOG2E; }
        float* SS2 = (float*)(ws + WS_SS2);
        for (int idx = gtid; idx < MR; idx += gsz) SS2[idx] = 0.f;
        float* bc = (float*)(ws + WS_BIASC);
        for (int it = bid; it < 32; it += G) if (tid < 256) { const int c = tid >> 7, h = tid & 127; const float* pe = p.in[c ? 19 : 16]; const float* w1 = p.in[c ? 20 : 17]; float a = 0.f;
#pragma unroll 8
            for (int k = it * 64; k < it * 64 + 64; ++k) a += pe[k] * w1[(size_t)k * 128 + h];
            atomicAdd(bc + tid, a); }
    }
    {
        bf16_t* CA = (bf16_t*)(ws + WS_CA);
        const int total = 2 * DB * PAST * 32;
        for (int idx0 = gtid; idx0 < total; idx0 += 8 * gsz) {
            f32x4 v[8]; size_t dst[8]; bool ok[8];
#pragma unroll
            for (int q = 0; q < 8; ++q) { const int idx = idx0 + q * gsz; ok[q] = idx < total; const int ii = ok[q] ? idx : 0;
                const int c4 = (ii & 31) * 4, tok = (ii >> 5) & (PAST - 1), b = (ii >> 19) & 31, c = ii >> 24;
                const int page = p.page_table[b * NPAGES + (tok >> 7)];
                v[q] = *(const f32x4*)(p.in[2 + c] + ((size_t)page * PAGE + (tok & 127)) * 128 + c4);
                const int seg = tok >> 4, s = tok & 15, g = c4 >> 6, d = c4 & 63;
                dst[q] = ((size_t)c * CROWS + (size_t)(b * 1024 + seg) * 2 + g) * 1024 + s * 64 + d; }
#pragma unroll
            for (int q = 0; q < 8; ++q) if (ok[q]) { u32x2 o; o.x = pk2(v[q][0], v[q][1]); o.y = pk2(v[q][2], v[q][3]); *(u32x2*)(CA + dst[q]) = o; }
        }
    }
    {
        const int total = 2 * DB * 511 * 32;
        for (int idx = gtid; idx < total; idx += gsz) { const int c4 = (idx & 31) * 4; int r = idx >> 5; const int j = r % 511; r /= 511; const int b = r & 31, c = r >> 5;
            const f32x4 v = *(const f32x4*)(p.in[6 + c] + ((size_t)b * 512 + j + 1) * 128 + c4);
            *(f32x4*)(p.out + (c ? O_SWV : O_SWK) + ((size_t)b * 512 + j) * 128 + c4) = v; }
    }
}

__device__ __forceinline__ s16x4 tr16(const unsigned char* p) { typedef short v4i16_t __attribute__((ext_vector_type(4))); return __builtin_bit_cast(s16x4, __builtin_amdgcn_ds_read_tr16_b64_v4i16((LAS v4i16_t*)p)); }
__device__ __forceinline__ bf16x8 cat8(s16x4 lo, s16x4 hi) { return (bf16x8){lo[0], lo[1], lo[2], lo[3], hi[0], hi[1], hi[2], hi[3]}; }
constexpr int RSTR = 272;
__device__ __forceinline__ float ret_lgam(int h) { return log2f(1.f - exp2f(-5.f - (float)h)); }
__device__ __forceinline__ bf16x8 tr_frag(const unsigned char* tile, int row0, int cb, int lane) {
    const int hi = lane >> 5;
    const unsigned char* a = tile + (size_t)(row0 + 4 * hi + ((lane & 15) >> 2)) * RSTR + (cb * 32 + 16 * ((lane >> 4) & 1) + 4 * (lane & 3)) * 2;
    return cat8(tr16(a), tr16(a + 8 * RSTR));
}
__device__ __forceinline__ void stage128(unsigned char* dst, const bf16_t* src, int tid, bool decay, float lg) {
    const int r = tid >> 2, q4 = tid & 3;
    float sc = decay ? exp2f((float)(127 - r) * lg) : 1.f;
#pragma unroll
    for (int i = 0; i < 4; ++i) { const int col = q4 * 32 + i * 8; u32x4 v = *(const u32x4*)(src + (size_t)r * 512 + col);
        if (decay) { v.x = pk2(bflo(v.x) * sc, bfhi(v.x) * sc); v.y = pk2(bflo(v.y) * sc, bfhi(v.y) * sc); v.z = pk2(bflo(v.z) * sc, bfhi(v.z) * sc); v.w = pk2(bflo(v.w) * sc, bfhi(v.w) * sc); }
        *(u32x4*)(dst + (size_t)r * RSTR + col * 2) = v; }
}
__device__ __forceinline__ void ret_r1_unit(const Params& p, unsigned char* lds, int b, int h, int c) {
    const int tid = threadIdx.x, lane = tid & 63, w = __builtin_amdgcn_readfirstlane(tid >> 6), r32 = lane & 31, hi = lane >> 5;
    const size_t row0 = (size_t)b * SEQ + c * 128;
    const float lg = ret_lgam(h);
    unsigned char* Kt = lds; unsigned char* Vt = lds + 128 * RSTR;
    stage128(Kt, (const bf16_t*)(p.ws + WS_RK) + row0 * 512 + h * 128, tid, true, lg);
    stage128(Vt, (const bf16_t*)(p.ws + WS_RV) + row0 * 512 + h * 128, tid, false, 0.f);
    __syncthreads();
    const int eb = w & 3, dp = w >> 2;
    f32x16 acc[2]; acc[0] = f32x16{}; acc[1] = f32x16{};
#pragma unroll
    for (int s = 0; s < 8; ++s) {
        const bf16x8 vf = tr_frag(Vt, 16 * s, eb, lane);
#pragma unroll
        for (int di = 0; di < 2; ++di) { const bf16x8 kf = tr_frag(Kt, 16 * s, 2 * dp + di, lane); acc[di] = __builtin_amdgcn_mfma_f32_32x32x16_bf16(vf, kf, acc[di], 0, 0, 0); }
    }
    float* KVT = (float*)(p.ws + WS_KVT) + ((size_t)((b * 4 + h) * 16 + c)) * 16384;
#pragma unroll
    for (int di = 0; di < 2; ++di)
#pragma unroll
        for (int r = 0; r < 16; ++r) KVT[(size_t)(32 * eb + crow(r, hi)) * 128 + 32 * (2 * dp + di) + r32] = acc[di][r];
    __syncthreads();
}
__device__ __forceinline__ void ret_r2_unit(const Params& p, unsigned char* lds, int b, int h, int c) {
    const int tid = threadIdx.x, lane = tid & 63, w = __builtin_amdgcn_readfirstlane(tid >> 6), r32 = lane & 31, hi = lane >> 5;
    const size_t row0 = (size_t)b * SEQ + c * 128;
    const float lg = ret_lgam(h);
    unsigned char* Qt = lds; unsigned char* Kt = lds + 128 * RSTR; unsigned char* Vt = lds + 2 * 128 * RSTR; float* st = (float*)(lds + 3 * 128 * RSTR);
    stage128(Qt, (const bf16_t*)(p.ws + WS_RQ) + row0 * 512 + h * 128, tid, false, 0.f);
    stage128(Kt, (const bf16_t*)(p.ws + WS_RK) + row0 * 512 + h * 128, tid, false, 0.f);
    stage128(Vt, (const bf16_t*)(p.ws + WS_RV) + row0 * 512 + h * 128, tid, false, 0.f);
    __syncthreads();
    const int eb = w & 3, ps = w >> 2;
    bf16x8 sf[8];
    if (c > 0) {
        const float* KV0 = (const float*)(p.ws + WS_KVT) + ((size_t)((b * 4 + h) * 16)) * 16384 + (size_t)(32 * eb + r32) * 128 + 8 * hi;
#pragma unroll
        for (int s = 0; s < 8; ++s) {
            float a[8];
#pragma unroll
            for (int e = 0; e < 8; ++e) a[e] = 0.f;
            for (int j = 0; j < c; ++j) { const float wj = exp2f(128.f * (float)(c - 1 - j) * lg); const float* src = KV0 + (size_t)j * 16384 + 16 * s;
                const f32x4 x0 = *(const f32x4*)src, x1 = *(const f32x4*)(src + 4);
#pragma unroll
                for (int e = 0; e < 4; ++e) { a[e] += wj * x0[e]; a[4 + e] += wj * x1[e]; } }
            const u32x4 pk = pack8(a); sf[s] = __builtin_bit_cast(bf16x8, pk);
        }
    }
    f32x16 accs[2];
#pragma unroll
    for (int ni = 0; ni < 2; ++ni) {
        const int nb = ps ? (1 + ni) : (ni ? 3 : 0);
        const int n = 32 * nb + r32;
        bf16x8 qf[8];
#pragma unroll
        for (int s = 0; s < 8; ++s) qf[s] = *(const bf16x8*)(Qt + (size_t)n * RSTR + (16 * s + 8 * hi) * 2);
        f32x16 acc = f32x16{};
        if (c > 0) {
#pragma unroll
            for (int s = 0; s < 8; ++s) acc = __builtin_amdgcn_mfma_f32_32x32x16_bf16(sf[s], qf[s], acc, 0, 0, 0);
            const float dn = exp2f((float)(n + 1) * lg);
#pragma unroll
            for (int r = 0; r < 16; ++r) acc[r] *= dn;
        }
        for (int mb = 0; mb <= nb; ++mb) {
            f32x16 x = f32x16{};
#pragma unroll
            for (int s = 0; s < 8; ++s) { const bf16x8 kf = *(const bf16x8*)(Kt + (size_t)(32 * mb + r32) * RSTR + (16 * s + 8 * hi) * 2); x = __builtin_amdgcn_mfma_f32_32x32x16_bf16(kf, qf[s], x, 0, 0, 0); }
            float pv[16];
#pragma unroll
            for (int r = 0; r < 16; ++r) { const int dm = n - (32 * mb + crow(r, hi)); pv[r] = dm >= 0 ? x[r] * exp2f((float)dm * lg) : 0.f; }
#pragma unroll
            for (int s2 = 0; s2 < 2; ++s2) { const u32x4 pk = pack8(pv + 8 * s2); const bf16x8 vf = tr_frag(Vt, 32 * mb + 16 * s2, eb, lane);
                acc = __builtin_amdgcn_mfma_f32_32x32x16_bf16(vf, __builtin_bit_cast(bf16x8, pk), acc, 0, 0, 0); }
        }
        float s1 = 0.f, s2 = 0.f;
#pragma unroll
        for (int r = 0; r < 16; ++r) { s1 += acc[r]; s2 += acc[r] * acc[r]; }
        s1 = xhalf_sum(s1); s2 = xhalf_sum(s2);
        if (hi == 0) { st[(eb * 128 + n) * 2] = s1; st[(eb * 128 + n) * 2 + 1] = s2; }
        accs[ni] = acc;
    }
    __syncthreads();
    const float* gn = p.in[22] + h * 128; const bf16_t* RG = (const bf16_t*)(p.ws + WS_RG); bf16_t* AO = (bf16_t*)(p.ws + WS_AO);
#pragma unroll
    for (int ni = 0; ni < 2; ++ni) {
        const int nb = ps ? (1 + ni) : (ni ? 3 : 0); const int n = 32 * nb + r32;
        float s1 = 0.f, s2 = 0.f;
#pragma unroll
        for (int q = 0; q < 4; ++q) { s1 += st[(q * 128 + n) * 2]; s2 += st[(q * 128 + n) * 2 + 1]; }
        const float mu = s1 * (1.f / 128.f), var = s2 * (1.f / 128.f) - mu * mu, rs = rsqrtf(var + EPS);
        const size_t row = row0 + n;
#pragma unroll
        for (int a = 0; a < 4; ++a) { const int e0 = 32 * eb + 8 * a + 4 * hi;
            const f32x4 gw = *(const f32x4*)(gn + e0); const u32x2 gg = *(const u32x2*)(RG + row * 512 + h * 128 + e0);
            const float g0 = bflo(gg.x), g1 = bfhi(gg.x), g2 = bflo(gg.y), g3 = bfhi(gg.y);
            u32x2 o; o.x = pk2((accs[ni][4 * a] - mu) * rs * gw[0] * g0, (accs[ni][4 * a + 1] - mu) * rs * gw[1] * g1);
            o.y = pk2((accs[ni][4 * a + 2] - mu) * rs * gw[2] * g2, (accs[ni][4 * a + 3] - mu) * rs * gw[3] * g3);
            *(u32x2*)(AO + row * 1024 + 512 + h * 128 + e0) = o; }
    }
    __syncthreads();
}
__device__ __forceinline__ void ret_sample_unit(const Params& p, unsigned char* lds, int b, int h) {
    const int tid = threadIdx.x;
    float* qv = (float*)lds; float* kv = qv + 128; float* vv = kv + 128; float* part = vv + 128; float* red = part + 512;
    const size_t row = (size_t)MP + b;
    if (tid < 384) { const int which = tid >> 7, d = tid & 127; const bf16_t* src = (const bf16_t*)(p.ws + (which == 0 ? WS_RQ : which == 1 ? WS_RK : WS_RV)) + row * 512 + h * 128 + d; qv[tid] = bf1(*src); }
    __syncthreads();
    const float gam = 1.f - exp2f(-5.f - (float)h);
    const int dq = tid >> 7, e = tid & 127;
    const float* st = p.in[8] + ((size_t)(b * 4 + h)) * 16384; float* so = p.out + O_SRET + ((size_t)(b * 4 + h)) * 16384;
    float acc = 0.f, qk = 0.f; const float ve = vv[e];
#pragma unroll 4
    for (int i = 0; i < 32; ++i) { const int d = dq + 4 * i; const float s = st[d * 128 + e]; acc += qv[d] * s; so[d * 128 + e] = gam * s + kv[d] * ve; }
#pragma unroll 4
    for (int d = 0; d < 128; ++d) qk += qv[d] * kv[d];
    part[dq * 128 + e] = acc;
    __syncthreads();
    float o = 0.f;
    if (tid < 128) { o = qk * ve + gam * (part[e] + part[128 + e] + part[256 + e] + part[384 + e]); }
    float s1 = tid < 128 ? o : 0.f, s2 = tid < 128 ? o * o : 0.f;
#pragma unroll
    for (int of = 1; of < 64; of <<= 1) { s1 += __shfl_xor(s1, of); s2 += __shfl_xor(s2, of); }
    if ((tid & 63) == 0 && tid < 128) { red[(tid >> 6) * 2] = s1; red[(tid >> 6) * 2 + 1] = s2; }
    __syncthreads();
    if (tid < 128) { const float t1 = red[0] + red[2], t2 = red[1] + red[3]; const float mu = t1 * (1.f / 128.f), var = t2 * (1.f / 128.f) - mu * mu, rs = rsqrtf(var + EPS);
        const float g = bf1(((const bf16_t*)(p.ws + WS_RG))[row * 512 + h * 128 + e]);
        const unsigned pk = pk2((o - mu) * rs * p.in[22][h * 128 + e] * g, 0.f);
        ((bf16_t*)(p.ws + WS_AO))[row * 1024 + 512 + h * 128 + e] = (bf16_t)(pk & 0xffffu); }
    __syncthreads();
}

__device__ __forceinline__ void compress2_task(const Params& p, int c, int task, int lane) {
    const int r32 = lane & 31, hi = lane >> 5;
    const int R = task * 32 + r32;
    const float* P0 = (const float*)(p.ws + WS_CP) + ((size_t)c * CROWS + R) * 256;
    const int R2 = (R + 2 < CROWS) ? R + 2 : CROWS - 1;
    const float* P1 = (const float*)(p.ws + WS_CP) + ((size_t)c * CROWS + R2) * 256 + 128;
    const float* bc = (const float*)(p.ws + WS_BIASC) + c * 128;
    const bf16_t* W2 = (const bf16_t*)(p.ws + WS_W2C) + (size_t)c * 64 * 128;
    f32x16 acc[2]; acc[0] = f32x16{}; acc[1] = f32x16{};
#pragma unroll
    for (int s = 0; s < 8; ++s) {
        const int k0 = 16 * s + 8 * hi; float hv[8];
#pragma unroll
        for (int q = 0; q < 2; ++q) { const f32x4 a = *(const f32x4*)(P0 + k0 + 4 * q), b = *(const f32x4*)(P1 + k0 + 4 * q), bb = *(const f32x4*)(bc + k0 + 4 * q);
#pragma unroll
            for (int e = 0; e < 4; ++e) hv[4 * q + e] = siluf_(a[e] + b[e] + bb[e]); }
        const u32x4 pk = pack8(hv); const bf16x8 hf = __builtin_bit_cast(bf16x8, pk);
#pragma unroll
        for (int eb = 0; eb < 2; ++eb) { const bf16x8 wf = *(const bf16x8*)(W2 + (size_t)(32 * eb + r32) * 128 + k0); acc[eb] = __builtin_amdgcn_mfma_f32_32x32x16_bf16(wf, hf, acc[eb], 0, 0, 0); }
    }
    float rs = 1.f;
    if (c == 0) { float ss = 0.f;
#pragma unroll
        for (int eb = 0; eb < 2; ++eb)
#pragma unroll
            for (int r = 0; r < 16; ++r) ss += acc[eb][r] * acc[eb][r];
        ss = xhalf_sum(ss); rs = rsqrtf(ss * (1.f / 64.f) + EPS); }
    bool valid; bf16_t* dst;
    if (R < CROWS_S) { valid = ((R >> 1) & 1023) < NC_S; dst = (bf16_t*)(p.ws + (c ? WS_CVCS : WS_CKCS)) + (size_t)R * 64; }
    else { const int Rp = R - CROWS_S; valid = ((Rp >> 1) & 127) < NC_P; dst = (bf16_t*)(p.ws + (c ? WS_CVCP : WS_CKCP)) + (size_t)Rp * 64; }
    if (valid) {
#pragma unroll
        for (int eb = 0; eb < 2; ++eb)
#pragma unroll
            for (int a = 0; a < 4; ++a) { const int e0 = 32 * eb + 8 * a + 4 * hi; float v[4];
#pragma unroll
                for (int e = 0; e < 4; ++e) { v[e] = acc[eb][4 * a + e] * rs; if (c == 0) v[e] *= p.in[15][e0 + e]; }
                u32x2 o; o.x = pk2(v[0], v[1]); o.y = pk2(v[2], v[3]); *(u32x2*)(dst + e0) = o; }
    }
}
__device__ __forceinline__ void pret_job(const Params& p) {
    const int gtid = blockIdx.x * 512 + threadIdx.x, gsz = gridDim.x * 512;
    for (int idx = gtid; idx < NB * 4 * 16384; idx += gsz) { const int d = idx & 127, e = (idx >> 7) & 127, bh = idx >> 14; const float lg = ret_lgam(bh & 3);
        const float* src = (const float*)(p.ws + WS_KVT) + (size_t)bh * 16 * 16384 + e * 128 + d; float a = 0.f;
#pragma unroll
        for (int j = 0; j < 16; ++j) a += exp2f(128.f * (float)(15 - j) * lg) * src[(size_t)j * 16384];
        p.out[O_PRET + (size_t)bh * 16384 + d * 128 + e] = a; }
}

constexpr int AT_K = 0, AT_V = 16384, AT_IMP = 32768, AT_IMPS = AT_IMP + 64 * 129 * 4, AT_MASK = AT_IMPS + 64 * 33 * 4, AT_BTAB = AT_MASK + 256, AT_END = AT_BTAB + 2048;
struct KVregs { u32x4 k, v; };
__device__ __forceinline__ KVregs kv_load(const bf16_t* Kg, const bf16_t* Vg, size_t rowbase, int rmax, int ld, int colg, int tid) {
    KVregs r; { int key = tid & 63; if (key > rmax) key = rmax; r.k = *(const u32x4*)(Kg + (rowbase + key) * ld + colg + (tid >> 6) * 8); }
    { int row = (tid >> 2) & 63; if (row > rmax) row = rmax; r.v = *(const u32x4*)(Vg + (rowbase + row) * ld + colg + (tid >> 8) * 32 + (tid & 3) * 8); }
    return r;
}
__device__ __forceinline__ void kv_store(unsigned char* Kb, unsigned char* Vb, const KVregs& r, int tid) {
    *(u32x4*)(Kb + (tid >> 6) * 1024 + (tid & 63) * 16) = r.k;
    *(u32x4*)(Vb + (tid >> 8) * 4096 + ((tid >> 2) & 63) * 64 + (tid & 3) * 16) = r.v;
}
__device__ __forceinline__ f32x16 qk_sub(const unsigned char* Kb, const bf16x8* qr, int sub, int r32, int hi) {
    f32x16 s = f32x16{};
#pragma unroll
    for (int d0 = 0; d0 < 4; ++d0) { const bf16x8 kf = *(const bf16x8*)(Kb + d0 * 2048 + hi * 1024 + (sub * 32 + r32) * 16); s = __builtin_amdgcn_mfma_f32_32x32x16_bf16(kf, qr[d0], s, 0, 0, 0); }
    return s;
}
__device__ __forceinline__ void pv_sub(f32x16* o, const unsigned char* Vb, const float* pv, int sub, int lane) {
    const int hi = lane >> 5;
    const unsigned char* vb = Vb + ((lane >> 4) & 1) * 32 + (lane & 3) * 8 + (4 * hi + ((lane & 15) >> 2)) * 64;
#pragma unroll
    for (int s2 = 0; s2 < 2; ++s2) { const u32x4 pk = pack8(pv + 8 * s2); const bf16x8 pf = __builtin_bit_cast(bf16x8, pk);
#pragma unroll
        for (int eb = 0; eb < 2; ++eb) { const unsigned char* a = vb + eb * 4096 + (2 * sub + s2) * 1024; const bf16x8 vf = cat8(tr16(a), tr16(a + 512));
            o[eb] = __builtin_amdgcn_mfma_f32_32x32x16_bf16(vf, pf, o[eb], 0, 0, 0); } }
}
__device__ __forceinline__ void attn_tile(const unsigned char* Kb, const unsigned char* Vb, const bf16x8* qr, const float* bt, int kp0, int qpos, bool isw, bool sel, float& m, float& l, f32x16* o, int lane) {
    const int r32 = lane & 31, hi = lane >> 5;
#pragma unroll 1
    for (int sub = 0; sub < 2; ++sub) {
        const int dist0 = qpos - kp0 - 32 * sub - 4 * hi;
        unsigned vm = 0;
#pragma unroll
        for (int r = 0; r < 16; ++r) { const int dist = dist0 - ((r & 3) + 8 * (r >> 2)); const bool ok = isw ? (dist >= 0 && dist < 512) : (sel && dist >= 0); vm |= ok ? (1u << r) : 0u; }
        if (__ballot(vm != 0) == 0ull) continue;
        f32x16 s = qk_sub(Kb, qr, sub, r32, hi);
        float mx = -1e30f;
#pragma unroll
        for (int r = 0; r < 16; ++r) { const int dist = dist0 - ((r & 3) + 8 * (r >> 2)); const int di = dist < 0 ? 0 : (dist > 127 ? 127 : dist);
            const float bv = bt[di]; const float sv = ((vm >> r) & 1u) ? s[r] + bv : -1e30f; s[r] = sv; mx = fmaxf(mx, sv); }
        mx = xhalf_max(mx);
        const float mn = fmaxf(m, mx), alpha = exp2f(m - mn);
        float pv[16]; float ps = 0.f;
#pragma unroll
        for (int r = 0; r < 16; ++r) { const float e = exp2f(s[r] - mn); pv[r] = ((vm >> r) & 1u) ? e : 0.f; ps += pv[r]; }
        l = l * alpha + ps; m = mn;
#pragma unroll
        for (int r = 0; r < 16; ++r) { o[0][r] *= alpha; o[1][r] *= alpha; }
        pv_sub(o, Vb, pv, sub, lane);
    }
}
__device__ __forceinline__ void attn_prompt_unit(const Params& p, unsigned char* lds, int b, int g, int i) {
    const int tid = threadIdx.x, lane = tid & 63, w = __builtin_amdgcn_readfirstlane(tid >> 6), r32 = lane & 31, hi = lane >> 5;
    const int hr = w >> 1, ql = (w & 1) * 32 + r32, qpos = 64 * i + ql, head = g * 4 + hr;
    const size_t row = (size_t)b * SEQ + qpos;
    float* imp = (float*)(lds + AT_IMP); float* imps = (float*)(lds + AT_IMPS); unsigned* mask = (unsigned*)(lds + AT_MASK); float* btab = (float*)(lds + AT_BTAB);
    const bf16_t* Qg = (const bf16_t*)(p.ws + WS_Q);
    for (int x = tid; x < 64 * 129; x += 512) imp[x] = 0.f;
    if (tid < 64) mask[tid] = (i < 16) ? 0xFFFFFFFFu : ((1u << 0) | (1u << i) | (1u << (i - 1)));
    btab[tid] = ((const float*)(p.ws + WS_BTAB))[(g * 4) * 128 + tid];
    bf16x8 qr[4];
#pragma unroll
    for (int d0 = 0; d0 < 4; ++d0) qr[d0] = *(const bf16x8*)(Qg + row * 512 + head * 64 + d0 * 16 + hi * 8);
    const float* gp = (const float*)(p.ws + WS_GATE) + row * 24 + head;
    const float g0 = gp[0], g1 = gp[8], g2 = gp[16];
    const float* bt = btab + hr * 128;
    f32x16 ot[2]; ot[0] = f32x16{}; ot[1] = f32x16{};
    unsigned char* Kb0 = lds + AT_K; unsigned char* Vb0 = lds + AT_V;
    {
        const bf16_t* CK = (const bf16_t*)(p.ws + WS_CKCP); const bf16_t* CV = (const bf16_t*)(p.ws + WS_CVCP);
#pragma unroll
        for (int t = 0; t < 2; ++t) { const KVregs kv = kv_load(CK, CV, (size_t)b * 128 + 64 * t, t ? 62 : 63, 128, g * 64, tid); kv_store(Kb0 + t * 8192, Vb0 + t * 8192, kv, tid); }
        __syncthreads();
        auto cmp_scores = [&](int t4) -> f32x16 {
            f32x16 sv = qk_sub(Kb0 + (t4 >> 1) * 8192, qr, t4 & 1, r32, hi);
#pragma unroll
            for (int r = 0; r < 16; ++r) { const int c = 32 * t4 + crow(r, hi); const int dist = qpos - (16 * c + 31); const int di = dist < 0 ? 0 : (dist > 127 ? 127 : dist);
                const float bv = bt[di]; sv[r] = (dist >= 0 && c < NC_P) ? sv[r] + bv : -1e30f; }
            return sv; };
        float mx = -1e30f;
#pragma unroll 1
        for (int t4 = 0; t4 < 4; ++t4) { const f32x16 sv = cmp_scores(t4);
#pragma unroll
            for (int r = 0; r < 16; ++r) mx = fmaxf(mx, sv[r]); }
        mx = xhalf_max(mx);
        float ps = 0.f;
#pragma unroll 1
        for (int t4 = 0; t4 < 4; ++t4) { const f32x16 sv = cmp_scores(t4);
#pragma unroll
            for (int r = 0; r < 16; ++r) ps += sv[r] > -1e29f ? exp2f(sv[r] - mx) : 0.f; }
        ps = xhalf_sum(ps);
        const float inv = ps > 0.f ? 1.f / ps : 0.f;
#pragma unroll 1
        for (int t4 = 0; t4 < 4; ++t4) { const f32x16 sv = cmp_scores(t4);
            float pv[16];
#pragma unroll
            for (int r = 0; r < 16; ++r) { const float pn = sv[r] > -1e29f ? exp2f(sv[r] - mx) * inv : 0.f; if (i >= 16 && pn > 0.f) atomicAdd(&imp[ql * 129 + 32 * t4 + crow(r, hi)], pn); pv[r] = pn * g0; }
            pv_sub(ot, Vb0 + (t4 >> 1) * 8192, pv, t4 & 1, lane);
        }
    }
    __syncthreads();
    if (i >= 16) {
        const int q = tid >> 3, jj = tid & 7, jmax = i - 2;
        for (int j = 1 + jj; j <= jmax; j += 8) { const float* ip = imp + q * 129 + 4 * j;
            imps[q * 33 + j] = 0.5f * ip[-1] + ip[0] + ip[1] + ip[2] + 0.5f * ip[3]; }
        __syncthreads();
        for (int j = 1 + jj; j <= jmax; j += 8) { const float vj = imps[q * 33 + j]; int cnt = 0;
            for (int k = 1; k <= jmax; ++k) { const float vk = imps[q * 33 + k]; cnt += (vk > vj || (vk == vj && k < j)) ? 1 : 0; }
            if (cnt < 13) atomicOr(&mask[q], 1u << j); }
        __syncthreads();
    }
    const unsigned selm = mask[ql];
    {
        const bf16_t* KSg = (const bf16_t*)(p.ws + WS_KS); const bf16_t* VSg = (const bf16_t*)(p.ws + WS_VS);
        const bf16_t* KWg = (const bf16_t*)(p.ws + WS_KW); const bf16_t* VWg = (const bf16_t*)(p.ws + WS_VW);
        const int nts = i + 1, t0w = i > 8 ? i - 8 : 0, NT = nts + (i - t0w + 1);
        float m = -1e30f, l = 0.f; f32x16 o[2]; o[0] = f32x16{}; o[1] = f32x16{};
        { const KVregs kv = kv_load(KSg, VSg, (size_t)b * SEQ, 63, 128, g * 64, tid); kv_store(Kb0, Vb0, kv, tid); }
#pragma unroll 1
        for (int t = 0; t < NT; ++t) {
            __syncthreads();
            KVregs nx; const bool more = t + 1 < NT;
            if (more) { const int tn = t + 1; const bool wn = tn >= nts; const int jn = wn ? t0w + tn - nts : tn;
                nx = kv_load(wn ? KWg : KSg, wn ? VWg : VSg, (size_t)b * SEQ + 64 * jn, 63, 128, g * 64, tid); }
            const bool isw = t >= nts; const int j = isw ? t0w + t - nts : t;
            if (t == nts) { l = xhalf_sum(l); const float sc = l > 0.f ? g1 / l : 0.f;
#pragma unroll
                for (int r = 0; r < 16; ++r) { ot[0][r] += sc * o[0][r]; ot[1][r] += sc * o[1][r]; o[0][r] = 0.f; o[1][r] = 0.f; }
                m = -1e30f; l = 0.f; }
            attn_tile(Kb0 + (t & 1) * 8192, Vb0 + (t & 1) * 8192, qr, bt, 64 * j, qpos, isw, (selm >> (j & 31)) & 1u, m, l, o, lane);
            if (more) kv_store(Kb0 + ((t + 1) & 1) * 8192, Vb0 + ((t + 1) & 1) * 8192, nx, tid);
        }
        l = xhalf_sum(l); const float sc = l > 0.f ? g2 / l : 0.f;
#pragma unroll
        for (int r = 0; r < 16; ++r) { ot[0][r] += sc * o[0][r]; ot[1][r] += sc * o[1][r]; }
    }
    bf16_t* AO = (bf16_t*)(p.ws + WS_AO) + row * 1024 + head * 64;
#pragma unroll
    for (int eb = 0; eb < 2; ++eb)
#pragma unroll
        for (int a = 0; a < 4; ++a) { u32x2 ov; ov.x = pk2(ot[eb][4 * a], ot[eb][4 * a + 1]); ov.y = pk2(ot[eb][4 * a + 2], ot[eb][4 * a + 3]); *(u32x2*)(AO + 32 * eb + 8 * a + 4 * hi) = ov; }
    __syncthreads();
}

constexpr int SA_Q = 0, SA_SC = 256, SA_IMP = SA_SC + 4096, SA_IMPS = SA_IMP + 1024, SA_SEL = SA_IMPS + 256, SA_ML = SA_SEL + 16, SA_OB = SA_ML + 8, SA_OT = SA_OB + 512, SA_PART = SA_OT + 256, SA_END = SA_PART + 64 * 256;
__device__ __forceinline__ void dot4_f32(const float* key, const float* q, float* a) {
#pragma unroll 2
    for (int d = 0; d < 64; d += 4) { const f32x4 kv = *(const f32x4*)(key + d);
#pragma unroll
        for (int r = 0; r < 4; ++r) { const f32x4 qv = *(const f32x4*)(q + r * 64 + d); a[r] += kv[0] * qv[0] + kv[1] * qv[1] + kv[2] * qv[2] + kv[3] * qv[3]; } }
}
__device__ __forceinline__ void dot4_bf16(const bf16_t* key, const float* q, float* a) {
#pragma unroll 2
    for (int d = 0; d < 64; d += 8) { const u32x4 kw = *(const u32x4*)(key + d); const float kf[8] = {bflo(kw.x), bfhi(kw.x), bflo(kw.y), bfhi(kw.y), bflo(kw.z), bfhi(kw.z), bflo(kw.w), bfhi(kw.w)};
#pragma unroll
        for (int r = 0; r < 4; ++r) { const f32x4 q0 = *(const f32x4*)(q + r * 64 + d), q1 = *(const f32x4*)(q + r * 64 + d + 4);
            a[r] += kf[0] * q0[0] + kf[1] * q0[1] + kf[2] * q0[2] + kf[3] * q0[3] + kf[4] * q1[0] + kf[5] * q1[1] + kf[6] * q1[2] + kf[7] * q1[3]; } }
}
struct Slot { const float* kf; const float* vf; const bf16_t* kb; const bf16_t* vb; int dist; bool valid; };
template <int BR>
__device__ __forceinline__ Slot sa_slot(const Params& p, int b, int g, int slot, const int* sel, const int* selb) {
    Slot s; s.kf = nullptr; s.vf = nullptr; s.kb = nullptr; s.vb = nullptr; s.valid = true; s.dist = 0;
    const size_t row = (size_t)MP + b;
    if (BR == 0) { const size_t off = ((size_t)(b * 1024 + slot) * 2 + g) * 64; s.kb = (const bf16_t*)(p.ws + WS_CKCS) + off; s.vb = (const bf16_t*)(p.ws + WS_CVCS) + off; s.dist = PAST - (16 * slot + 31); }
    else if (BR == 1) { const int blk = sel[slot >> 6], kk = slot & 63, pos = 64 * blk + kk;
        if (blk == 256) { s.valid = (kk == 0); s.kb = (const bf16_t*)(p.ws + WS_KS) + row * 128 + g * 64; s.vb = (const bf16_t*)(p.ws + WS_VS) + row * 128 + g * 64; s.dist = 0; }
        else { const size_t off = (size_t)selb[slot >> 6] + (size_t)kk * 128; s.kf = p.in[4] + off; s.vf = p.in[5] + off; s.dist = PAST - pos; } }
    else { const int j = slot + 1;
        if (j == 512) { s.kb = (const bf16_t*)(p.ws + WS_KW) + row * 128 + g * 64; s.vb = (const bf16_t*)(p.ws + WS_VW) + row * 128 + g * 64; s.dist = 0; }
        else { const size_t off = (((size_t)b * 512 + j) * 2 + g) * 64; s.kf = p.in[6] + off; s.vf = p.in[7] + off; s.dist = 512 - j; } }
    return s;
}
template <int BR>
__device__ __forceinline__ void sa_branch(const Params& p, float* L, int b, int g, int nslots, const float* btg, const float* gates  ) {
    const int tid = threadIdx.x, lane = tid & 63, w = tid >> 6;
    float* q = L + SA_Q; float* sc = L + SA_SC; float* ml = L + SA_ML; float* ob = L + SA_OB; float* ot = L + SA_OT; const int* sel = (const int*)(L + SA_SEL);
    for (int slot = tid; slot < nslots; slot += 512) {
        const Slot s = sa_slot<BR>(p, b, g, slot, sel, (const int*)(L + SA_IMPS)); float a[4] = {0.f, 0.f, 0.f, 0.f};
        if (s.valid) { if (s.kf) dot4_f32(s.kf, q, a); else dot4_bf16(s.kb, q, a); }
        const int di = s.dist > 127 ? 127 : s.dist;
#pragma unroll
        for (int r = 0; r < 4; ++r) sc[r * 1024 + slot] = s.valid ? a[r] + btg[r * 128 + di] : -1e30f;
    }
    __syncthreads();
    if (w < 4) { float mx = -1e30f;
        for (int s = lane; s < nslots; s += 64) mx = fmaxf(mx, sc[w * 1024 + s]);
#pragma unroll
        for (int of = 1; of < 64; of <<= 1) mx = fmaxf(mx, __shfl_xor(mx, of));
        float sum = 0.f;
        for (int s = lane; s < nslots; s += 64) { const float v = sc[w * 1024 + s]; const float e = v > -1e29f ? exp2f(v - mx) : 0.f; sc[w * 1024 + s] = e; sum += e; }
#pragma unroll
        for (int of = 1; of < 64; of <<= 1) sum += __shfl_xor(sum, of);
        const float inv = sum > 0.f ? 1.f / sum : 0.f;
        for (int s = lane; s < nslots; s += 64) sc[w * 1024 + s] *= inv;
    }
    __syncthreads();
    { const int sl = tid >> 3, e0 = (tid & 7) * 8; float acc[4][8];
#pragma unroll
      for (int r = 0; r < 4; ++r)
#pragma unroll
          for (int e = 0; e < 8; ++e) acc[r][e] = 0.f;
      const size_t row = (size_t)MP + b;
      const int* selb = (const int*)(L + SA_IMPS);
#pragma unroll 4
      for (int slot = sl; slot < nslots; slot += 64) {
          float pr[4];
#pragma unroll
          for (int r = 0; r < 4; ++r) pr[r] = sc[r * 1024 + slot];
          const float* vf = nullptr; const bf16_t* vb = nullptr;
          if (BR == 0) vb = (const bf16_t*)(p.ws + WS_CVCS) + ((size_t)(b * 1024 + slot) * 2 + g) * 64;
          else if (BR == 1) { const int si = slot >> 6, kk = slot & 63; if (sel[si] == 256) vb = (const bf16_t*)(p.ws + WS_VS) + row * 128 + g * 64; else vf = p.in[5] + (size_t)selb[si] + (size_t)kk * 128; }
          else { if (slot == 511) vb = (const bf16_t*)(p.ws + WS_VW) + row * 128 + g * 64; else vf = p.in[7] + (((size_t)b * 512 + slot + 1) * 2 + g) * 64; }
          float vv[8];
          if (vf) { const f32x4 a0 = *(const f32x4*)(vf + e0), a1 = *(const f32x4*)(vf + e0 + 4); vv[0] = a0[0]; vv[1] = a0[1]; vv[2] = a0[2]; vv[3] = a0[3]; vv[4] = a1[0]; vv[5] = a1[1]; vv[6] = a1[2]; vv[7] = a1[3]; }
          else { const u32x4 w = *(const u32x4*)(vb + e0); vv[0] = bflo(w.x); vv[1] = bfhi(w.x); vv[2] = bflo(w.y); vv[3] = bfhi(w.y); vv[4] = bflo(w.z); vv[5] = bfhi(w.z); vv[6] = bflo(w.w); vv[7] = bfhi(w.w); }
#pragma unroll
          for (int r = 0; r < 4; ++r)
#pragma unroll
              for (int e = 0; e < 8; ++e) acc[r][e] += pr[r] * vv[e];
      }
      float* part = L + SA_PART;
#pragma unroll
      for (int r = 0; r < 4; ++r) { *(f32x4*)(part + sl * 256 + r * 64 + e0) = (f32x4){acc[r][0], acc[r][1], acc[r][2], acc[r][3]}; *(f32x4*)(part + sl * 256 + r * 64 + e0 + 4) = (f32x4){acc[r][4], acc[r][5], acc[r][6], acc[r][7]}; }
    }
    __syncthreads();
    if (tid < 256) { float a = 0.f; const float* part = L + SA_PART;
#pragma unroll 8
        for (int q = 0; q < 64; ++q) a += part[q * 256 + tid];
        ob[tid] = a; ob[256 + tid] = 0.f; }
    if (tid < 256) { const int r = tid >> 6; ot[tid] += gates[r] * (ob[tid] + ob[256 + tid]); }
    __syncthreads();
    (void)ml;
}
__device__ __forceinline__ void attn_sample_unit(const Params& p, unsigned char* lds, int b, int g) {
    const int tid = threadIdx.x;
    float* L = (float*)lds; float* q = L + SA_Q; float* sc = L + SA_SC; float* imp = L + SA_IMP; float* imps = L + SA_IMPS; int* sel = (int*)(L + SA_SEL); float* ot = L + SA_OT; float* gsh = L + SA_ML;
    const size_t row = (size_t)MP + b;
    if (tid < 256) { q[tid] = bf1(((const bf16_t*)(p.ws + WS_Q))[row * 512 + g * 256 + tid]); ot[tid] = 0.f; }
    __syncthreads();
    const float* btg = (const float*)(p.ws + WS_BTAB) + (g * 4) * 128;
    const float* GT = (const float*)(p.ws + WS_GATE) + row * 24 + g * 4;
    sa_branch<0>(p, L, b, g, NC_S, btg, GT);
    for (int c = tid; c < NC_S; c += 512) imp[c] = sc[c] + sc[1024 + c] + sc[2048 + c] + sc[3072 + c];
    __syncthreads();
    if (tid >= 1 && tid <= 254) { const int j = tid; imps[j] = 0.5f * imp[4 * j - 1] + imp[4 * j] + imp[4 * j + 1] + imp[4 * j + 2] + 0.5f * imp[4 * j + 3]; }
    if (tid == 0) { sel[0] = 0; sel[1] = 255; sel[2] = 256; }
    __syncthreads();
    if (tid >= 1 && tid <= 254) { const float vj = imps[tid]; int cnt = 0;
        for (int k = 1; k <= 254; ++k) { const float vk = imps[k]; cnt += (vk > vj || (vk == vj && k < tid)) ? 1 : 0; }
        if (cnt < 13) sel[3 + cnt] = tid; }
    __syncthreads();
    if (tid < 16) { const int blk = sel[tid]; int off = 0;
        if (blk < 256) { const int page = p.page_table[b * NPAGES + (blk >> 1)]; off = ((page * PAGE + (blk & 1) * 64) * 2 + g) * 64; }
        ((int*)imps)[tid] = off; }
    __syncthreads();
    sa_branch<1>(p, L, b, g, 1024, btg, GT + 8);
    sa_branch<2>(p, L, b, g, 512, btg, GT + 16);
    if (tid < 256) { const unsigned pk = pk2(ot[tid], 0.f); ((bf16_t*)(p.ws + WS_AO))[row * 1024 + g * 256 + tid] = (bf16_t)(pk & 0xffffu); }
    __syncthreads();
    (void)gsh;
}

constexpr int LDS_BYTES = pg8::STAGE_BYTES + 256;
constexpr int NPHASE = 9;
#ifndef REPEAT_PHASE
#define REPEAT_PHASE -1
#endif
template <int K> __device__ __forceinline__ void phase_body(const Params& p, unsigned char* lds) {
    const int tid = threadIdx.x, bid = blockIdx.x, G = gridDim.x;
    const int wv = __builtin_amdgcn_readfirstlane(tid >> 6);
    unsigned char* ws = p.ws;
    if constexpr (K == 0) phase_prologue(p, lds);
    if constexpr (K == 1) {
        pg8::Gemm g{(const bf16_t*)(ws + WS_XB), (const bf16_t*)(ws + WS_W1), MR, N1, DM};
        {   SubsetOrder S; S.init(MR, 7 * 256, G, bid); S.set = 0;
            EpiProj<0> E; E.ss1 = (const float*)(ws + WS_SS1); E.qn = p.in[14]; E.kn = p.in[15]; E.rot = (const float*)(ws + WS_ROT);
            E.Q = (bf16_t*)(ws + WS_Q); E.CA = (bf16_t*)(ws + WS_CA); E.KS = (bf16_t*)(ws + WS_KS); E.VS = (bf16_t*)(ws + WS_VS); E.KW = (bf16_t*)(ws + WS_KW); E.VW = (bf16_t*)(ws + WS_VW);
            E.RQ = (bf16_t*)(ws + WS_RQ); E.RK = (bf16_t*)(ws + WS_RK); E.RV = (bf16_t*)(ws + WS_RV); E.RG = (bf16_t*)(ws + WS_RG); E.GATE = (float*)(ws + WS_GATE); E.out = p.out;
            pg8::gemm_phase((LAS unsigned char*)lds, g, S, E); }
        {   SubsetOrder S; S.init(MR, 7 * 256, G, bid); S.set = 1;
            EpiProj<1> E; E.ss1 = (const float*)(ws + WS_SS1); E.qn = p.in[14]; E.kn = p.in[15]; E.rot = (const float*)(ws + WS_ROT);
            E.Q = (bf16_t*)(ws + WS_Q); E.CA = (bf16_t*)(ws + WS_CA); E.KS = (bf16_t*)(ws + WS_KS); E.VS = (bf16_t*)(ws + WS_VS); E.KW = (bf16_t*)(ws + WS_KW); E.VW = (bf16_t*)(ws + WS_VW);
            E.RQ = (bf16_t*)(ws + WS_RQ); E.RK = (bf16_t*)(ws + WS_RK); E.RV = (bf16_t*)(ws + WS_RV); E.RG = (bf16_t*)(ws + WS_RG); E.GATE = (float*)(ws + WS_GATE); E.out = p.out;
            pg8::gemm_phase((LAS unsigned char*)lds, g, S, E); }
    }
    if constexpr (K == 2) {
        { pg8::Gemm g{(const bf16_t*)(ws + WS_CA), (const bf16_t*)(ws + WS_W1C), 2 * CROWS, 256, 1024};
          CmpOrder S; S.G = G; S.c = bid; EpiCmp E; E.C = (float*)(ws + WS_CP);
          pg8::gemm_phase((LAS unsigned char*)lds, g, S, E); }
        __syncthreads();
        for (int u = bid; u < NB * 4 * 16; u += G) ret_r1_unit(p, lds, u >> 6, (u >> 4) & 3, u & 15);
        for (int u = bid; u < DB * 4; u += G) ret_sample_unit(p, lds, u >> 2, u & 3);
    }
    if constexpr (K == 3) {
        for (int u = bid; u < NB * 4 * 16; u += G) ret_r2_unit(p, lds, u >> 6, (u >> 4) & 3, u & 15);
        constexpr int NT = CROWS / 32;
        for (int t = bid * 8 + wv; t < 2 * NT; t += G * 8) compress2_task(p, t / NT, t % NT, tid & 63);
        pret_job(p);
    }
    if constexpr (K == 4) {
        unsigned* qh = (unsigned*)(ws + WS_QUEUE);
        volatile LAS unsigned* qs = (volatile LAS unsigned*)(lds + pg8::STAGE_BYTES + 16);
        for (;;) {
            if (tid == 0) *qs = __hip_atomic_fetch_add(qh, 1u, __ATOMIC_RELAXED, __HIP_MEMORY_SCOPE_AGENT);
            __syncthreads();
            const unsigned it = *qs;
            __syncthreads();
            if (it >= 576u) break;
            if (it < 64u) attn_sample_unit(p, lds, (int)(it >> 1), (int)(it & 1));
            else { const int q = (int)it - 64, bg = q & 15; attn_prompt_unit(p, lds, bg >> 1, bg & 1, 31 - (q >> 4)); }
        }
    }
    if constexpr (K == 5) {
        pg8::Gemm g{(const bf16_t*)(ws + WS_AO), (const bf16_t*)(ws + WS_WO), MR, DM, DM};
        pg8::StaticOrder S; S.init(MR, DM, G, bid);
        EpiOut E; E.xp = p.in[0]; E.xs = p.in[1]; E.H = (float*)(ws + WS_H); E.HB = (bf16_t*)(ws + WS_HB); E.SS2 = (float*)(ws + WS_SS2);
        pg8::gemm_phase((LAS unsigned char*)lds, g, S, E);
    }
    if constexpr (K == 6) {
        pg8::Gemm g{(const bf16_t*)(ws + WS_HB), (const bf16_t*)(ws + WS_WGU), MR, NGU, DM};
        pg8::StaticOrder S; S.init(MR, NGU, G, bid);
        EpiGU E; E.SS2 = (const float*)(ws + WS_SS2); E.ACT = (bf16_t*)(ws + WS_ACT);
        pg8::gemm_phase((LAS unsigned char*)lds, g, S, E);
    }
    if constexpr (K == 7) {
        { pg8::Gemm g{(const bf16_t*)(ws + WS_ACT), (const bf16_t*)(ws + WS_WD), MR, DM, DFF};
          pg8::StaticOrder S; S.init(MR, DM, G, bid);
          EpiDown E; E.H = (const float*)(ws + WS_H); E.H2 = (float*)(ws + WS_H2); E.H2B = (bf16_t*)(ws + WS_H2B);
          pg8::gemm_phase((LAS unsigned char*)lds, g, S, E); }
        { pg8::Gemm g{(const bf16_t*)(ws + WS_PB), (const bf16_t*)(ws + WS_WPP), MR, DM, PLE};
          pg8::StaticOrder S; S.init(MR, DM, G, bid);
          EpiF32 E; E.C = (float*)(ws + WS_VP); E.ld = DM;
          pg8::gemm_phase((LAS unsigned char*)lds, g, S, E); }
    }
    if constexpr (K == 8) {
        pg8::Gemm g{(const bf16_t*)(ws + WS_H2B), (const bf16_t*)(ws + WS_WPG), MR, DM, DM};
        pg8::StaticOrder S; S.init(MR, DM, G, bid);
        EpiFinal E; E.H2 = (const float*)(ws + WS_H2); E.VP = (const float*)(ws + WS_VP); E.out = p.out;
        pg8::gemm_phase((LAS unsigned char*)lds, g, S, E);
    }
}
__global__ void __launch_bounds__(512, 2) nsa_ret_fwd(Params p) {
    extern __shared__ __attribute__((aligned(16))) unsigned char lds[];
    const int tid = threadIdx.x;
    unsigned char* ws = p.ws;
    if (tid < 4) ((LAS unsigned*)(lds + pg8::STAGE_BYTES))[tid] = 0u;
    __syncthreads();
    const bool fused = (p.ph_hi - p.ph_lo) > 1;
    XcdBarrier bar; bar.bar = (unsigned*)(ws + WS_CTL); bar.x = 0; bar.st = (volatile LAS unsigned*)(lds + pg8::STAGE_BYTES);
    if (fused) bar = xcd_barrier_post((unsigned*)(ws + WS_CTL), (volatile LAS unsigned*)(lds + pg8::STAGE_BYTES));
#define PH_ON(k) (p.ph_lo <= (k) && (k) < p.ph_hi)
#define SEAM(k) do { if (PH_ON(k) && PH_ON((k) + 1)) xcd_barrier(bar); } while (0)
#define PHASE(k) do { if (PH_ON(k)) { phase_body<k>(p, lds); if (REPEAT_PHASE == (k)) { __syncthreads(); phase_body<k>(p, lds); } } } while (0)
    PHASE(0); SEAM(0);
    PHASE(1); SEAM(1);
    PHASE(2); SEAM(2);
    PHASE(3); SEAM(3);
    PHASE(4); SEAM(4);
    PHASE(5); SEAM(5);
    PHASE(6); SEAM(6);
    PHASE(7); SEAM(7);
    PHASE(8);
}

extern "C" void kernel_launch(void* const* d_in, const int* in_sizes, int n_in, void* d_out, int out_size, void* d_ws, size_t ws_size, hipStream_t stream) {
    static int grid = 0;
    if (grid == 0) {
        if (n_in != 31 || (size_t)out_size != O_END || ws_size < WS_END) { fprintf(stderr, "kernel_launch: unexpected shapes: n_in %d out %d ws %zu (need %zu)\n", n_in, out_size, ws_size, (size_t)WS_END); grid = -1; return; }
        int dev = 0, cus = 0;
        if (hipGetDevice(&dev) != hipSuccess || hipDeviceGetAttribute(&cus, hipDeviceAttributeMultiprocessorCount, dev) != hipSuccess) { grid = -1; return; }
        if (hipFuncSetAttribute((const void*)nsa_ret_fwd, hipFuncAttributeMaxDynamicSharedMemorySize, LDS_BYTES) != hipSuccess) { fprintf(stderr, "kernel_launch: hipFuncSetAttribute failed\n"); grid = -1; return; }
        int per_cu = 0;
        if (hipOccupancyMaxActiveBlocksPerMultiprocessor(&per_cu, (const void*)nsa_ret_fwd, 512, LDS_BYTES) != hipSuccess || per_cu < 1) { fprintf(stderr, "kernel_launch: occupancy query says %d blocks per CU\n", per_cu); }
        (void)hipGetLastError();
        grid = cus;
    }
    if (grid < 0) return;
    (void)hipMemsetAsync((char*)d_ws + WS_CTL, 0, CTL_BYTES, stream);
    Params p; memset(&p, 0, sizeof(p));
    for (int i = 0; i < 31; ++i) p.in[i] = (const float*)d_in[i];
    p.page_table = (const int*)d_in[9]; p.out = (float*)d_out; p.ws = (unsigned char*)d_ws;
#if MK_PER_PHASE_LAUNCH
    for (int ph = 0; ph < NPHASE; ++ph) { p.ph_lo = ph; p.ph_hi = ph + 1; hipLaunchKernelGGL(nsa_ret_fwd, dim3(grid), dim3(512), LDS_BYTES, stream, p); }
#else
    p.ph_lo = 0; p.ph_hi = NPHASE; hipLaunchKernelGGL(nsa_ret_fwd, dim3(grid), dim3(512), LDS_BYTES, stream, p);
#endif
}
```

```cpp
#include <hip/hip_runtime.h>
#include <cstdio>
#include <cstdint>
#include <cstring>

#ifndef MK_PER_PHASE_LAUNCH
#define MK_PER_PHASE_LAUNCH 0
#endif

constexpr int DM = 1024, NB = 8, SEQ = 2048, DB = 32, PAST = 16384, PAGE = 128, NPAGES = 128;
constexpr int MP = NB * SEQ;
constexpr int MV = MP + DB;
constexpr int MR = 16640;
constexpr int INC = 3352, N1 = 3584, DFF = 2816, NGU = 5632, PLE = 256;
constexpr int NSEG_S = 1024, NSEG_P = 128;
constexpr int CROWS_S = DB * NSEG_S * 2;
constexpr int CROWS_P = NB * NSEG_P * 2;
constexpr int CROWS = CROWS_S + CROWS_P;
constexpr int NC_P = 127, NC_S = 1023;
constexpr float EPS = 1e-6f;
constexpr float LOG2E = 1.4426950408889634f;

constexpr size_t O_YP = 0, O_YS = O_YP + (size_t)MP * DM, O_PCK = O_YS + (size_t)DB * DM, O_PCV = O_PCK + (size_t)MP * 128, O_PSK = O_PCV + (size_t)MP * 128,
                 O_PSV = O_PSK + (size_t)MP * 128, O_PWK = O_PSV + (size_t)MP * 128, O_PWV = O_PWK + (size_t)NB * 512 * 128, O_PRET = O_PWV + (size_t)NB * 512 * 128,
                 O_SCK = O_PRET + (size_t)NB * 4 * 128 * 128, O_SCV = O_SCK + DB * 128, O_SSK = O_SCV + DB * 128, O_SSV = O_SSK + DB * 128, O_SWK = O_SSV + DB * 128,
                 O_SWV = O_SWK + (size_t)DB * 512 * 128, O_SRET = O_SWV + (size_t)DB * 512 * 128, O_END = O_SRET + (size_t)DB * 4 * 128 * 128;

constexpr size_t al256(size_t x) { return (x + 255) & ~(size_t)255; }
constexpr size_t WS_CTL = 0, CTL_BYTES = 16384;
constexpr size_t WS_W1 = WS_CTL + CTL_BYTES;
constexpr size_t WS_WO = WS_W1 + (size_t)N1 * DM * 2;
constexpr size_t WS_WGU = WS_WO + (size_t)DM * DM * 2;
constexpr size_t WS_WD = WS_WGU + (size_t)NGU * DM * 2;
constexpr size_t WS_WPG = WS_WD + (size_t)DM * DFF * 2;
constexpr size_t WS_WPP = WS_WPG + (size_t)DM * DM * 2;
constexpr size_t WS_W1C = WS_WPP + (size_t)DM * PLE * 2;
constexpr size_t WS_W2C = WS_W1C + (size_t)2 * 256 * 1024 * 2;
constexpr size_t WS_BIASC = WS_CTL + 14336;
constexpr size_t WS_QUEUE = WS_CTL + 15360;
constexpr size_t WS_BTAB = WS_W2C + (size_t)2 * 64 * 128 * 2;
constexpr size_t WS_ROT = WS_BTAB + 4096;
constexpr size_t WS_SS1 = al256(WS_ROT + (size_t)2049 * 64 * 8);
constexpr size_t WS_SS2 = WS_SS1 + (size_t)MR * 4;
constexpr size_t WS_XB = al256(WS_SS2 + (size_t)MR * 4);
constexpr size_t WS_PB = WS_XB + (size_t)MR * DM * 2;
constexpr size_t WS_Q = WS_PB + (size_t)MR * PLE * 2;
constexpr size_t WS_KS = WS_Q + (size_t)MR * 512 * 2;
constexpr size_t WS_VS = WS_KS + (size_t)MR * 128 * 2;
constexpr size_t WS_KW = WS_VS + (size_t)MR * 128 * 2;
constexpr size_t WS_VW = WS_KW + (size_t)MR * 128 * 2;
constexpr size_t WS_RQ = WS_VW + (size_t)MR * 128 * 2;
constexpr size_t WS_RK = WS_RQ + (size_t)MR * 512 * 2;
constexpr size_t WS_RV = WS_RK + (size_t)MR * 512 * 2;
constexpr size_t WS_RG = WS_RV + (size_t)MR * 512 * 2;
constexpr size_t WS_GATE = WS_RG + (size_t)MR * 512 * 2;
constexpr size_t WS_CA = al256(WS_GATE + (size_t)MR * 24 * 4);
constexpr size_t WS_CP = WS_CA + (size_t)2 * CROWS * 1024 * 2;
constexpr size_t WS_CKCP = WS_CP + (size_t)2 * CROWS * 256 * 4;
constexpr size_t WS_CVCP = WS_CKCP + (size_t)NB * 128 * 128 * 2;
constexpr size_t WS_CKCS = WS_CVCP + (size_t)NB * 128 * 128 * 2;
constexpr size_t WS_CVCS = WS_CKCS + (size_t)DB * 1024 * 128 * 2;
constexpr size_t WS_KVT = WS_CVCS + (size_t)DB * 1024 * 128 * 2;
constexpr size_t WS_AO = WS_KVT + (size_t)NB * 4 * 16 * 16384 * 4;
constexpr size_t WS_H = WS_AO + (size_t)MR * DM * 2;
constexpr size_t WS_HB = WS_H + (size_t)MR * DM * 4;
constexpr size_t WS_ACT = WS_HB + (size_t)MR * DM * 2;
constexpr size_t WS_H2 = WS_ACT + (size_t)MR * DFF * 2;
constexpr size_t WS_H2B = WS_H2 + (size_t)MR * DM * 4;
constexpr size_t WS_VP = WS_H2B + (size_t)MR * DM * 2;
constexpr size_t WS_END = WS_VP + (size_t)MR * DM * 4;

typedef unsigned short bf16_t;
typedef short bf16x8 __attribute__((ext_vector_type(8)));
typedef short s16x4 __attribute__((ext_vector_type(4)));
typedef float f32x4 __attribute__((ext_vector_type(4)));
typedef float f32x16 __attribute__((ext_vector_type(16)));
typedef unsigned u32x4 __attribute__((ext_vector_type(4)));
typedef unsigned u32x2 __attribute__((ext_vector_type(2)));
typedef float f32x2_t __attribute__((ext_vector_type(2)));
typedef __bf16 bf16x2_t __attribute__((ext_vector_type(2)));
#define LAS __attribute__((address_space(3)))

__device__ __forceinline__ unsigned pk2(float lo, float hi) { f32x2_t v = {lo, hi}; bf16x2_t b = __builtin_convertvector(v, bf16x2_t); return __builtin_bit_cast(unsigned, b); }
__device__ __forceinline__ float bflo(unsigned w) { return __uint_as_float(w << 16); }
__device__ __forceinline__ float bfhi(unsigned w) { return __uint_as_float(w & 0xffff0000u); }
__device__ __forceinline__ float bf1(bf16_t b) { return __uint_as_float(((unsigned)b) << 16); }
__device__ __forceinline__ float sigmoidf_(float x) { return 1.f / (1.f + __expf(-x)); }
__device__ __forceinline__ float siluf_(float x) { return x / (1.f + __expf(-x)); }
__device__ __forceinline__ int crow(int r, int hi) { return (r & 3) + 8 * (r >> 2) + 4 * hi; }
__device__ __forceinline__ float xhalf_max(float v) { auto rr = __builtin_amdgcn_permlane32_swap(__float_as_uint(v), __float_as_uint(v), false, false); return fmaxf(__uint_as_float(rr[0]), __uint_as_float(rr[1])); }
__device__ __forceinline__ float xhalf_sum(float v) { auto rr = __builtin_amdgcn_permlane32_swap(__float_as_uint(v), __float_as_uint(v), false, false); return __uint_as_float(rr[0]) + __uint_as_float(rr[1]); }

struct Params {
    const float* in[31];
    const int* page_table;
    float* out;
    unsigned char* ws;
    int ph_lo, ph_hi;
};

#define XB_TMO      128
#define XB_XCNT(j)  (256  + 64 * (j))
#define XB_XSUB(j)  (1280 + 64 * (j))
#define XB_XGEN(j)  (2304 + 64 * (j))
#define XB_TOP      3328
#define XB_TOPGEN   3392
#define XCD_BAR_WORDS 3456
#define XB_SPIN_CAP (1u << 18)
__device__ __forceinline__ unsigned xb_ld(unsigned* p)              { return __hip_atomic_load(p, __ATOMIC_RELAXED, __HIP_MEMORY_SCOPE_AGENT); }
__device__ __forceinline__ unsigned xb_add(unsigned* p, unsigned v) { return __hip_atomic_fetch_add(p, v, __ATOMIC_RELAXED, __HIP_MEMORY_SCOPE_AGENT); }
__device__ __forceinline__ unsigned xb_xcc_id() { return (unsigned)__builtin_amdgcn_s_getreg((3 << 11) | 20) & 0xFu; }
#define XB_SPIN(cond, bar) do { unsigned _sp = 0; while (cond) { __builtin_amdgcn_s_sleep(1); \
    if ((++_sp & 255u) == 0u) { if (xb_ld(&(bar)[XB_TMO])) break; if (_sp > XB_SPIN_CAP) { atomicAdd(&(bar)[XB_TMO], 1u); break; } } } } while (0)
struct XcdBarrier { unsigned* bar; unsigned x; volatile LAS unsigned* st; };
__device__ __forceinline__ XcdBarrier xcd_barrier_post(unsigned* bar, volatile LAS unsigned* st) {
    XcdBarrier b; b.bar = bar; b.x = xb_xcc_id(); b.st = st;
    if (threadIdx.x == 0) (void)xb_add(&bar[XB_XCNT(b.x)], 1u);
    return b;
}
__device__ __forceinline__ void xcd_barrier_complete(unsigned* bar, unsigned x, unsigned& nloc, unsigned& nx) {
    const unsigned G = gridDim.x * gridDim.y * gridDim.z;
    unsigned sum, cnt, mine, sp = 0u;
    for (;;) {
        sum = 0u; cnt = 0u; mine = 0u;
#pragma unroll
        for (unsigned j = 0; j < 16; ++j) { const unsigned c = xb_ld(&bar[XB_XCNT(j)]); sum += c; cnt += (c > 0u) ? 1u : 0u; mine = (j == x) ? c : mine; }
        if (sum == G) break;
        __builtin_amdgcn_s_sleep(1);
        if ((++sp & 255u) == 0u) { if (xb_ld(&bar[XB_TMO])) break; if (sp > XB_SPIN_CAP) { atomicAdd(&bar[XB_TMO], 1u); break; } }
    }
    nloc = mine > 0u ? mine : 1u; nx = cnt > 0u ? cnt : 1u;
}
__device__ __forceinline__ void xcd_barrier(const XcdBarrier& b) {
    asm volatile("s_waitcnt vmcnt(0)" ::: "memory");
    __syncthreads();
    if (threadIdx.x == 0) {
        unsigned* bar = b.bar;
        __builtin_amdgcn_s_waitcnt(0);
        unsigned nloc = b.st[0], nx = b.st[1];
        if (nloc == 0u) { xcd_barrier_complete(bar, b.x, nloc, nx); b.st[0] = nloc; b.st[1] = nx; }
        const unsigned old = xb_add(&bar[XB_XSUB(b.x)], 1u);
        const unsigned gen = old / nloc;
        if (old + 1u == (gen + 1u) * nloc) {
            __builtin_amdgcn_fence(__ATOMIC_RELEASE, "agent");
            asm volatile("s_waitcnt vmcnt(0)" ::: "memory");
            const unsigned og = xb_add(&bar[XB_TOP], 1u);
            const unsigned tg = og / nx;
            if (og + 1u == (tg + 1u) * nx) xb_add(&bar[XB_TOPGEN], 1u);
            else XB_SPIN(xb_ld(&bar[XB_TOPGEN]) == tg, bar);
            __builtin_amdgcn_fence(__ATOMIC_ACQUIRE, "agent");
            xb_add(&bar[XB_XGEN(b.x)], 1u);
            asm volatile("s_waitcnt vmcnt(0)" ::: "memory");
        } else {
            XB_SPIN(xb_ld(&bar[XB_XGEN(b.x)]) == gen, bar);
            __builtin_amdgcn_fence(__ATOMIC_ACQUIRE, "agent");
            asm volatile("s_waitcnt vmcnt(0)" ::: "memory");
        }
    }
    __syncthreads();
}

namespace pg8 {
constexpr int BM = 256, BK = 64, HALF = 128, HTB = HALF * BK * 2, STAGE_BYTES = 8 * HTB, NXCD = 8, WGM = 8;
__host__ __device__ __forceinline__ int lds_byte(int r, int c) { const int st = (r >> 4) * 2 + (c >> 5), rr = r & 15, cc = c & 31, ob = rr * 64 + cc * 2; return st * 1024 + (ob ^ (((ob >> 9) & 1) << 5)); }
__host__ __device__ __forceinline__ void stage_rc(int b, int& R, int& C) { const int st = b / 1024, sb = b % 1024, swz = sb ^ (((sb >> 9) & 1) << 5); R = (st >> 1) * 16 + swz / 64; C = (st & 1) * 32 + (swz % 64) / 2; }
__host__ __device__ __forceinline__ int perm32(int rho) { const int n = rho >> 4, i = rho & 15; return 8 * (i >> 2) + 4 * n + (i & 3); }
struct Unit { int pm, pn; };
struct Gemm { const bf16_t* A; const bf16_t* Bt; int M, N, K; };
struct StaticOrder {
    int nM, nN, nwg, G, c;
    __host__ __device__ void init(int M, int N, int G_, int c_) { nM = M / BM; nN = N / BM; nwg = nM * nN; G = G_; c = c_; }
    __host__ __device__ bool next(int i, Unit& u) const {
        const long L = (long)i * G + c; if (L >= nwg) return false;
        int wgid = (int)L; { const int q = nwg / NXCD, r = nwg % NXCD, xcd = wgid % NXCD, off = wgid / NXCD; wgid = (xcd < r ? xcd * (q + 1) : r * (q + 1) + (xcd - r) * q) + off; }
        const int nig = WGM * nN, gid = wgid / nig, fm = gid * WGM, gsz = (nM - fm) < WGM ? (nM - fm) : WGM;
        u.pm = fm + ((wgid % nig) % gsz); u.pn = (wgid % nig) / gsz; return true;
    }
    __device__ __forceinline__ void a_ready(const Unit&) const {}
    __device__ __forceinline__ void done(const Unit&) const {}
};
template <class Epi, class Sched>
__device__ __forceinline__ void gemm_phase(LAS unsigned char* lds, const Gemm g, const Sched& S, const Epi& E) {
    const int tid = threadIdx.x, wid = __builtin_amdgcn_readfirstlane(tid >> 6), lane = tid & 63, wr = wid >> 2, wc = wid & 3, fr = lane & 15, fq = lane >> 4;
    const int K = g.K, nt = K / BK;
    unsigned voffA[2], voffB[2];
#pragma unroll
    for (int i = 0; i < 2; ++i) { int R, C; stage_rc(tid * 16 + i * 8192, R, C); const int Rb = Epi::PERM ? ((R & ~31) + perm32(R & 31)) : R;
        voffA[i] = (unsigned)(R * K + C) * 2u; voffB[i] = (unsigned)(Rb * K + C) * 2u; }
    const size_t kstep = (size_t)(BK * 2);
    const size_t hstep = (size_t)HALF * K * 2;
    const size_t tstep = 2 * hstep;
    const unsigned ldsw = (unsigned)wid * 1024u;
    const int aoff = lds_byte(wr * 64 + fr, fq * 8), boff = lds_byte(wc * 32 + fr, fq * 8);
#define PG8_SA(b, h) (((b) * 2 + (h)) * HTB)
#define PG8_SB(b, h) ((4 + (b) * 2 + (h)) * HTB)
#define PG8_STAGE(bufoff, gbase, voff) do { _Pragma("unroll") for (int _i = 0; _i < 2; ++_i) \
        __builtin_amdgcn_global_load_lds((const unsigned*)((const char*)(gbase) + (voff)[_i]), (LAS unsigned*)(lds + (bufoff) + ldsw + _i * 8192), 16, 0, 0); } while (0)
#define PG8_LDA(dst, b, h) do { _Pragma("unroll") for (int m = 0; m < 4; ++m) _Pragma("unroll") for (int k = 0; k < 2; ++k) dst[m][k] = *(const LAS bf16x8*)(lds + PG8_SA(b, h) + aoff + m * 2048 + k * 1024); } while (0)
#define PG8_LDB(dst, b, h) do { _Pragma("unroll") for (int n = 0; n < 2; ++n) _Pragma("unroll") for (int k = 0; k < 2; ++k) dst[n][k] = *(const LAS bf16x8*)(lds + PG8_SB(b, h) + boff + n * 2048 + k * 1024); } while (0)
#define PG8_MMA(ai, bj, At, Bt) do { __builtin_amdgcn_s_setprio(1); _Pragma("unroll") for (int m = 0; m < 4; ++m) _Pragma("unroll") for (int n = 0; n < 2; ++n) _Pragma("unroll") for (int k = 0; k < 2; ++k) \
        acc[ai][bj][m][n] = __builtin_amdgcn_mfma_f32_16x16x32_bf16(Bt[n][k], At[m][k], acc[ai][bj][m][n], 0, 0, 0); __builtin_amdgcn_s_setprio(0); } while (0)
#define PG8_WAIT_V(n) asm volatile("s_waitcnt vmcnt(" #n ")" ::: "memory")
#define PG8_WAIT_L(n) asm volatile("s_waitcnt lgkmcnt(" #n ")" ::: "memory")
#define PG8_BAR __builtin_amdgcn_s_barrier()
#define PG8_SCHED __builtin_amdgcn_sched_barrier(0)
    Unit cur, nxt; int ui = 0;
    if (!S.next(0, cur)) return;
    f32x4 acc[2][2][4][2];
#pragma unroll
    for (int a = 0; a < 2; ++a)
#pragma unroll
        for (int b = 0; b < 2; ++b)
#pragma unroll
            for (int m = 0; m < 4; ++m)
#pragma unroll
                for (int n = 0; n < 2; ++n) acc[a][b][m][n] = (f32x4){0.f, 0.f, 0.f, 0.f};
    bf16x8 At[4][2], B0[2][2], B1[2][2];
    const char* cA = (const char*)g.A + (size_t)cur.pm * tstep; const char* cB = (const char*)g.Bt + (size_t)cur.pn * tstep;
    S.a_ready(cur);
    PG8_STAGE(PG8_SB(0, 0), cB, voffB); PG8_STAGE(PG8_SA(0, 0), cA, voffA); PG8_STAGE(PG8_SB(0, 1), cB + hstep, voffB); PG8_STAGE(PG8_SA(0, 1), cA + hstep, voffA);
    if (wr == 1) PG8_BAR;
    PG8_WAIT_V(4); PG8_BAR;
    PG8_STAGE(PG8_SB(1, 0), cB + kstep, voffB); PG8_STAGE(PG8_SA(1, 0), cA + kstep, voffA); PG8_STAGE(PG8_SB(1, 1), cB + hstep + kstep, voffB);
    PG8_WAIT_V(6); PG8_BAR;
    for (;;) {
        const bool has_next = S.next(ui + 1, nxt);
        const char* nA = has_next ? (const char*)g.A + (size_t)nxt.pm * tstep : cA; const char* nB = has_next ? (const char*)g.Bt + (size_t)nxt.pn * tstep : cB;
        for (int t = 0; t < nt; t += 2) {
            const bool last = (t == nt - 2);
            const char* a1 = cA + (size_t)(t + 1) * kstep;
            const char* a2 = last ? nA : cA + (size_t)(t + 2) * kstep; const char* b2 = last ? nB : cB + (size_t)(t + 2) * kstep;
            const char* a3 = a2 + kstep; const char* b3 = b2 + kstep;
            if (last && has_next) S.a_ready(nxt);
            PG8_LDB(B0, 0, 0); PG8_SCHED; PG8_LDA(At, 0, 0); PG8_STAGE(PG8_SA(1, 1), a1 + hstep, voffA);
            PG8_WAIT_L(8); PG8_BAR; PG8_WAIT_L(0); PG8_MMA(0, 0, At, B0); PG8_BAR; PG8_SCHED;
            PG8_LDB(B1, 0, 1); PG8_STAGE(PG8_SB(0, 0), b2, voffB);
            PG8_BAR; PG8_WAIT_L(0); PG8_MMA(0, 1, At, B1); PG8_BAR;
            PG8_LDA(At, 0, 1); PG8_STAGE(PG8_SA(0, 0), a2, voffA);
            PG8_BAR; PG8_WAIT_L(0); PG8_MMA(1, 0, At, B0); PG8_BAR; PG8_SCHED;
            PG8_STAGE(PG8_SB(0, 1), b2 + hstep, voffB);
            PG8_WAIT_V(6); PG8_BAR; PG8_MMA(1, 1, At, B1); PG8_BAR;
            PG8_LDB(B0, 1, 0); PG8_SCHED; PG8_LDA(At, 1, 0); PG8_STAGE(PG8_SA(0, 1), a2 + hstep, voffA);
            PG8_WAIT_L(8); PG8_BAR; PG8_WAIT_L(0); PG8_MMA(0, 0, At, B0); PG8_BAR; PG8_SCHED;
            PG8_LDB(B1, 1, 1); PG8_STAGE(PG8_SB(1, 0), b3, voffB);
            PG8_BAR; PG8_WAIT_L(0); PG8_MMA(0, 1, At, B1); PG8_BAR;
            PG8_LDA(At, 1, 1); PG8_STAGE(PG8_SA(1, 0), a3, voffA);
            PG8_BAR; PG8_WAIT_L(0); PG8_MMA(1, 0, At, B0); PG8_BAR; PG8_SCHED;
            PG8_STAGE(PG8_SB(1, 1), b3 + hstep, voffB);
            PG8_WAIT_V(6); PG8_BAR; PG8_MMA(1, 1, At, B1); PG8_BAR;
        }
        E(acc, cur, wr, wc, fr, fq);
        if (!has_next) break;
#pragma unroll
        for (int a = 0; a < 2; ++a)
#pragma unroll
            for (int b = 0; b < 2; ++b)
#pragma unroll
                for (int m = 0; m < 4; ++m)
#pragma unroll
                    for (int n = 0; n < 2; ++n) acc[a][b][m][n] = (f32x4){0.f, 0.f, 0.f, 0.f};
        cur = nxt; cA = nA; cB = nB; ++ui;
    }
    PG8_WAIT_V(0);
    if (wr == 0) PG8_BAR;
    PG8_BAR;
#undef PG8_SA
#undef PG8_SB
#undef PG8_STAGE
#undef PG8_LDA
#undef PG8_LDB
#undef PG8_MMA
#undef PG8_WAIT_V
#undef PG8_WAIT_L
#undef PG8_BAR
#undef PG8_SCHED
}
}

typedef f32x4 Acc[2][2][4][2];
#define EPI_ROWS(...) _Pragma("unroll") for (int ai = 0; ai < 2; ++ai) _Pragma("unroll") for (int m = 0; m < 4; ++m) { const int row = u.pm * 256 + ai * 128 + wr * 64 + m * 16 + fr; __VA_ARGS__ }
__device__ __forceinline__ u32x4 pack8(const float* v) { u32x4 w; w.x = pk2(v[0], v[1]); w.y = pk2(v[2], v[3]); w.z = pk2(v[4], v[5]); w.w = pk2(v[6], v[7]); return w; }

template <int SET> struct EpiProj {
    static constexpr bool PERM = true;
    const float* ss1; const float* qn; const float* kn; const float* rot;
    bf16_t *Q, *CA, *KS, *VS, *KW, *VW, *RQ, *RK, *RV, *RG; float* GATE; float* out;
    __device__ __forceinline__ void operator()(const Acc& acc, const pg8::Unit& u, int wr, int wc, int fr, int fq) const {
        const int pn = u.pn, c8 = 8 * fq;
        if (SET == 0 && (pn < 2 || pn == 3)) {
            const float* nw = (pn < 2) ? qn : kn; const float post = (pn < 2) ? 0.125f * LOG2E : 1.f;
            EPI_ROWS(
                const float s1 = ss1[row]; float v[2][8]; float ss = 0.f;
                _Pragma("unroll") for (int bj = 0; bj < 2; ++bj) _Pragma("unroll") for (int e = 0; e < 8; ++e) { v[bj][e] = acc[ai][bj][m][e >> 2][e & 3] * s1; ss += v[bj][e] * v[bj][e]; }
                ss += __shfl_xor(ss, 16); ss += __shfl_xor(ss, 32);
                const float rs = rsqrtf(ss * (1.f / 64.f) + EPS) * post;
                _Pragma("unroll") for (int bj = 0; bj < 2; ++bj) {
                    const int d0 = 32 * bj + c8;
                    const f32x4 w0 = *(const f32x4*)(nw + d0), w1 = *(const f32x4*)(nw + d0 + 4);
                    _Pragma("unroll") for (int e = 0; e < 4; ++e) { v[bj][e] *= rs * w0[e]; v[bj][4 + e] *= rs * w1[e]; }
                    if (pn < 2) { *(u32x4*)(Q + (size_t)row * 512 + (pn * 4 + wc) * 64 + d0) = pack8(v[bj]); }
                    else {
                        const int col = (wc & 1) * 64 + d0;
                        if (wc < 2) {
                            *(u32x4*)(KS + (size_t)row * 128 + col) = pack8(v[bj]);
                            float* o = row < MP ? out + O_PSK + (size_t)row * 128 + col : out + O_SSK + (size_t)(row - MP) * 128 + col;
                            if (row < MV) { *(f32x4*)o = (f32x4){v[bj][0], v[bj][1], v[bj][2], v[bj][3]}; *(f32x4*)(o + 4) = (f32x4){v[bj][4], v[bj][5], v[bj][6], v[bj][7]}; }
                        } else {
                            *(u32x4*)(KW + (size_t)row * 128 + col) = pack8(v[bj]);
                            float* o = nullptr; const int t = row & 2047;
                            if (row < MP) { if (t >= 1536) o = out + O_PWK + ((size_t)(row >> 11) * 512 + (t - 1536)) * 128 + col; }
                            else if (row < MV) o = out + O_SWK + ((size_t)(row - MP) * 512 + 511) * 128 + col;
                            if (o) { *(f32x4*)o = (f32x4){v[bj][0], v[bj][1], v[bj][2], v[bj][3]}; *(f32x4*)(o + 4) = (f32x4){v[bj][4], v[bj][5], v[bj][6], v[bj][7]}; }
                        }
                    }
                }
            )
        } else if (SET == 1 && (pn == 2 || pn == 4)) {
            EPI_ROWS(
                const float s1 = ss1[row];
                _Pragma("unroll") for (int bj = 0; bj < 2; ++bj) {
                    float v[8]; _Pragma("unroll") for (int e = 0; e < 8; ++e) v[e] = acc[ai][bj][m][e >> 2][e & 3] * s1;
                    const int col = 32 * wc + c8;
                    float* o = nullptr;
                    if (pn == 2) {
                        if (row < MP) { const int b = row >> 11, t = row & 2047, g = col >> 6, d = col & 63;
                            *(u32x4*)(CA + ((size_t)bj * CROWS + CROWS_S + ((b * 128 + (t >> 4)) * 2 + g)) * 1024 + (t & 15) * 64 + d) = pack8(v);
                            o = out + (bj ? O_PCV : O_PCK) + (size_t)row * 128 + col; }
                        else if (row < MV) o = out + (bj ? O_SCV : O_SCK) + (size_t)(row - MP) * 128 + col;
                    } else if (bj == 0) {
                        *(u32x4*)(VS + (size_t)row * 128 + col) = pack8(v);
                        if (row < MP) o = out + O_PSV + (size_t)row * 128 + col; else if (row < MV) o = out + O_SSV + (size_t)(row - MP) * 128 + col;
                    } else {
                        *(u32x4*)(VW + (size_t)row * 128 + col) = pack8(v);
                        const int t = row & 2047;
                        if (row < MP) { if (t >= 1536) o = out + O_PWV + ((size_t)(row >> 11) * 512 + (t - 1536)) * 128 + col; }
                        else if (row < MV) o = out + O_SWV + ((size_t)(row - MP) * 512 + 511) * 128 + col;
                    }
                    if (o) { *(f32x4*)o = (f32x4){v[0], v[1], v[2], v[3]}; *(f32x4*)(o + 4) = (f32x4){v[4], v[5], v[6], v[7]}; }
                }
            )
        } else if (SET == 0) {
            const int isk = (pn >= 7) ? 1 : 0, head = ((pn - 5) & 1) * 2 + (wc >> 1), j0 = 32 * (wc & 1) + c8;
            bf16_t* dst = isk ? RK : RQ; const float post = isk ? 0.08838834764831845f : 1.f;
            EPI_ROWS(
                const float s1 = ss1[row] * post; const int pidx = row < MP ? (row & 2047) : 2048;
                const float* rp = rot + ((size_t)pidx * 64 + j0) * 2;
                float y1[8], y2[8];
                _Pragma("unroll") for (int e2 = 0; e2 < 4; ++e2) { const f32x4 cs = *(const f32x4*)(rp + 4 * e2);
                    _Pragma("unroll") for (int t = 0; t < 2; ++t) { const int e = 2 * e2 + t; const float x1 = acc[ai][0][m][e >> 2][e & 3] * s1, x2 = acc[ai][1][m][e >> 2][e & 3] * s1, c = cs[2 * t], s = cs[2 * t + 1];
                        y1[e] = x1 * c - x2 * s; y2[e] = x1 * s + x2 * c; } }
                *(u32x4*)(dst + (size_t)row * 512 + head * 128 + j0) = pack8(y1);
                *(u32x4*)(dst + (size_t)row * 512 + head * 128 + 64 + j0) = pack8(y2);
            )
        } else if (SET == 1 && pn <= 12) {
            const int isg = pn >= 11; bf16_t* dst = isg ? RG : RV; const int cb = ((pn - 9) & 1) * 256;
            EPI_ROWS(
                const float s1 = ss1[row];
                _Pragma("unroll") for (int bj = 0; bj < 2; ++bj) { float v[8];
                    _Pragma("unroll") for (int e = 0; e < 8; ++e) { const float x = acc[ai][bj][m][e >> 2][e & 3] * s1; v[e] = isg ? siluf_(x) : x; }
                    *(u32x4*)(dst + (size_t)row * 512 + cb + 128 * bj + 32 * wc + c8) = pack8(v); }
            )
        } else if (SET == 1) {
            if (wc == 0 && fq < 3) {
                EPI_ROWS(
                    const float s1 = ss1[row]; float v[8];
                    _Pragma("unroll") for (int e = 0; e < 8; ++e) v[e] = sigmoidf_(acc[ai][0][m][e >> 2][e & 3] * s1);
                    float* o = GATE + (size_t)row * 24 + c8;
                    *(f32x4*)o = (f32x4){v[0], v[1], v[2], v[3]}; *(f32x4*)(o + 4) = (f32x4){v[4], v[5], v[6], v[7]};
                )
            }
        }
    }
};

struct SubsetOrder : pg8::StaticOrder {
    int set;
    __device__ __forceinline__ bool next(int i, pg8::Unit& u) const { if (!pg8::StaticOrder::next(i, u)) return false; const int k = u.pn;
        u.pn = set == 0 ? (k < 2 ? k : (k == 2 ? 3 : k + 2)) : (k == 0 ? 2 : (k == 1 ? 4 : k + 7)); return true; }
};
struct EpiF32 {
    static constexpr bool PERM = true;
    float* C; int ld;
    __device__ __forceinline__ void operator()(const Acc& acc, const pg8::Unit& u, int wr, int wc, int fr, int fq) const {
        EPI_ROWS(
            _Pragma("unroll") for (int bj = 0; bj < 2; ++bj) { float* o = C + (size_t)row * ld + u.pn * 256 + 128 * bj + 32 * wc + 8 * fq;
                *(f32x4*)o = acc[ai][bj][m][0]; *(f32x4*)(o + 4) = acc[ai][bj][m][1]; }
        )
    }
};
struct EpiCmp {
    static constexpr bool PERM = true;
    float* C;
    __device__ __forceinline__ void operator()(const Acc& acc, const pg8::Unit& u, int wr, int wc, int fr, int fq) const {
        EPI_ROWS(
            _Pragma("unroll") for (int bj = 0; bj < 2; ++bj) { float* o = C + (size_t)row * 256 + 128 * bj + 32 * wc + 8 * fq;
                *(f32x4*)o = acc[ai][bj][m][0]; *(f32x4*)(o + 4) = acc[ai][bj][m][1]; }
        )
    }
};
struct CmpOrder {
    int G, c;
    __device__ __forceinline__ bool next(int i, pg8::Unit& u) const { const int L = i * G + c; if (L >= 2 * (CROWS / 256)) return false; u.pm = L; u.pn = L / (CROWS / 256); return true; }
    __device__ __forceinline__ void a_ready(const pg8::Unit&) const {}
    __device__ __forceinline__ void done(const pg8::Unit&) const {}
};

struct EpiOut {
    static constexpr bool PERM = true;
    const float* xp; const float* xs; float* H; bf16_t* HB; float* SS2;
    __device__ __forceinline__ void operator()(const Acc& acc, const pg8::Unit& u, int wr, int wc, int fr, int fq) const {
        EPI_ROWS(
            float ss = 0.f;
            _Pragma("unroll") for (int bj = 0; bj < 2; ++bj) { const int col = u.pn * 256 + 128 * bj + 32 * wc + 8 * fq; float v[8];
                f32x4 x0 = (f32x4){0.f, 0.f, 0.f, 0.f}, x1 = x0;
                if (row < MV) { const float* xr = row < MP ? xp + (size_t)row * DM + col : xs + (size_t)(row - MP) * DM + col; x0 = *(const f32x4*)xr; x1 = *(const f32x4*)(xr + 4); }
                _Pragma("unroll") for (int e = 0; e < 4; ++e) { v[e] = acc[ai][bj][m][0][e] + x0[e]; v[4 + e] = acc[ai][bj][m][1][e] + x1[e]; }
                _Pragma("unroll") for (int e = 0; e < 8; ++e) ss += v[e] * v[e];
                float* o = H + (size_t)row * DM + col; *(f32x4*)o = (f32x4){v[0], v[1], v[2], v[3]}; *(f32x4*)(o + 4) = (f32x4){v[4], v[5], v[6], v[7]};
                *(u32x4*)(HB + (size_t)row * DM + col) = pack8(v); }
            ss += __shfl_xor(ss, 16); ss += __shfl_xor(ss, 32);
            if (fq == 0 && row < MV) atomicAdd(SS2 + row, ss);
        )
    }
};
struct EpiGU {
    static constexpr bool PERM = true;
    const float* SS2; bf16_t* ACT;
    __device__ __forceinline__ void operator()(const Acc& acc, const pg8::Unit& u, int wr, int wc, int fr, int fq) const {
        EPI_ROWS(
            const float s2 = rsqrtf(SS2[row] * (1.f / 1024.f) + EPS); float v[8];
            _Pragma("unroll") for (int e = 0; e < 8; ++e) { const float gt = acc[ai][0][m][e >> 2][e & 3] * s2, up = acc[ai][1][m][e >> 2][e & 3] * s2; v[e] = siluf_(gt) * up; }
            *(u32x4*)(ACT + (size_t)row * DFF + u.pn * 128 + 32 * wc + 8 * fq) = pack8(v);
        )
    }
};
struct EpiDown {
    static constexpr bool PERM = true;
    const float* H; float* H2; bf16_t* H2B;
    __device__ __forceinline__ void operator()(const Acc& acc, const pg8::Unit& u, int wr, int wc, int fr, int fq) const {
        EPI_ROWS(
            _Pragma("unroll") for (int bj = 0; bj < 2; ++bj) { const size_t off = (size_t)row * DM + u.pn * 256 + 128 * bj + 32 * wc + 8 * fq; float v[8];
                const f32x4 h0 = *(const f32x4*)(H + off), h1 = *(const f32x4*)(H + off + 4);
                _Pragma("unroll") for (int e = 0; e < 4; ++e) { v[e] = acc[ai][bj][m][0][e] + h0[e]; v[4 + e] = acc[ai][bj][m][1][e] + h1[e]; }
                *(f32x4*)(H2 + off) = (f32x4){v[0], v[1], v[2], v[3]}; *(f32x4*)(H2 + off + 4) = (f32x4){v[4], v[5], v[6], v[7]};
                *(u32x4*)(H2B + off) = pack8(v); }
        )
    }
};
struct EpiFinal {
    static constexpr bool PERM = true;
    const float* H2; const float* VP; float* out;
    __device__ __forceinline__ void operator()(const Acc& acc, const pg8::Unit& u, int wr, int wc, int fr, int fq) const {
        EPI_ROWS(
            if (row < MV) {
                _Pragma("unroll") for (int bj = 0; bj < 2; ++bj) { const int col = u.pn * 256 + 128 * bj + 32 * wc + 8 * fq; const size_t off = (size_t)row * DM + col; float v[8];
                    const f32x4 h0 = *(const f32x4*)(H2 + off), h1 = *(const f32x4*)(H2 + off + 4), p0 = *(const f32x4*)(VP + off), p1 = *(const f32x4*)(VP + off + 4);
                    _Pragma("unroll") for (int e = 0; e < 4; ++e) { v[e] = h0[e] + sigmoidf_(acc[ai][bj][m][0][e]) * p0[e]; v[4 + e] = h1[e] + sigmoidf_(acc[ai][bj][m][1][e]) * p1[e]; }
                    float* o = row < MP ? out + O_YP + off : out + O_YS + (size_t)(row - MP) * DM + col;
                    *(f32x4*)o = (f32x4){v[0], v[1], v[2], v[3]}; *(f32x4*)(o + 4) = (f32x4){v[4], v[5], v[6], v[7]}; }
            }
        )
    }
};

__device__ __forceinline__ int rel_bucket(int dist) {
    const int n = dist < 0 ? 0 : dist;
    if (n < 16) return n;
    const int large = 16 + (int)(logf((float)n / 16.f) / 2.0794415416798357f * 16.f);
    return large < 31 ? large : 31;
}
struct WSrc { const float* src; int ld, vt; const float* ks; };
__device__ __forceinline__ WSrc wsrc(const Params& p, int wid, int n0) {
    WSrc w; w.vt = 32; w.ks = nullptr;
    if (wid == 0) {
        const int tile = n0 >> 8, c = n0 & 255, bj = c >> 7, wc = (c >> 5) & 3; int col;
        if (tile < 2) col = (tile * 4 + wc) * 64 + 32 * bj;
        else if (tile == 2) col = 512 + c;
        else if (tile == 3) col = (wc < 2 ? 768 : 1024) + (wc & 1) * 64 + 32 * bj;
        else if (tile == 4) col = (bj ? 1152 : 896) + (c & 127);
        else if (tile <= 8) col = (tile >= 7 ? 1816 : 1304) + ((((tile - 5) & 1) * 2 + (wc >> 1)) * 128) + 64 * bj + 32 * (wc & 1);
        else if (tile <= 10) col = 2328 + (tile - 9) * 256 + c;
        else if (tile <= 12) col = 2840 + (tile - 11) * 256 + c;
        else { col = 1280; w.vt = (c == 0) ? 24 : 0; }
        w.src = p.in[13] + col; w.ld = INC; w.ks = p.in[12];
    } else if (wid == 1) { w.src = p.in[23] + n0; w.ld = DM; }
    else if (wid == 2) { const int pn = n0 >> 8, bj = (n0 >> 7) & 1, c7 = n0 & 127; w.src = (bj ? p.in[26] : p.in[25]) + pn * 128 + c7; w.ld = DFF; w.ks = p.in[24]; }
    else if (wid == 3) { w.src = p.in[27] + n0; w.ld = DM; }
    else if (wid == 4) { w.src = p.in[28] + n0; w.ld = DM; }
    else if (wid == 5) { w.src = p.in[29] + n0; w.ld = DM; }
    else if (wid == 6 || wid == 7) { const int j = n0 >> 7, h0 = n0 & 127; w.src = p.in[wid == 6 ? 17 : 20] + (size_t)j * 1024 * 128 + h0; w.ld = 128; }
    else { w.src = p.in[wid == 8 ? 18 : 21] + n0; w.ld = 64; }
    return w;
}
__device__ __forceinline__ void phase_prologue(const Params& p, unsigned char* lds) {
    const int tid = threadIdx.x, lane = tid & 63, wid = tid >> 6, G = gridDim.x, bid = blockIdx.x;
    unsigned char* ws = p.ws;
    {
        const int tn[10] = {112, 32, 176, 32, 32, 32, 8, 8, 2, 2}, tk[10] = {16, 16, 16, 44, 16, 4, 16, 16, 2, 2};
        const size_t dsto[10] = {WS_W1, WS_WO, WS_WGU, WS_WD, WS_WPG, WS_WPP, WS_W1C, WS_W1C + (size_t)256 * 1024 * 2, WS_W2C, WS_W2C + (size_t)64 * 128 * 2};
        int total = 0;
#pragma unroll
        for (int i = 0; i < 10; ++i) total += tn[i] * tk[i];
        float* tl = (float*)lds;
        int total4 = 0;
#pragma unroll
        for (int i = 0; i < 10; ++i) total4 += ((tn[i] + 3) / 4) * tk[i];
        for (int t = bid; t < total4; t += G) {
            int wsel = 0, rem = t;
#pragma unroll
            for (int i = 0; i < 9; ++i) { const int cnt = ((tn[i] + 3) / 4) * tk[i]; if (wsel == i && rem >= cnt) { rem -= cnt; wsel = i + 1; } }
            int tkk = 16, tnn = 4; size_t doff = 0;
#pragma unroll
            for (int i = 0; i < 10; ++i) if (wsel == i) { tkk = tk[i]; tnn = tn[i]; doff = dsto[i]; }
            const int K = tkk * 64;
            const int n0 = (rem / tkk) * 128, k0 = (rem % tkk) * 64;
            const int nch = (tnn - n0 / 32) < 4 ? (tnn - n0 / 32) : 4;
            float v[4][4];
#pragma unroll
            for (int ch = 0; ch < 4; ++ch) { if (ch < nch) { const WSrc w = wsrc(p, wsel, n0 + 32 * ch);
#pragma unroll
                for (int it = 0; it < 4; ++it) { const int kk = it * 16 + (tid >> 5), tt = tid & 31; float x = 0.f;
                    if (tt < w.vt) { x = w.src[(size_t)(k0 + kk) * w.ld + tt]; if (w.ks) x *= w.ks[k0 + kk]; }
                    v[ch][it] = x; } } }
#pragma unroll
            for (int ch = 0; ch < 4; ++ch) if (ch < nch) {
#pragma unroll
                for (int it = 0; it < 4; ++it) tl[ch * 2112 + (it * 16 + (tid >> 5)) * 33 + (tid & 31)] = v[ch][it]; }
            __syncthreads();
#pragma unroll
            for (int ch = 0; ch < 4; ++ch) if (ch < nch) { const int nt = tid >> 4, kq = (tid & 15) * 4; const float* tc = tl + ch * 2112;
              u32x2 o; o.x = pk2(tc[(kq + 0) * 33 + nt], tc[(kq + 1) * 33 + nt]); o.y = pk2(tc[(kq + 2) * 33 + nt], tc[(kq + 3) * 33 + nt]);
              *(u32x2*)((bf16_t*)(ws + doff) + (size_t)(n0 + 32 * ch + nt) * K + k0 + kq) = o; }
            __syncthreads();
        }
    }
    {
        bf16_t* XB = (bf16_t*)(ws + WS_XB); float* SS1 = (float*)(ws + WS_SS1); bf16_t* PB = (bf16_t*)(ws + WS_PB);
        for (int row = bid * 8 + wid; row < MR; row += G * 8) {
            const float* xr = row < MP ? p.in[0] + (size_t)row * DM : p.in[1] + (size_t)(row - MP) * DM;
            const float* pr = row < MP ? p.in[10] + (size_t)row * PLE : p.in[11] + (size_t)(row - MP) * PLE;
            f32x4 v[4]; float ss = 0.f;
#pragma unroll
            for (int i = 0; i < 4; ++i) { v[i] = row < MV ? *(const f32x4*)(xr + i * 256 + lane * 4) : (f32x4){0.f, 0.f, 0.f, 0.f}; ss += v[i][0] * v[i][0] + v[i][1] * v[i][1] + v[i][2] * v[i][2] + v[i][3] * v[i][3]; }
#pragma unroll
            for (int o = 1; o < 64; o <<= 1) ss += __shfl_xor(ss, o);
#pragma unroll
            for (int i = 0; i < 4; ++i) { u32x2 o; o.x = pk2(v[i][0], v[i][1]); o.y = pk2(v[i][2], v[i][3]); *(u32x2*)(XB + (size_t)row * DM + i * 256 + lane * 4) = o; }
            if (lane == 0) SS1[row] = rsqrtf(ss * (1.f / 1024.f) + EPS);
            const f32x4 pv = row < MV ? *(const f32x4*)(pr + lane * 4) : (f32x4){0.f, 0.f, 0.f, 0.f};
            u32x2 o; o.x = pk2(pv[0], pv[1]); o.y = pk2(pv[2], pv[3]); *(u32x2*)(PB + (size_t)row * PLE + lane * 4) = o;
        }
    }
    const int gtid = bid * 512 + tid, gsz = G * 512;
    {
        float* rot = (float*)(ws + WS_ROT);
        for (int idx = gtid; idx < 2049 * 64; idx += gsz) { const int pidx = idx >> 6, j = idx & 63; const float pos = pidx < 2048 ? (float)pidx : 16384.f;
            const float inv = powf(10000.f, -(float)j / 64.f); const float ang = pos * inv; const double a = (double)ang;
            rot[(size_t)idx * 2] = (float)cos(a); rot[(size_t)idx * 2 + 1] = (float)sin(a); }
        float* btab = (float*)(ws + WS_BTAB);
        for (int idx = gtid; idx < 8 * 128; idx += gsz) { const int head = idx >> 7, dist = idx & 127; btab[idx] = p.in[30][rel_bucket(dist) * 8 + head] * LOG2E; }
        float* SS2 = (float*)(ws + WS_SS2);
        for (int idx = gtid; idx < MR; idx += gsz) SS2[idx] = 0.f;
        float* bc = (float*)(ws + WS_BIASC);
        for (int it = bid; it < 32; it += G) if (tid < 256) { const int c = tid >> 7, h = tid & 127; const float* pe = p.in[c ? 19 : 16]; const float* w1 = p.in[c ? 20 : 17]; float a = 0.f;
#pragma unroll 8
            for (int k = it * 64; k < it * 64 + 64; ++k) a += pe[k] * w1[(size_t)k * 128 + h];
            atomicAdd(bc + tid, a); }
    }
    {
        bf16_t* CA = (bf16_t*)(ws + WS_CA);
        const int total = 2 * DB * PAST * 32;
        for (int idx0 = gtid; idx0 < total; idx0 += 8 * gsz) {
            f32x4 v[8]; size_t dst[8]; bool ok[8];
#pragma unroll
            for (int q = 0; q < 8; ++q) { const int idx = idx0 + q * gsz; ok[q] = idx < total; const int ii = ok[q] ? idx : 0;
                const int c4 = (ii & 31) * 4, tok = (ii >> 5) & (PAST - 1), b = (ii >> 19) & 31, c = ii >> 24;
                const int page = p.page_table[b * NPAGES + (tok >> 7)];
                v[q] = *(const f32x4*)(p.in[2 + c] + ((size_t)page * PAGE + (tok & 127)) * 128 + c4);
                const int seg = tok >> 4, s = tok & 15, g = c4 >> 6, d = c4 & 63;
                dst[q] = ((size_t)c * CROWS + (size_t)(b * 1024 + seg) * 2 + g) * 1024 + s * 64 + d; }
#pragma unroll
            for (int q = 0; q < 8; ++q) if (ok[q]) { u32x2 o; o.x = pk2(v[q][0], v[q][1]); o.y = pk2(v[q][2], v[q][3]); *(u32x2*)(CA + dst[q]) = o; }
        }
    }
    {
        const int total = 2 * DB * 511 * 32;
        for (int idx = gtid; idx < total; idx += gsz) { const int c4 = (idx & 31) * 4; int r = idx >> 5; const int j = r % 511; r /= 511; const int b = r & 31, c = r >> 5;
            const f32x4 v = *(const f32x4*)(p.in[6 + c] + ((size_t)b * 512 + j + 1) * 128 + c4);
            *(f32x4*)(p.out + (c ? O_SWV : O_SWK) + ((size_t)b * 512 + j) * 128 + c4) = v; }
    }
}

__device__ __forceinline__ s16x4 tr16(const unsigned char* p) { typedef short v4i16_t __attribute__((ext_vector_type(4))); return __builtin_bit_cast(s16x4, __builtin_amdgcn_ds_read_tr16_b64_v4i16((LAS v4i16_t*)p)); }
__device__ __forceinline__ bf16x8 cat8(s16x4 lo, s16x4 hi) { return (bf16x8){lo[0], lo[1], lo[2], lo[3], hi[0], hi[1], hi[2], hi[3]}; }
constexpr int RSTR = 272;
__device__ __forceinline__ float ret_lgam(int h) { return log2f(1.f - exp2f(-5.f - (float)h)); }
__device__ __forceinline__ bf16x8 tr_frag(const unsigned char* tile, int row0, int cb, int lane) {
    const int hi = lane >> 5;
    const unsigned char* a = tile + (size_t)(row0 + 4 * hi + ((lane & 15) >> 2)) * RSTR + (cb * 32 + 16 * ((lane >> 4) & 1) + 4 * (lane & 3)) * 2;
    return cat8(tr16(a), tr16(a + 8 * RSTR));
}
__device__ __forceinline__ void stage128(unsigned char* dst, const bf16_t* src, int tid, bool decay, float lg) {
    const int r = tid >> 2, q4 = tid & 3;
    float sc = decay ? exp2f((float)(127 - r) * lg) : 1.f;
#pragma unroll
    for (int i = 0; i < 4; ++i) { const int col = q4 * 32 + i * 8; u32x4 v = *(const u32x4*)(src + (size_t)r * 512 + col);
        if (decay) { v.x = pk2(bflo(v.x) * sc, bfhi(v.x) * sc); v.y = pk2(bflo(v.y) * sc, bfhi(v.y) * sc); v.z = pk2(bflo(v.z) * sc, bfhi(v.z) * sc); v.w = pk2(bflo(v.w) * sc, bfhi(v.w) * sc); }
        *(u32x4*)(dst + (size_t)r * RSTR + col * 2) = v; }
}
__device__ __forceinline__ void ret_r1_unit(const Params& p, unsigned char* lds, int b, int h, int c) {
    const int tid = threadIdx.x, lane = tid & 63, w = __builtin_amdgcn_readfirstlane(tid >> 6), r32 = lane & 31, hi = lane >> 5;
    const size_t row0 = (size_t)b * SEQ + c * 128;
    const float lg = ret_lgam(h);
    unsigned char* Kt = lds; unsigned char* Vt = lds + 128 * RSTR;
    stage128(Kt, (const bf16_t*)(p.ws + WS_RK) + row0 * 512 + h * 128, tid, true, lg);
    stage128(Vt, (const bf16_t*)(p.ws + WS_RV) + row0 * 512 + h * 128, tid, false, 0.f);
    __syncthreads();
    const int eb = w & 3, dp = w >> 2;
    f32x16 acc[2]; acc[0] = f32x16{}; acc[1] = f32x16{};
#pragma unroll
    for (int s = 0; s < 8; ++s) {
        const bf16x8 vf = tr_frag(Vt, 16 * s, eb, lane);
#pragma unroll
        for (int di = 0; di < 2; ++di) { const bf16x8 kf = tr_frag(Kt, 16 * s, 2 * dp + di, lane); acc[di] = __builtin_amdgcn_mfma_f32_32x32x16_bf16(vf, kf, acc[di], 0, 0, 0); }
    }
    float* KVT = (float*)(p.ws + WS_KVT) + ((size_t)((b * 4 + h) * 16 + c)) * 16384;
#pragma unroll
    for (int di = 0; di < 2; ++di)
#pragma unroll
        for (int r = 0; r < 16; ++r) KVT[(size_t)(32 * eb + crow(r, hi)) * 128 + 32 * (2 * dp + di) + r32] = acc[di][r];
    __syncthreads();
}
__device__ __forceinline__ void ret_r2_unit(const Params& p, unsigned char* lds, int b, int h, int c) {
    const int tid = threadIdx.x, lane = tid & 63, w = __builtin_amdgcn_readfirstlane(tid >> 6), r32 = lane & 31, hi = lane >> 5;
    const size_t row0 = (size_t)b * SEQ + c * 128;
    const float lg = ret_lgam(h);
    unsigned char* Qt = lds; unsigned char* Kt = lds + 128 * RSTR; unsigned char* Vt = lds + 2 * 128 * RSTR; float* st = (float*)(lds + 3 * 128 * RSTR);
    stage128(Qt, (const bf16_t*)(p.ws + WS_RQ) + row0 * 512 + h * 128, tid, false, 0.f);
    stage128(Kt, (const bf16_t*)(p.ws + WS_RK) + row0 * 512 + h * 128, tid, false, 0.f);
    stage128(Vt, (const bf16_t*)(p.ws + WS_RV) + row0 * 512 + h * 128, tid, false, 0.f);
    __syncthreads();
    const int eb = w & 3, ps = w >> 2;
    bf16x8 sf[8];
    if (c > 0) {
        const float* KV0 = (const float*)(p.ws + WS_KVT) + ((size_t)((b * 4 + h) * 16)) * 16384 + (size_t)(32 * eb + r32) * 128 + 8 * hi;
#pragma unroll
        for (int s = 0; s < 8; ++s) {
            float a[8];
#pragma unroll
            for (int e = 0; e < 8; ++e) a[e] = 0.f;
            for (int j = 0; j < c; ++j) { const float wj = exp2f(128.f * (float)(c - 1 - j) * lg); const float* src = KV0 + (size_t)j * 16384 + 16 * s;
                const f32x4 x0 = *(const f32x4*)src, x1 = *(const f32x4*)(src + 4);
#pragma unroll
                for (int e = 0; e < 4; ++e) { a[e] += wj * x0[e]; a[4 + e] += wj * x1[e]; } }
            const u32x4 pk = pack8(a); sf[s] = __builtin_bit_cast(bf16x8, pk);
        }
    }
    f32x16 accs[2];
#pragma unroll
    for (int ni = 0; ni < 2; ++ni) {
        const int nb = ps ? (1 + ni) : (ni ? 3 : 0);
        const int n = 32 * nb + r32;
        bf16x8 qf[8];
#pragma unroll
        for (int s = 0; s < 8; ++s) qf[s] = *(const bf16x8*)(Qt + (size_t)n * RSTR + (16 * s + 8 * hi) * 2);
        f32x16 acc = f32x16{};
        if (c > 0) {
#pragma unroll
            for (int s = 0; s < 8; ++s) acc = __builtin_amdgcn_mfma_f32_32x32x16_bf16(sf[s], qf[s], acc, 0, 0, 0);
            const float dn = exp2f((float)(n + 1) * lg);
#pragma unroll
            for (int r = 0; r < 16; ++r) acc[r] *= dn;
        }
        for (int mb = 0; mb <= nb; ++mb) {
            f32x16 x = f32x16{};
#pragma unroll
            for (int s = 0; s < 8; ++s) { const bf16x8 kf = *(const bf16x8*)(Kt + (size_t)(32 * mb + r32) * RSTR + (16 * s + 8 * hi) * 2); x = __builtin_amdgcn_mfma_f32_32x32x16_bf16(kf, qf[s], x, 0, 0, 0); }
            float pv[16];
#pragma unroll
            for (int r = 0; r < 16; ++r) { const int dm = n - (32 * mb + crow(r, hi)); pv[r] = dm >= 0 ? x[r] * exp2f((float)dm * lg) : 0.f; }
#pragma unroll
            for (int s2 = 0; s2 < 2; ++s2) { const u32x4 pk = pack8(pv + 8 * s2); const bf16x8 vf = tr_frag(Vt, 32 * mb + 16 * s2, eb, lane);
                acc = __builtin_amdgcn_mfma_f32_32x32x16_bf16(vf, __builtin_bit_cast(bf16x8, pk), acc, 0, 0, 0); }
        }
        float s1 = 0.f, s2 = 0.f;
#pragma unroll
        for (int r = 0; r < 16; ++r) { s1 += acc[r]; s2 += acc[r] * acc[r]; }
        s1 = xhalf_sum(s1); s2 = xhalf_sum(s2);
        if (hi == 0) { st[(eb * 128 + n) * 2] = s1; st[(eb * 128 + n) * 2 + 1] = s2; }
        accs[ni] = acc;
    }
    __syncthreads();
    const float* gn = p.in[22] + h * 128; const bf16_t* RG = (const bf16_t*)(p.ws + WS_RG); bf16_t* AO = (bf16_t*)(p.ws + WS_AO);
#pragma unroll
    for (int ni = 0; ni < 2; ++ni) {
        const int nb = ps ? (1 + ni) : (ni ? 3 : 0); const int n = 32 * nb + r32;
        float s1 = 0.f, s2 = 0.f;
#pragma unroll
        for (int q = 0; q < 4; ++q) { s1 += st[(q * 128 + n) * 2]; s2 += st[(q * 128 + n) * 2 + 1]; }
        const float mu = s1 * (1.f / 128.f), var = s2 * (1.f / 128.f) - mu * mu, rs = rsqrtf(var + EPS);
        const size_t row = row0 + n;
#pragma unroll
        for (int a = 0; a < 4; ++a) { const int e0 = 32 * eb + 8 * a + 4 * hi;
            const f32x4 gw = *(const f32x4*)(gn + e0); const u32x2 gg = *(const u32x2*)(RG + row * 512 + h * 128 + e0);
            const float g0 = bflo(gg.x), g1 = bfhi(gg.x), g2 = bflo(gg.y), g3 = bfhi(gg.y);
            u32x2 o; o.x = pk2((accs[ni][4 * a] - mu) * rs * gw[0] * g0, (accs[ni][4 * a + 1] - mu) * rs * gw[1] * g1);
            o.y = pk2((accs[ni][4 * a + 2] - mu) * rs * gw[2] * g2, (accs[ni][4 * a + 3] - mu) * rs * gw[3] * g3);
            *(u32x2*)(AO + row * 1024 + 512 + h * 128 + e0) = o; }
    }
    __syncthreads();
}
__device__ __forceinline__ void ret_sample_unit(const Params& p, unsigned char* lds, int b, int h) {
    const int tid = threadIdx.x;
    float* qv = (float*)lds; float* kv = qv + 128; float* vv = kv + 128; float* part = vv + 128; float* red = part + 512;
    const size_t row = (size_t)MP + b;
    if (tid < 384) { const int which = tid >> 7, d = tid & 127; const bf16_t* src = (const bf16_t*)(p.ws + (which == 0 ? WS_RQ : which == 1 ? WS_RK : WS_RV)) + row * 512 + h * 128 + d; qv[tid] = bf1(*src); }
    __syncthreads();
    const float gam = 1.f - exp2f(-5.f - (float)h);
    const int dq = tid >> 7, e = tid & 127;
    const float* st = p.in[8] + ((size_t)(b * 4 + h)) * 16384; float* so = p.out + O_SRET + ((size_t)(b * 4 + h)) * 16384;
    float acc = 0.f, qk = 0.f; const float ve = vv[e];
#pragma unroll 4
    for (int i = 0; i < 32; ++i) { const int d = dq + 4 * i; const float s = st[d * 128 + e]; acc += qv[d] * s; so[d * 128 + e] = gam * s + kv[d] * ve; }
#pragma unroll 4
    for (int d = 0; d < 128; ++d) qk += qv[d] * kv[d];
    part[dq * 128 + e] = acc;
    __syncthreads();
    float o = 0.f;
    if (tid < 128) { o = qk * ve + gam * (part[e] + part[128 + e] + part[256 + e] + part[384 + e]); }
    float s1 = tid < 128 ? o : 0.f, s2 = tid < 128 ? o * o : 0.f;
#pragma unroll
    for (int of = 1; of < 64; of <<= 1) { s1 += __shfl_xor(s1, of); s2 += __shfl_xor(s2, of); }
    if ((tid & 63) == 0 && tid < 128) { red[(tid >> 6) * 2] = s1; red[(tid >> 6) * 2 + 1] = s2; }
    __syncthreads();
    if (tid < 128) { const float t1 = red[0] + red[2], t2 = red[1] + red[3]; const float mu = t1 * (1.f / 128.f), var = t2 * (1.f / 128.f) - mu * mu, rs = rsqrtf(var + EPS);
        const float g = bf1(((const bf16_t*)(p.ws + WS_RG))[row * 512 + h * 128 + e]);
        const unsigned pk = pk2((o - mu) * rs * p.in[22][h * 128 + e] * g, 0.f);
        ((bf16_t*)(p.ws + WS_AO))[row * 1024 + 512 + h * 128 + e] = (bf16_t)(pk & 0xffffu); }
    __syncthreads();
}

__device__ __forceinline__ void compress2_task(const Params& p, int c, int task, int lane) {
    const int r32 = lane & 31, hi = lane >> 5;
    const int R = task * 32 + r32;
    const float* P0 = (const float*)(p.ws + WS_CP) + ((size_t)c * CROWS + R) * 256;
    const int R2 = (R + 2 < CROWS) ? R + 2 : CROWS - 1;
    const float* P1 = (const float*)(p.ws + WS_CP) + ((size_t)c * CROWS + R2) * 256 + 128;
    const float* bc = (const float*)(p.ws + WS_BIASC) + c * 128;
    const bf16_t* W2 = (const bf16_t*)(p.ws + WS_W2C) + (size_t)c * 64 * 128;
    f32x16 acc[2]; acc[0] = f32x16{}; acc[1] = f32x16{};
#pragma unroll
    for (int s = 0; s < 8; ++s) {
        const int k0 = 16 * s + 8 * hi; float hv[8];
#pragma unroll
        for (int q = 0; q < 2; ++q) { const f32x4 a = *(const f32x4*)(P0 + k0 + 4 * q), b = *(const f32x4*)(P1 + k0 + 4 * q), bb = *(const f32x4*)(bc + k0 + 4 * q);
#pragma unroll
            for (int e = 0; e < 4; ++e) hv[4 * q + e] = siluf_(a[e] + b[e] + bb[e]); }
        const u32x4 pk = pack8(hv); const bf16x8 hf = __builtin_bit_cast(bf16x8, pk);
#pragma unroll
        for (int eb = 0; eb < 2; ++eb) { const bf16x8 wf = *(const bf16x8*)(W2 + (size_t)(32 * eb + r32) * 128 + k0); acc[eb] = __builtin_amdgcn_mfma_f32_32x32x16_bf16(wf, hf, acc[eb], 0, 0, 0); }
    }
    float rs = 1.f;
    if (c == 0) { float ss = 0.f;
#pragma unroll
        for (int eb = 0; eb < 2; ++eb)
#pragma unroll
            for (int r = 0; r < 16; ++r) ss += acc[eb][r] * acc[eb][r];
        ss = xhalf_sum(ss); rs = rsqrtf(ss * (1.f / 64.f) + EPS); }
    bool valid; bf16_t* dst;
    if (R < CROWS_S) { valid = ((R >> 1) & 1023) < NC_S; dst = (bf16_t*)(p.ws + (c ? WS_CVCS : WS_CKCS)) + (size_t)R * 64; }
    else { const int Rp = R - CROWS_S; valid = ((Rp >> 1) & 127) < NC_P; dst = (bf16_t*)(p.ws + (c ? WS_CVCP : WS_CKCP)) + (size_t)Rp * 64; }
    if (valid) {
#pragma unroll
        for (int eb = 0; eb < 2; ++eb)
#pragma unroll
            for (int a = 0; a < 4; ++a) { const int e0 = 32 * eb + 8 * a + 4 * hi; float v[4];
#pragma unroll
                for (int e = 0; e < 4; ++e) { v[e] = acc[eb][4 * a + e] * rs; if (c == 0) v[e] *= p.in[15][e0 + e]; }
                u32x2 o; o.x = pk2(v[0], v[1]); o.y = pk2(v[2], v[3]); *(u32x2*)(dst + e0) = o; }
    }
}
__device__ __forceinline__ void pret_job(const Params& p) {
    const int gtid = blockIdx.x * 512 + threadIdx.x, gsz = gridDim.x * 512;
    for (int idx = gtid; idx < NB * 4 * 16384; idx += gsz) { const int d = idx & 127, e = (idx >> 7) & 127, bh = idx >> 14; const float lg = ret_lgam(bh & 3);
        const float* src = (const float*)(p.ws + WS_KVT) + (size_t)bh * 16 * 16384 + e * 128 + d; float a = 0.f;
#pragma unroll
        for (int j = 0; j < 16; ++j) a += exp2f(128.f * (float)(15 - j) * lg) * src[(size_t)j * 16384];
        p.out[O_PRET + (size_t)bh * 16384 + d * 128 + e] = a; }
}

constexpr int AT_K = 0, AT_V = 16384, AT_IMP = 32768, AT_IMPS = AT_IMP + 64 * 129 * 4, AT_MASK = AT_IMPS + 64 * 33 * 4, AT_BTAB = AT_MASK + 256, AT_END = AT_BTAB + 2048;
struct KVregs { u32x4 k, v; };
__device__ __forceinline__ KVregs kv_load(const bf16_t* Kg, const bf16_t* Vg, size_t rowbase, int rmax, int ld, int colg, int tid) {
    KVregs r; { int key = tid & 63; if (key > rmax) key = rmax; r.k = *(const u32x4*)(Kg + (rowbase + key) * ld + colg + (tid >> 6) * 8); }
    { int row = (tid >> 2) & 63; if (row > rmax) row = rmax; r.v = *(const u32x4*)(Vg + (rowbase + row) * ld + colg + (tid >> 8) * 32 + (tid & 3) * 8); }
    return r;
}
__device__ __forceinline__ void kv_store(unsigned char* Kb, unsigned char* Vb, const KVregs& r, int tid) {
    *(u32x4*)(Kb + (tid >> 6) * 1024 + (tid & 63) * 16) = r.k;
    *(u32x4*)(Vb + (tid >> 8) * 4096 + ((tid >> 2) & 63) * 64 + (tid & 3) * 16) = r.v;
}
__device__ __forceinline__ f32x16 qk_sub(const unsigned char* Kb, const bf16x8* qr, int sub, int r32, int hi) {
    f32x16 s = f32x16{};
#pragma unroll
    for (int d0 = 0; d0 < 4; ++d0) { const bf16x8 kf = *(const bf16x8*)(Kb + d0 * 2048 + hi * 1024 + (sub * 32 + r32) * 16); s = __builtin_amdgcn_mfma_f32_32x32x16_bf16(kf, qr[d0], s, 0, 0, 0); }
    return s;
}
__device__ __forceinline__ void pv_sub(f32x16* o, const unsigned char* Vb, const float* pv, int sub, int lane) {
    const int hi = lane >> 5;
    const unsigned char* vb = Vb + ((lane >> 4) & 1) * 32 + (lane & 3) * 8 + (4 * hi + ((lane & 15) >> 2)) * 64;
#pragma unroll
    for (int s2 = 0; s2 < 2; ++s2) { const u32x4 pk = pack8(pv + 8 * s2); const bf16x8 pf = __builtin_bit_cast(bf16x8, pk);
#pragma unroll
        for (int eb = 0; eb < 2; ++eb) { const unsigned char* a = vb + eb * 4096 + (2 * sub + s2) * 1024; const bf16x8 vf = cat8(tr16(a), tr16(a + 512));
            o[eb] = __builtin_amdgcn_mfma_f32_32x32x16_bf16(vf, pf, o[eb], 0, 0, 0); } }
}
__device__ __forceinline__ void attn_tile(const unsigned char* Kb, const unsigned char* Vb, const bf16x8* qr, const float* bt, int kp0, int qpos, bool isw, bool sel, float& m, float& l, f32x16* o, int lane) {
    const int r32 = lane & 31, hi = lane >> 5;
#pragma unroll 1
    for (int sub = 0; sub < 2; ++sub) {
        const int dist0 = qpos - kp0 - 32 * sub - 4 * hi;
        unsigned vm = 0;
#pragma unroll
        for (int r = 0; r < 16; ++r) { const int dist = dist0 - ((r & 3) + 8 * (r >> 2)); const bool ok = isw ? (dist >= 0 && dist < 512) : (sel && dist >= 0); vm |= ok ? (1u << r) : 0u; }
        if (__ballot(vm != 0) == 0ull) continue;
        f32x16 s = qk_sub(Kb, qr, sub, r32, hi);
        float mx = -1e30f;
#pragma unroll
        for (int r = 0; r < 16; ++r) { const int dist = dist0 - ((r & 3) + 8 * (r >> 2)); const int di = dist < 0 ? 0 : (dist > 127 ? 127 : dist);
            const float bv = bt[di]; const float sv = ((vm >> r) & 1u) ? s[r] + bv : -1e30f; s[r] = sv; mx = fmaxf(mx, sv); }
        mx = xhalf_max(mx);
        const float mn = fmaxf(m, mx), alpha = exp2f(m - mn);
        float pv[16]; float ps = 0.f;
#pragma unroll
        for (int r = 0; r < 16; ++r) { const float e = exp2f(s[r] - mn); pv[r] = ((vm >> r) & 1u) ? e : 0.f; ps += pv[r]; }
        l = l * alpha + ps; m = mn;
#pragma unroll
        for (int r = 0; r < 16; ++r) { o[0][r] *= alpha; o[1][r] *= alpha; }
        pv_sub(o, Vb, pv, sub, lane);
    }
}
__device__ __forceinline__ void attn_prompt_unit(const Params& p, unsigned char* lds, int b, int g, int i) {
    const int tid = threadIdx.x, lane = tid & 63, w = __builtin_amdgcn_readfirstlane(tid >> 6), r32 = lane & 31, hi = lane >> 5;
    const int hr = w >> 1, ql = (w & 1) * 32 + r32, qpos = 64 * i + ql, head = g * 4 + hr;
    const size_t row = (size_t)b * SEQ + qpos;
    float* imp = (float*)(lds + AT_IMP); float* imps = (float*)(lds + AT_IMPS); unsigned* mask = (unsigned*)(lds + AT_MASK); float* btab = (float*)(lds + AT_BTAB);
    const bf16_t* Qg = (const bf16_t*)(p.ws + WS_Q);
    for (int x = tid; x < 64 * 129; x += 512) imp[x] = 0.f;
    if (tid < 64) mask[tid] = (i < 16) ? 0xFFFFFFFFu : ((1u << 0) | (1u << i) | (1u << (i - 1)));
    btab[tid] = ((const float*)(p.ws + WS_BTAB))[(g * 4) * 128 + tid];
    bf16x8 qr[4];
#pragma unroll
    for (int d0 = 0; d0 < 4; ++d0) qr[d0] = *(const bf16x8*)(Qg + row * 512 + head * 64 + d0 * 16 + hi * 8);
    const float* gp = (const float*)(p.ws + WS_GATE) + row * 24 + head;
    const float g0 = gp[0], g1 = gp[8], g2 = gp[16];
    const float* bt = btab + hr * 128;
    f32x16 ot[2]; ot[0] = f32x16{}; ot[1] = f32x16{};
    unsigned char* Kb0 = lds + AT_K; unsigned char* Vb0 = lds + AT_V;
    {
        const bf16_t* CK = (const bf16_t*)(p.ws + WS_CKCP); const bf16_t* CV = (const bf16_t*)(p.ws + WS_CVCP);
#pragma unroll
        for (int t = 0; t < 2; ++t) { const KVregs kv = kv_load(CK, CV, (size_t)b * 128 + 64 * t, t ? 62 : 63, 128, g * 64, tid); kv_store(Kb0 + t * 8192, Vb0 + t * 8192, kv, tid); }
        __syncthreads();
        auto cmp_scores = [&](int t4) -> f32x16 {
            f32x16 sv = qk_sub(Kb0 + (t4 >> 1) * 8192, qr, t4 & 1, r32, hi);
#pragma unroll
            for (int r = 0; r < 16; ++r) { const int c = 32 * t4 + crow(r, hi); const int dist = qpos - (16 * c + 31); const int di = dist < 0 ? 0 : (dist > 127 ? 127 : dist);
                const float bv = bt[di]; sv[r] = (dist >= 0 && c < NC_P) ? sv[r] + bv : -1e30f; }
            return sv; };
        float mx = -1e30f;
#pragma unroll 1
        for (int t4 = 0; t4 < 4; ++t4) { const f32x16 sv = cmp_scores(t4);
#pragma unroll
            for (int r = 0; r < 16; ++r) mx = fmaxf(mx, sv[r]); }
        mx = xhalf_max(mx);
        float ps = 0.f;
#pragma unroll 1
        for (int t4 = 0; t4 < 4; ++t4) { const f32x16 sv = cmp_scores(t4);
#pragma unroll
            for (int r = 0; r < 16; ++r) ps += sv[r] > -1e29f ? exp2f(sv[r] - mx) : 0.f; }
        ps = xhalf_sum(ps);
        const float inv = ps > 0.f ? 1.f / ps : 0.f;
#pragma unroll 1
        for (int t4 = 0; t4 < 4; ++t4) { const f32x16 sv = cmp_scores(t4);
            float pv[16];
#pragma unroll
            for (int r = 0; r < 16; ++r) { const float pn = sv[r] > -1e29f ? exp2f(sv[r] - mx) * inv : 0.f; if (i >= 16 && pn > 0.f) atomicAdd(&imp[ql * 129 + 32 * t4 + crow(r, hi)], pn); pv[r] = pn * g0; }
            pv_sub(ot, Vb0 + (t4 >> 1) * 8192, pv, t4 & 1, lane);
        }
    }
    __syncthreads();
    if (i >= 16) {
        const int q = tid >> 3, jj = tid & 7, jmax = i - 2;
        for (int j = 1 + jj; j <= jmax; j += 8) { const float* ip = imp + q * 129 + 4 * j;
            imps[q * 33 + j] = 0.5f * ip[-1] + ip[0] + ip[1] + ip[2] + 0.5f * ip[3]; }
        __syncthreads();
        for (int j = 1 + jj; j <= jmax; j += 8) { const float vj = imps[q * 33 + j]; int cnt = 0;
            for (int k = 1; k <= jmax; ++k) { const float vk = imps[q * 33 + k]; cnt += (vk > vj || (vk == vj && k < j)) ? 1 : 0; }
            if (cnt < 13) atomicOr(&mask[q], 1u << j); }
        __syncthreads();
    }
    const unsigned selm = mask[ql];
    {
        const bf16_t* KSg = (const bf16_t*)(p.ws + WS_KS); const bf16_t* VSg = (const bf16_t*)(p.ws + WS_VS);
        const bf16_t* KWg = (const bf16_t*)(p.ws + WS_KW); const bf16_t* VWg = (const bf16_t*)(p.ws + WS_VW);
        const int nts = i + 1, t0w = i > 8 ? i - 8 : 0, NT = nts + (i - t0w + 1);
        float m = -1e30f, l = 0.f; f32x16 o[2]; o[0] = f32x16{}; o[1] = f32x16{};
        { const KVregs kv = kv_load(KSg, VSg, (size_t)b * SEQ, 63, 128, g * 64, tid); kv_store(Kb0, Vb0, kv, tid); }
#pragma unroll 1
        for (int t = 0; t < NT; ++t) {
            __syncthreads();
            KVregs nx; const bool more = t + 1 < NT;
            if (more) { const int tn = t + 1; const bool wn = tn >= nts; const int jn = wn ? t0w + tn - nts : tn;
                nx = kv_load(wn ? KWg : KSg, wn ? VWg : VSg, (size_t)b * SEQ + 64 * jn, 63, 128, g * 64, tid); }
            const bool isw = t >= nts; const int j = isw ? t0w + t - nts : t;
            if (t == nts) { l = xhalf_sum(l); const float sc = l > 0.f ? g1 / l : 0.f;
#pragma unroll
                for (int r = 0; r < 16; ++r) { ot[0][r] += sc * o[0][r]; ot[1][r] += sc * o[1][r]; o[0][r] = 0.f; o[1][r] = 0.f; }
                m = -1e30f; l = 0.f; }
            attn_tile(Kb0 + (t & 1) * 8192, Vb0 + (t & 1) * 8192, qr, bt, 64 * j, qpos, isw, (selm >> (j & 31)) & 1u, m, l, o, lane);
            if (more) kv_store(Kb0 + ((t + 1) & 1) * 8192, Vb0 + ((t + 1) & 1) * 8192, nx, tid);
        }
        l = xhalf_sum(l); const float sc = l > 0.f ? g2 / l : 0.f;
#pragma unroll
        for (int r = 0; r < 16; ++r) { ot[0][r] += sc * o[0][r]; ot[1][r] += sc * o[1][r]; }
    }
    bf16_t* AO = (bf16_t*)(p.ws + WS_AO) + row * 1024 + head * 64;
#pragma unroll
    for (int eb = 0; eb < 2; ++eb)
#pragma unroll
        for (int a = 0; a < 4; ++a) { u32x2 ov; ov.x = pk2(ot[eb][4 * a], ot[eb][4 * a + 1]); ov.y = pk2(ot[eb][4 * a + 2], ot[eb][4 * a + 3]); *(u32x2*)(AO + 32 * eb + 8 * a + 4 * hi) = ov; }
    __syncthreads();
}

constexpr int SA_Q = 0, SA_SC = 256, SA_IMP = SA_SC + 4096, SA_IMPS = SA_IMP + 1024, SA_SEL = SA_IMPS + 256, SA_ML = SA_SEL + 16, SA_OB = SA_ML + 8, SA_OT = SA_OB + 512, SA_PART = SA_OT + 256, SA_END = SA_PART + 64 * 256;
__device__ __forceinline__ void dot4_f32(const float* key, const float* q, float* a) {
#pragma unroll 2
    for (int d = 0; d < 64; d += 4) { const f32x4 kv = *(const f32x4*)(key + d);
#pragma unroll
        for (int r = 0; r < 4; ++r) { const f32x4 qv = *(const f32x4*)(q + r * 64 + d); a[r] += kv[0] * qv[0] + kv[1] * qv[1] + kv[2] * qv[2] + kv[3] * qv[3]; } }
}
__device__ __forceinline__ void dot4_bf16(const bf16_t* key, const float* q, float* a) {
#pragma unroll 2
    for (int d = 0; d < 64; d += 8) { const u32x4 kw = *(const u32x4*)(key + d); const float kf[8] = {bflo(kw.x), bfhi(kw.x), bflo(kw.y), bfhi(kw.y), bflo(kw.z), bfhi(kw.z), bflo(kw.w), bfhi(kw.w)};
#pragma unroll
        for (int r = 0; r < 4; ++r) { const f32x4 q0 = *(const f32x4*)(q + r * 64 + d), q1 = *(const f32x4*)(q + r * 64 + d + 4);
            a[r] += kf[0] * q0[0] + kf[1] * q0[1] + kf[2] * q0[2] + kf[3] * q0[3] + kf[4] * q1[0] + kf[5] * q1[1] + kf[6] * q1[2] + kf[7] * q1[3]; } }
}
struct Slot { const float* kf; const float* vf; const bf16_t* kb; const bf16_t* vb; int dist; bool valid; };
template <int BR>
__device__ __forceinline__ Slot sa_slot(const Params& p, int b, int g, int slot, const int* sel, const int* selb) {
    Slot s; s.kf = nullptr; s.vf = nullptr; s.kb = nullptr; s.vb = nullptr; s.valid = true; s.dist = 0;
    const size_t row = (size_t)MP + b;
    if (BR == 0) { const size_t off = ((size_t)(b * 1024 + slot) * 2 + g) * 64; s.kb = (const bf16_t*)(p.ws + WS_CKCS) + off; s.vb = (const bf16_t*)(p.ws + WS_CVCS) + off; s.dist = PAST - (16 * slot + 31); }
    else if (BR == 1) { const int blk = sel[slot >> 6], kk = slot & 63, pos = 64 * blk + kk;
        if (blk == 256) { s.valid = (kk == 0); s.kb = (const bf16_t*)(p.ws + WS_KS) + row * 128 + g * 64; s.vb = (const bf16_t*)(p.ws + WS_VS) + row * 128 + g * 64; s.dist = 0; }
        else { const size_t off = (size_t)selb[slot >> 6] + (size_t)kk * 128; s.kf = p.in[4] + off; s.vf = p.in[5] + off; s.dist = PAST - pos; } }
    else { const int j = slot + 1;
        if (j == 512) { s.kb = (const bf16_t*)(p.ws + WS_KW) + row * 128 + g * 64; s.vb = (const bf16_t*)(p.ws + WS_VW) + row * 128 + g * 64; s.dist = 0; }
        else { const size_t off = (((size_t)b * 512 + j) * 2 + g) * 64; s.kf = p.in[6] + off; s.vf = p.in[7] + off; s.dist = 512 - j; } }
    return s;
}
template <int BR>
__device__ __forceinline__ void sa_branch(const Params& p, float* L, int b, int g, int nslots, const float* btg, const float* gates  ) {
    const int tid = threadIdx.x, lane = tid & 63, w = tid >> 6;
    float* q = L + SA_Q; float* sc = L + SA_SC; float* ml = L + SA_ML; float* ob = L + SA_OB; float* ot = L + SA_OT; const int* sel = (const int*)(L + SA_SEL);
    for (int slot = tid; slot < nslots; slot += 512) {
        const Slot s = sa_slot<BR>(p, b, g, slot, sel, (const int*)(L + SA_IMPS)); float a[4] = {0.f, 0.f, 0.f, 0.f};
        if (s.valid) { if (s.kf) dot4_f32(s.kf, q, a); else dot4_bf16(s.kb, q, a); }
        const int di = s.dist > 127 ? 127 : s.dist;
#pragma unroll
        for (int r = 0; r < 4; ++r) sc[r * 1024 + slot] = s.valid ? a[r] + btg[r * 128 + di] : -1e30f;
    }
    __syncthreads();
    if (w < 4) { float mx = -1e30f;
        for (int s = lane; s < nslots; s += 64) mx = fmaxf(mx, sc[w * 1024 + s]);
#pragma unroll
        for (int of = 1; of < 64; of <<= 1) mx = fmaxf(mx, __shfl_xor(mx, of));
        float sum = 0.f;
        for (int s = lane; s < nslots; s += 64) { const float v = sc[w * 1024 + s]; const float e = v > -1e29f ? exp2f(v - mx) : 0.f; sc[w * 1024 + s] = e; sum += e; }
#pragma unroll
        for (int of = 1; of < 64; of <<= 1) sum += __shfl_xor(sum, of);
        const float inv = sum > 0.f ? 1.f / sum : 0.f;
        for (int s = lane; s < nslots; s += 64) sc[w * 1024 + s] *= inv;
    }
    __syncthreads();
    { const int sl = tid >> 3, e0 = (tid & 7) * 8; float acc[4][8];
#pragma unroll
      for (int r = 0; r < 4; ++r)
#pragma unroll
          for (int e = 0; e < 8; ++e) acc[r][e] = 0.f;
      const size_t row = (size_t)MP + b;
      const int* selb = (const int*)(L + SA_IMPS);
#pragma unroll 4
      for (int slot = sl; slot < nslots; slot += 64) {
          float pr[4];
#pragma unroll
          for (int r = 0; r < 4; ++r) pr[r] = sc[r * 1024 + slot];
          const float* vf = nullptr; const bf16_t* vb = nullptr;
          if (BR == 0) vb = (const bf16_t*)(p.ws + WS_CVCS) + ((size_t)(b * 1024 + slot) * 2 + g) * 64;
          else if (BR == 1) { const int si = slot >> 6, kk = slot & 63; if (sel[si] == 256) vb = (const bf16_t*)(p.ws + WS_VS) + row * 128 + g * 64; else vf = p.in[5] + (size_t)selb[si] + (size_t)kk * 128; }
          else { if (slot == 511) vb = (const bf16_t*)(p.ws + WS_VW) + row * 128 + g * 64; else vf = p.in[7] + (((size_t)b * 512 + slot + 1) * 2 + g) * 64; }
          float vv[8];
          if (vf) { const f32x4 a0 = *(const f32x4*)(vf + e0), a1 = *(const f32x4*)(vf + e0 + 4); vv[0] = a0[0]; vv[1] = a0[1]; vv[2] = a0[2]; vv[3] = a0[3]; vv[4] = a1[0]; vv[5] = a1[1]; vv[6] = a1[2]; vv[7] = a1[3]; }
          else { const u32x4 w = *(const u32x4*)(vb + e0); vv[0] = bflo(w.x); vv[1] = bfhi(w.x); vv[2] = bflo(w.y); vv[3] = bfhi(w.y); vv[4] = bflo(w.z); vv[5] = bfhi(w.z); vv[6] = bflo(w.w); vv[7] = bfhi(w.w); }
#pragma unroll
          for (int r = 0; r < 4; ++r)
#pragma unroll
              for (int e = 0; e < 8; ++e) acc[r][e] += pr[r] * vv[e];
      }
      float* part = L + SA_PART;
#pragma unroll
      for (int r = 0; r < 4; ++r) { *(f32x4*)(part + sl * 256 + r * 64 + e0) = (f32x4){acc[r][0], acc[r][1], acc[r][2], acc[r][3]}; *(f32x4*)(part + sl * 256 + r * 64 + e0 + 4) = (f32x4){acc[r][4], acc[r][5], acc[r][6], acc[r][7]}; }
    }
    __syncthreads();
    if (tid < 256) { float a = 0.f; const float* part = L + SA_PART;
#pragma unroll 8
        for (int q = 0; q < 64; ++q) a += part[q * 256 + tid];
        ob[tid] = a; ob[256 + tid] = 0.f; }
    if (tid < 256) { const int r = tid >> 6; ot[tid] += gates[r] * (ob[tid] + ob[256 + tid]); }
    __syncthreads();
    (void)ml;
}
__device__ __forceinline__ void attn_sample_unit(const Params& p, unsigned char* lds, int b, int g) {
    const int tid = threadIdx.x;
    float* L = (float*)lds; float* q = L + SA_Q; float* sc = L + SA_SC; float* imp = L + SA_IMP; float* imps = L + SA_IMPS; int* sel = (int*)(L + SA_SEL); float* ot = L + SA_OT; float* gsh = L + SA_ML;
    const size_t row = (size_t)MP + b;
    if (tid < 256) { q[tid] = bf1(((const bf16_t*)(p.ws + WS_Q))[row * 512 + g * 256 + tid]); ot[tid] = 0.f; }
    __syncthreads();
    const float* btg = (const float*)(p.ws + WS_BTAB) + (g * 4) * 128;
    const float* GT = (const float*)(p.ws + WS_GATE) + row * 24 + g * 4;
    sa_branch<0>(p, L, b, g, NC_S, btg, GT);
    for (int c = tid; c < NC_S; c += 512) imp[c] = sc[c] + sc[1024 + c] + sc[2048 + c] + sc[3072 + c];
    __syncthreads();
    if (tid >= 1 && tid <= 254) { const int j = tid; imps[j] = 0.5f * imp[4 * j - 1] + imp[4 * j] + imp[4 * j + 1] + imp[4 * j + 2] + 0.5f * imp[4 * j + 3]; }
    if (tid == 0) { sel[0] = 0; sel[1] = 255; sel[2] = 256; }
    __syncthreads();
    if (tid >= 1 && tid <= 254) { const float vj = imps[tid]; int cnt = 0;
        for (int k = 1; k <= 254; ++k) { const float vk = imps[k]; cnt += (vk > vj || (vk == vj && k < tid)) ? 1 : 0; }
        if (cnt < 13) sel[3 + cnt] = tid; }
    __syncthreads();
    if (tid < 16) { const int blk = sel[tid]; int off = 0;
        if (blk < 256) { const int page = p.page_table[b * NPAGES + (blk >> 1)]; off = ((page * PAGE + (blk & 1) * 64) * 2 + g) * 64; }
        ((int*)imps)[tid] = off; }
    __syncthreads();
    sa_branch<1>(p, L, b, g, 1024, btg, GT + 8);
    sa_branch<2>(p, L, b, g, 512, btg, GT + 16);
    if (tid < 256) { const unsigned pk = pk2(ot[tid], 0.f); ((bf16_t*)(p.ws + WS_AO))[row * 1024 + g * 256 + tid] = (bf16_t)(pk & 0xffffu); }
    __syncthreads();
    (void)gsh;
}

__device__ __forceinline__ void skinny_tile(const bf16_t* X, int lda, const bf16_t* Wt, int K, int rowA, int rowB, float* red, float* T) {
    const int tid = threadIdx.x, lane = tid & 63, w = __builtin_amdgcn_readfirstlane(tid >> 6), r32 = lane & 31, hi = lane >> 5;
    const int kw = K >> 3;
    f32x16 acc0 = f32x16{}, acc1 = f32x16{};
    const bf16_t* xp = X + (size_t)r32 * lda + w * kw + 8 * hi;
    const bf16_t* wa = Wt + (size_t)(rowA + r32) * K + w * kw + 8 * hi;
    const bf16_t* wb = Wt + (size_t)(rowB + r32) * K + w * kw + 8 * hi;
#pragma unroll 4
    for (int k = 0; k < kw; k += 16) { const bf16x8 xf = *(const bf16x8*)(xp + k), fa = *(const bf16x8*)(wa + k), fb = *(const bf16x8*)(wb + k);
        acc0 = __builtin_amdgcn_mfma_f32_32x32x16_bf16(fa, xf, acc0, 0, 0, 0); acc1 = __builtin_amdgcn_mfma_f32_32x32x16_bf16(fb, xf, acc1, 0, 0, 0); }
#pragma unroll
    for (int r = 0; r < 16; ++r) { red[((w * 2 + 0) * 16 + r) * 64 + lane] = acc0[r]; red[((w * 2 + 1) * 16 + r) * 64 + lane] = acc1[r]; }
    __syncthreads();
#pragma unroll
    for (int q = 0; q < 4; ++q) { const int idx = tid + 512 * q, l2 = idx & 63, br = idx >> 6, blk = br >> 4, r = br & 15; float a = 0.f;
#pragma unroll
        for (int ww = 0; ww < 8; ++ww) a += red[((ww * 2 + blk) * 16 + r) * 64 + l2];
        T[(l2 & 31) * 65 + 32 * blk + crow(r, l2 >> 5)] = a; }
    __syncthreads();
}
__device__ __forceinline__ float grp16_sum(float v) { v += __shfl_xor(v, 1); v += __shfl_xor(v, 2); v += __shfl_xor(v, 4); v += __shfl_xor(v, 8); return v; }
__device__ __forceinline__ void st4bf(bf16_t* dst, const float* v) { u32x2 o; o.x = pk2(v[0], v[1]); o.y = pk2(v[2], v[3]); *(u32x2*)dst = o; }
__device__ __forceinline__ void st4f(float* dst, const float* v) { *(f32x4*)dst = (f32x4){v[0], v[1], v[2], v[3]}; }
template <int WHICH> __device__ __forceinline__ void skinny_phase(const Params& p, unsigned char* lds) {
    const int tid = threadIdx.x, bid = blockIdx.x, G = gridDim.x;
    unsigned char* ws = p.ws;
    float* red = (float*)lds; float* T = (float*)(lds + 65536);
    const int row = tid >> 4, c4 = (tid & 15) * 4, bj = c4 >> 5, tt = c4 & 31; const size_t grow = (size_t)MP + row;
    const bf16_t* X; const bf16_t* Wt; int lda, K, nitems;
    if (WHICH == 1) { X = (const bf16_t*)(ws + WS_XB); lda = DM; Wt = (const bf16_t*)(ws + WS_W1); K = DM; nitems = 53; }
    else if (WHICH == 5) { X = (const bf16_t*)(ws + WS_AO); lda = DM; Wt = (const bf16_t*)(ws + WS_WO); K = DM; nitems = 16; }
    else if (WHICH == 6) { X = (const bf16_t*)(ws + WS_HB); lda = DM; Wt = (const bf16_t*)(ws + WS_WGU); K = DM; nitems = 88; }
    else if (WHICH == 7) { X = (const bf16_t*)(ws + WS_ACT); lda = DFF; Wt = (const bf16_t*)(ws + WS_WD); K = DFF; nitems = 16; }
    else if (WHICH == 9) { X = (const bf16_t*)(ws + WS_PB); lda = PLE; Wt = (const bf16_t*)(ws + WS_WPP); K = PLE; nitems = 16; }
    else { X = (const bf16_t*)(ws + WS_H2B); lda = DM; Wt = (const bf16_t*)(ws + WS_WPG); K = DM; nitems = 16; }
    X += (size_t)MP * lda;
    for (int it = bid; it < nitems; it += G) {
        const int pn = it >> 2, wc = it & 3;
        skinny_tile(X, lda, Wt, K, pn * 256 + wc * 32, pn * 256 + 128 + wc * 32, red, T);
        float x[4];
#pragma unroll
        for (int e = 0; e < 4; ++e) x[e] = T[row * 65 + c4 + e];
        if (WHICH == 1) {
            const float s1 = ((const float*)(ws + WS_SS1))[grow];
            if (pn < 2 || pn == 3) {
                float v[4], ss = 0.f;
#pragma unroll
                for (int e = 0; e < 4; ++e) { v[e] = x[e] * s1; ss += v[e] * v[e]; }
                ss = grp16_sum(ss);
                const float* nw = (pn < 2) ? p.in[14] : p.in[15]; const float rs = rsqrtf(ss * (1.f / 64.f) + EPS) * ((pn < 2) ? 0.125f * LOG2E : 1.f);
                const int d0 = 32 * bj + tt;
#pragma unroll
                for (int e = 0; e < 4; ++e) v[e] *= rs * nw[d0 + e];
                if (pn < 2) st4bf((bf16_t*)(ws + WS_Q) + grow * 512 + (pn * 4 + wc) * 64 + d0, v);
                else { const int col = (wc & 1) * 64 + d0;
                    if (wc < 2) { st4bf((bf16_t*)(ws + WS_KS) + grow * 128 + col, v); st4f(p.out + O_SSK + (size_t)row * 128 + col, v); }
                    else { st4bf((bf16_t*)(ws + WS_KW) + grow * 128 + col, v); st4f(p.out + O_SWK + ((size_t)row * 512 + 511) * 128 + col, v); } }
            } else if (pn == 2 || pn == 4) {
                float v[4];
#pragma unroll
                for (int e = 0; e < 4; ++e) v[e] = x[e] * s1;
                const int col = 32 * wc + tt;
                if (pn == 2) st4f(p.out + (bj ? O_SCV : O_SCK) + (size_t)row * 128 + col, v);
                else if (bj == 0) { st4bf((bf16_t*)(ws + WS_VS) + grow * 128 + col, v); st4f(p.out + O_SSV + (size_t)row * 128 + col, v); }
                else { st4bf((bf16_t*)(ws + WS_VW) + grow * 128 + col, v); st4f(p.out + O_SWV + ((size_t)row * 512 + 511) * 128 + col, v); }
            } else if (pn <= 8) {
                const int isk = (pn >= 7) ? 1 : 0, head = ((pn - 5) & 1) * 2 + (wc >> 1), j0 = 32 * (wc & 1) + tt;
                const float sc = s1 * (isk ? 0.08838834764831845f : 1.f);
                const float* rp = (const float*)(ws + WS_ROT) + ((size_t)2048 * 64 + j0) * 2;
                float v[4];
#pragma unroll
                for (int e = 0; e < 4; ++e) { const float x1 = T[row * 65 + tt + e] * sc, x2 = T[row * 65 + 32 + tt + e] * sc, c = rp[2 * e], sn = rp[2 * e + 1];
                    v[e] = bj ? (x1 * sn + x2 * c) : (x1 * c - x2 * sn); }
                st4bf((bf16_t*)(ws + (isk ? WS_RK : WS_RQ)) + grow * 512 + head * 128 + 64 * bj + j0, v);
            } else if (pn <= 12) {
                const int isg = pn >= 11; float v[4];
#pragma unroll
                for (int e = 0; e < 4; ++e) { const float y = x[e] * s1; v[e] = isg ? siluf_(y) : y; }
                st4bf((bf16_t*)(ws + (isg ? WS_RG : WS_RV)) + grow * 512 + ((pn - 9) & 1) * 256 + 128 * bj + 32 * wc + tt, v);
            } else {
                if (bj == 0 && tt < 24) { float v[4];
#pragma unroll
                    for (int e = 0; e < 4; ++e) v[e] = sigmoidf_(x[e] * s1);
                    st4f((float*)(ws + WS_GATE) + grow * 24 + tt, v); }
            }
        } else {
            const int col = pn * 256 + 128 * bj + 32 * wc + tt; const size_t off = grow * DM + col;
            if (WHICH == 5) { float v[4], ss = 0.f; const f32x4 xs = *(const f32x4*)(p.in[1] + (size_t)row * DM + col);
#pragma unroll
                for (int e = 0; e < 4; ++e) { v[e] = x[e] + xs[e]; ss += v[e] * v[e]; }
                st4f((float*)(ws + WS_H) + off, v); st4bf((bf16_t*)(ws + WS_HB) + off, v);
                ss = grp16_sum(ss); if ((tid & 15) == 0) atomicAdd((float*)(ws + WS_SS2) + grow, ss);
            } else if (WHICH == 6) {
                if (bj == 0) { const float s2 = rsqrtf(((const float*)(ws + WS_SS2))[grow] * (1.f / 1024.f) + EPS); float v[4];
#pragma unroll
                    for (int e = 0; e < 4; ++e) v[e] = siluf_(x[e] * s2) * (T[row * 65 + 32 + tt + e] * s2);
                    st4bf((bf16_t*)(ws + WS_ACT) + grow * DFF + pn * 128 + 32 * wc + tt, v); }
            } else if (WHICH == 7) { float v[4]; const f32x4 h = *(const f32x4*)((const float*)(ws + WS_H) + off);
#pragma unroll
                for (int e = 0; e < 4; ++e) v[e] = x[e] + h[e];
                st4f((float*)(ws + WS_H2) + off, v); st4bf((bf16_t*)(ws + WS_H2B) + off, v);
            } else if (WHICH == 9) { st4f((float*)(ws + WS_VP) + off, x);
            } else { float v[4]; const f32x4 h = *(const f32x4*)((const float*)(ws + WS_H2) + off), vp = *(const f32x4*)((const float*)(ws + WS_VP) + off);
#pragma unroll
                for (int e = 0; e < 4; ++e) v[e] = h[e] + sigmoidf_(x[e]) * vp[e];
                st4f(p.out + O_YS + (size_t)row * DM + col, v); }
        }
        __syncthreads();
    }
}

constexpr int LDS_BYTES = pg8::STAGE_BYTES + 256;
constexpr int NPHASE = 9;
#ifndef REPEAT_PHASE
#define REPEAT_PHASE -1
#endif
template <int K> __device__ __forceinline__ void phase_body(const Params& p, unsigned char* lds) {
    const int tid = threadIdx.x, bid = blockIdx.x, G = gridDim.x;
    const int wv = __builtin_amdgcn_readfirstlane(tid >> 6);
    unsigned char* ws = p.ws;
    if constexpr (K == 0) phase_prologue(p, lds);
    if constexpr (K == 1) {
        pg8::Gemm g{(const bf16_t*)(ws + WS_XB), (const bf16_t*)(ws + WS_W1), MP, N1, DM};
        {   SubsetOrder S; S.init(MP, 7 * 256, G, bid); S.set = 0;
            EpiProj<0> E; E.ss1 = (const float*)(ws + WS_SS1); E.qn = p.in[14]; E.kn = p.in[15]; E.rot = (const float*)(ws + WS_ROT);
            E.Q = (bf16_t*)(ws + WS_Q); E.CA = (bf16_t*)(ws + WS_CA); E.KS = (bf16_t*)(ws + WS_KS); E.VS = (bf16_t*)(ws + WS_VS); E.KW = (bf16_t*)(ws + WS_KW); E.VW = (bf16_t*)(ws + WS_VW);
            E.RQ = (bf16_t*)(ws + WS_RQ); E.RK = (bf16_t*)(ws + WS_RK); E.RV = (bf16_t*)(ws + WS_RV); E.RG = (bf16_t*)(ws + WS_RG); E.GATE = (float*)(ws + WS_GATE); E.out = p.out;
            pg8::gemm_phase((LAS unsigned char*)lds, g, S, E); }
        {   SubsetOrder S; S.init(MP, 7 * 256, G, bid); S.set = 1;
            EpiProj<1> E; E.ss1 = (const float*)(ws + WS_SS1); E.qn = p.in[14]; E.kn = p.in[15]; E.rot = (const float*)(ws + WS_ROT);
            E.Q = (bf16_t*)(ws + WS_Q); E.CA = (bf16_t*)(ws + WS_CA); E.KS = (bf16_t*)(ws + WS_KS); E.VS = (bf16_t*)(ws + WS_VS); E.KW = (bf16_t*)(ws + WS_KW); E.VW = (bf16_t*)(ws + WS_VW);
            E.RQ = (bf16_t*)(ws + WS_RQ); E.RK = (bf16_t*)(ws + WS_RK); E.RV = (bf16_t*)(ws + WS_RV); E.RG = (bf16_t*)(ws + WS_RG); E.GATE = (float*)(ws + WS_GATE); E.out = p.out;
            pg8::gemm_phase((LAS unsigned char*)lds, g, S, E); }
        skinny_phase<1>(p, lds);
    }
    if constexpr (K == 2) {
        { pg8::Gemm g{(const bf16_t*)(ws + WS_CA), (const bf16_t*)(ws + WS_W1C), 2 * CROWS, 256, 1024};
          CmpOrder S; S.G = G; S.c = bid; EpiCmp E; E.C = (float*)(ws + WS_CP);
          pg8::gemm_phase((LAS unsigned char*)lds, g, S, E); }
        __syncthreads();
        for (int u = bid; u < NB * 4 * 16; u += G) ret_r1_unit(p, lds, u >> 6, (u >> 4) & 3, u & 15);
        for (int u = bid; u < DB * 4; u += G) ret_sample_unit(p, lds, u >> 2, u & 3);
    }
    if constexpr (K == 3) {
        for (int u = bid; u < NB * 4 * 16; u += G) ret_r2_unit(p, lds, u >> 6, (u >> 4) & 3, u & 15);
        constexpr int NT = CROWS / 32;
        for (int t = bid * 8 + wv; t < 2 * NT; t += G * 8) compress2_task(p, t / NT, t % NT, tid & 63);
        pret_job(p);
    }
    if constexpr (K == 4) {
        unsigned* qh = (unsigned*)(ws + WS_QUEUE);
        volatile LAS unsigned* qs = (volatile LAS unsigned*)(lds + pg8::STAGE_BYTES + 16);
        for (;;) {
            if (tid == 0) *qs = __hip_atomic_fetch_add(qh, 1u, __ATOMIC_RELAXED, __HIP_MEMORY_SCOPE_AGENT);
            __syncthreads();
            const unsigned it = *qs;
            __syncthreads();
            if (it >= 576u) break;
            if (it < 64u) attn_sample_unit(p, lds, (int)(it >> 1), (int)(it & 1));
            else { const int q = (int)it - 64, bg = q & 15; attn_prompt_unit(p, lds, bg >> 1, bg & 1, 31 - (q >> 4)); }
        }
    }
    if constexpr (K == 5) {
        pg8::Gemm g{(const bf16_t*)(ws + WS_AO), (const bf16_t*)(ws + WS_WO), MP, DM, DM};
        pg8::StaticOrder S; S.init(MP, DM, G, bid);
        EpiOut E; E.xp = p.in[0]; E.xs = p.in[1]; E.H = (float*)(ws + WS_H); E.HB = (bf16_t*)(ws + WS_HB); E.SS2 = (float*)(ws + WS_SS2);
        pg8::gemm_phase((LAS unsigned char*)lds, g, S, E);
        skinny_phase<5>(p, lds);
    }
    if constexpr (K == 6) {
        pg8::Gemm g{(const bf16_t*)(ws + WS_HB), (const bf16_t*)(ws + WS_WGU), MP, NGU, DM};
        pg8::StaticOrder S; S.init(MP, NGU, G, bid);
        EpiGU E; E.SS2 = (const float*)(ws + WS_SS2); E.ACT = (bf16_t*)(ws + WS_ACT);
        pg8::gemm_phase((LAS unsigned char*)lds, g, S, E);
        skinny_phase<6>(p, lds);
    }
    if constexpr (K == 7) {
        { pg8::Gemm g{(const bf16_t*)(ws + WS_ACT), (const bf16_t*)(ws + WS_WD), MP, DM, DFF};
          pg8::StaticOrder S; S.init(MP, DM, G, bid);
          EpiDown E; E.H = (const float*)(ws + WS_H); E.H2 = (float*)(ws + WS_H2); E.H2B = (bf16_t*)(ws + WS_H2B);
          pg8::gemm_phase((LAS unsigned char*)lds, g, S, E); }
        { pg8::Gemm g{(const bf16_t*)(ws + WS_PB), (const bf16_t*)(ws + WS_WPP), MP, DM, PLE};
          pg8::StaticOrder S; S.init(MP, DM, G, bid);
          EpiF32 E; E.C = (float*)(ws + WS_VP); E.ld = DM;
          pg8::gemm_phase((LAS unsigned char*)lds, g, S, E); }
        skinny_phase<7>(p, lds);
        skinny_phase<9>(p, lds);
    }
    if constexpr (K == 8) {
        pg8::Gemm g{(const bf16_t*)(ws + WS_H2B), (const bf16_t*)(ws + WS_WPG), MP, DM, DM};
        pg8::StaticOrder S; S.init(MP, DM, G, bid);
        EpiFinal E; E.H2 = (const float*)(ws + WS_H2); E.VP = (const float*)(ws + WS_VP); E.out = p.out;
        pg8::gemm_phase((LAS unsigned char*)lds, g, S, E);
        skinny_phase<8>(p, lds);
    }
}
__global__ void __launch_bounds__(512, 2) nsa_ret_fwd(Params p) {
    extern __shared__ __attribute__((aligned(16))) unsigned char lds[];
    const int tid = threadIdx.x;
    unsigned char* ws = p.ws;
    if (tid < 4) ((LAS unsigned*)(lds + pg8::STAGE_BYTES))[tid] = 0u;
    __syncthreads();
    const bool fused = (p.ph_hi - p.ph_lo) > 1;
    XcdBarrier bar; bar.bar = (unsigned*)(ws + WS_CTL); bar.x = 0; bar.st = (volatile LAS unsigned*)(lds + pg8::STAGE_BYTES);
    if (fused) bar = xcd_barrier_post((unsigned*)(ws + WS_CTL), (volatile LAS unsigned*)(lds + pg8::STAGE_BYTES));
#define PH_ON(k) (p.ph_lo <= (k) && (k) < p.ph_hi)
#define SEAM(k) do { if (PH_ON(k) && PH_ON((k) + 1)) xcd_barrier(bar); } while (0)
#define PHASE(k) do { if (PH_ON(k)) { phase_body<k>(p, lds); if (REPEAT_PHASE == (k)) { __syncthreads(); phase_body<k>(p, lds); } } } while (0)
    PHASE(0); SEAM(0);
    PHASE(1); SEAM(1);
    PHASE(2); SEAM(2);
    PHASE(3); SEAM(3);
    PHASE(4); SEAM(4);
    PHASE(5); SEAM(5);
    PHASE(6); SEAM(6);
    PHASE(7); SEAM(7);
    PHASE(8);
}

extern "C" void kernel_launch(void* const* d_in, const int* in_sizes, int n_in, void* d_out, int out_size, void* d_ws, size_t ws_size, hipStream_t stream) {
    static int grid = 0;
    if (grid == 0) {
        if (n_in != 31 || (size_t)out_size != O_END || ws_size < WS_END) { fprintf(stderr, "kernel_launch: unexpected shapes: n_in %d out %d ws %zu (need %zu)\n", n_in, out_size, ws_size, (size_t)WS_END); grid = -1; return; }
        int dev = 0, cus = 0;
        if (hipGetDevice(&dev) != hipSuccess || hipDeviceGetAttribute(&cus, hipDeviceAttributeMultiprocessorCount, dev) != hipSuccess) { grid = -1; return; }
        if (hipFuncSetAttribute((const void*)nsa_ret_fwd, hipFuncAttributeMaxDynamicSharedMemorySize, LDS_BYTES) != hipSuccess) { fprintf(stderr, "kernel_launch: hipFuncSetAttribute failed\n"); grid = -1; return; }
        int per_cu = 0;
        if (hipOccupancyMaxActiveBlocksPerMultiprocessor(&per_cu, (const void*)nsa_ret_fwd, 512, LDS_BYTES) != hipSuccess || per_cu < 1) { fprintf(stderr, "kernel_launch: occupancy query says %d blocks per CU\n", per_cu); }
        (void)hipGetLastError();
        grid = cus;
    }
    if (grid < 0) return;
    (void)hipMemsetAsync((char*)d_ws + WS_CTL, 0, CTL_BYTES, stream);
    Params p; memset(&p, 0, sizeof(p));
    for (int i = 0; i < 31; ++i) p.in[i] = (const float*)d_in[i];
    p.page_table = (const int*)d_in[9]; p.out = (float*)d_out; p.ws = (unsigned char*)d_ws;
#if MK_PER_PHASE_LAUNCH
    for (int ph = 0; ph < NPHASE; ++ph) { p.ph_lo = ph; p.ph_hi = ph + 1; hipLaunchKernelGGL(nsa_ret_fwd, dim3(grid), dim3(512), LDS_BYTES, stream, p); }
#else
    p.ph_lo = 0; p.ph_hi = NPHASE; hipLaunchKernelGGL(nsa_ret_fwd, dim3(grid), dim3(512), LDS_BYTES, stream, p);
#endif
}
```

```cpp
#include <hip/hip_runtime.h>
#include <cstdio>
#include <cstdint>
#include <cstring>

#ifndef MK_PER_PHASE_LAUNCH
#define MK_PER_PHASE_LAUNCH 0
#endif

constexpr int DM = 1024, NB = 8, SEQ = 2048, DB = 32, PAST = 16384, PAGE = 128, NPAGES = 128;
constexpr int MP = NB * SEQ;
constexpr int MV = MP + DB;
constexpr int MR = 16640;
constexpr int INC = 3352, N1 = 3584, DFF = 2816, NGU = 5632, PLE = 256;
constexpr int NSEG_S = 1024, NSEG_P = 128;
constexpr int CROWS_S = DB * NSEG_S * 2;
constexpr int CROWS_P = NB * NSEG_P * 2;
constexpr int CROWS = CROWS_S + CROWS_P;
constexpr int NC_P = 127, NC_S = 1023;
constexpr float EPS = 1e-6f;
constexpr float LOG2E = 1.4426950408889634f;

constexpr size_t O_YP = 0, O_YS = O_YP + (size_t)MP * DM, O_PCK = O_YS + (size_t)DB * DM, O_PCV = O_PCK + (size_t)MP * 128, O_PSK = O_PCV + (size_t)MP * 128,
                 O_PSV = O_PSK + (size_t)MP * 128, O_PWK = O_PSV + (size_t)MP * 128, O_PWV = O_PWK + (size_t)NB * 512 * 128, O_PRET = O_PWV + (size_t)NB * 512 * 128,
                 O_SCK = O_PRET + (size_t)NB * 4 * 128 * 128, O_SCV = O_SCK + DB * 128, O_SSK = O_SCV + DB * 128, O_SSV = O_SSK + DB * 128, O_SWK = O_SSV + DB * 128,
                 O_SWV = O_SWK + (size_t)DB * 512 * 128, O_SRET = O_SWV + (size_t)DB * 512 * 128, O_END = O_SRET + (size_t)DB * 4 * 128 * 128;

constexpr size_t al256(size_t x) { return (x + 255) & ~(size_t)255; }
constexpr size_t WS_CTL = 0, CTL_BYTES = 16384;
constexpr size_t WS_W1 = WS_CTL + CTL_BYTES;
constexpr size_t WS_WO = WS_W1 + (size_t)N1 * DM * 2;
constexpr size_t WS_WGU = WS_WO + (size_t)DM * DM * 2;
constexpr size_t WS_WD = WS_WGU + (size_t)NGU * DM * 2;
constexpr size_t WS_WPG = WS_WD + (size_t)DM * DFF * 2;
constexpr size_t WS_WPP = WS_WPG + (size_t)DM * DM * 2;
constexpr size_t WS_W1C = WS_WPP + (size_t)DM * PLE * 2;
constexpr size_t WS_W2C = WS_W1C + (size_t)2 * 256 * 1024 * 2;
constexpr size_t WS_BIASC = WS_CTL + 14336;
constexpr size_t WS_QUEUE = WS_CTL + 15360;
constexpr size_t WS_BTAB = WS_W2C + (size_t)2 * 64 * 128 * 2;
constexpr size_t WS_ROT = WS_BTAB + 4096;
constexpr size_t WS_SS1 = al256(WS_ROT + (size_t)2049 * 64 * 8);
constexpr size_t WS_SS2 = WS_SS1 + (size_t)MR * 4;
constexpr size_t WS_XB = al256(WS_SS2 + (size_t)MR * 4);
constexpr size_t WS_PB = WS_XB + (size_t)MR * DM * 2;
constexpr size_t WS_Q = WS_PB + (size_t)MR * PLE * 2;
constexpr size_t WS_KS = WS_Q + (size_t)MR * 512 * 2;
constexpr size_t WS_VS = WS_KS + (size_t)MR * 128 * 2;
constexpr size_t WS_KW = WS_VS + (size_t)MR * 128 * 2;
constexpr size_t WS_VW = WS_KW + (size_t)MR * 128 * 2;
constexpr size_t WS_RQ = WS_VW + (size_t)MR * 128 * 2;
constexpr size_t WS_RK = WS_RQ + (size_t)MR * 512 * 2;
constexpr size_t WS_RV = WS_RK + (size_t)MR * 512 * 2;
constexpr size_t WS_RG = WS_RV + (size_t)MR * 512 * 2;
constexpr size_t WS_GATE = WS_RG + (size_t)MR * 512 * 2;
constexpr size_t WS_CA = al256(WS_GATE + (size_t)MR * 24 * 4);
constexpr size_t WS_KC = WS_CA, WS_VC = WS_CA + (size_t)MR * 128 * 2;
constexpr size_t WS_CP = WS_CA + (size_t)2 * CROWS * 1024 * 2;
constexpr size_t WS_CKCP = WS_CP + (size_t)2 * CROWS * 256 * 4;
constexpr size_t WS_CVCP = WS_CKCP + (size_t)NB * 128 * 128 * 2;
constexpr size_t WS_CKCS = WS_CVCP + (size_t)NB * 128 * 128 * 2;
constexpr size_t WS_CVCS = WS_CKCS + (size_t)DB * 1024 * 128 * 2;
constexpr size_t WS_KVT = WS_CVCS + (size_t)DB * 1024 * 128 * 2;
constexpr size_t WS_AO = WS_KVT + (size_t)NB * 4 * 16 * 16384 * 4;
constexpr size_t WS_H = WS_AO + (size_t)MR * DM * 2;
constexpr size_t WS_HB = WS_H + (size_t)MR * DM * 4;
constexpr size_t WS_ACT = WS_HB + (size_t)MR * DM * 2;
constexpr size_t WS_H2 = WS_ACT + (size_t)MR * DFF * 2;
constexpr size_t WS_H2B = WS_H2 + (size_t)MR * DM * 4;
constexpr size_t WS_VP = WS_H2B + (size_t)MR * DM * 2;
constexpr size_t WS_END = WS_VP + (size_t)MR * DM * 4;

constexpr int LDS_MAIN = 147456;
typedef unsigned short bf16_t;
typedef short bf16x8 __attribute__((ext_vector_type(8)));
typedef short s16x4 __attribute__((ext_vector_type(4)));
typedef float f32x4 __attribute__((ext_vector_type(4)));
typedef float f32x16 __attribute__((ext_vector_type(16)));
typedef unsigned u32x4 __attribute__((ext_vector_type(4)));
typedef unsigned u32x2 __attribute__((ext_vector_type(2)));
typedef float f32x2_t __attribute__((ext_vector_type(2)));
typedef __bf16 bf16x2_t __attribute__((ext_vector_type(2)));
#define LAS __attribute__((address_space(3)))

__device__ __forceinline__ unsigned pk2(float lo, float hi) { f32x2_t v = {lo, hi}; bf16x2_t b = __builtin_convertvector(v, bf16x2_t); return __builtin_bit_cast(unsigned, b); }
__device__ __forceinline__ float bflo(unsigned w) { return __uint_as_float(w << 16); }
__device__ __forceinline__ float bfhi(unsigned w) { return __uint_as_float(w & 0xffff0000u); }
__device__ __forceinline__ float bf1(bf16_t b) { return __uint_as_float(((unsigned)b) << 16); }
__device__ __forceinline__ float sigmoidf_(float x) { return 1.f / (1.f + __expf(-x)); }
__device__ __forceinline__ float siluf_(float x) { return x / (1.f + __expf(-x)); }
__device__ __forceinline__ int crow(int r, int hi) { return (r & 3) + 8 * (r >> 2) + 4 * hi; }
__device__ __forceinline__ float xhalf_max(float v) { auto rr = __builtin_amdgcn_permlane32_swap(__float_as_uint(v), __float_as_uint(v), false, false); return fmaxf(__uint_as_float(rr[0]), __uint_as_float(rr[1])); }
__device__ __forceinline__ float xhalf_sum(float v) { auto rr = __builtin_amdgcn_permlane32_swap(__float_as_uint(v), __float_as_uint(v), false, false); return __uint_as_float(rr[0]) + __uint_as_float(rr[1]); }

struct Params {
    const float* in[31];
    const int* page_table;
    float* out;
    unsigned char* ws;
    int ph_lo, ph_hi;
};

#define XB_TMO      128
#define XB_XCNT(j)  (256  + 64 * (j))
#define XB_XSUB(j)  (1280 + 64 * (j))
#define XB_XGEN(j)  (2304 + 64 * (j))
#define XB_TOP      3328
#define XB_TOPGEN   3392
#define XCD_BAR_WORDS 3456
#define XB_SPIN_CAP (1u << 18)
__device__ __forceinline__ unsigned xb_ld(unsigned* p)              { return __hip_atomic_load(p, __ATOMIC_RELAXED, __HIP_MEMORY_SCOPE_AGENT); }
__device__ __forceinline__ unsigned xb_add(unsigned* p, unsigned v) { return __hip_atomic_fetch_add(p, v, __ATOMIC_RELAXED, __HIP_MEMORY_SCOPE_AGENT); }
__device__ __forceinline__ unsigned xb_xcc_id() { return (unsigned)__builtin_amdgcn_s_getreg((3 << 11) | 20) & 0xFu; }
#define XB_SPIN(cond, bar) do { unsigned _sp = 0; while (cond) { __builtin_amdgcn_s_sleep(1); \
    if ((++_sp & 255u) == 0u) { if (xb_ld(&(bar)[XB_TMO])) break; if (_sp > XB_SPIN_CAP) { atomicAdd(&(bar)[XB_TMO], 1u); break; } } } } while (0)
struct XcdBarrier { unsigned* bar; unsigned x; volatile LAS unsigned* st; };
__device__ __forceinline__ XcdBarrier xcd_barrier_post(unsigned* bar, volatile LAS unsigned* st) {
    XcdBarrier b; b.bar = bar; b.x = xb_xcc_id(); b.st = st;
    if (threadIdx.x == 0) (void)xb_add(&bar[XB_XCNT(b.x)], 1u);
    return b;
}
__device__ __forceinline__ void xcd_barrier_complete(unsigned* bar, unsigned x, unsigned& nloc, unsigned& nx) {
    const unsigned G = gridDim.x * gridDim.y * gridDim.z;
    unsigned sum, cnt, mine, sp = 0u;
    for (;;) {
        sum = 0u; cnt = 0u; mine = 0u;
#pragma unroll
        for (unsigned j = 0; j < 16; ++j) { const unsigned c = xb_ld(&bar[XB_XCNT(j)]); sum += c; cnt += (c > 0u) ? 1u : 0u; mine = (j == x) ? c : mine; }
        if (sum == G) break;
        __builtin_amdgcn_s_sleep(1);
        if ((++sp & 255u) == 0u) { if (xb_ld(&bar[XB_TMO])) break; if (sp > XB_SPIN_CAP) { atomicAdd(&bar[XB_TMO], 1u); break; } }
    }
    nloc = mine > 0u ? mine : 1u; nx = cnt > 0u ? cnt : 1u;
}
__device__ __forceinline__ void xcd_barrier(const XcdBarrier& b) {
    asm volatile("s_waitcnt vmcnt(0)" ::: "memory");
    __syncthreads();
    if (threadIdx.x == 0) {
        unsigned* bar = b.bar;
        __builtin_amdgcn_s_waitcnt(0);
        unsigned nloc = b.st[0], nx = b.st[1];
        if (nloc == 0u) { xcd_barrier_complete(bar, b.x, nloc, nx); b.st[0] = nloc; b.st[1] = nx; }
        const unsigned old = xb_add(&bar[XB_XSUB(b.x)], 1u);
        const unsigned gen = old / nloc;
        if (old + 1u == (gen + 1u) * nloc) {
            __builtin_amdgcn_fence(__ATOMIC_RELEASE, "agent");
            asm volatile("s_waitcnt vmcnt(0)" ::: "memory");
            const unsigned og = xb_add(&bar[XB_TOP], 1u);
            const unsigned tg = og / nx;
            if (og + 1u == (tg + 1u) * nx) xb_add(&bar[XB_TOPGEN], 1u);
            else XB_SPIN(xb_ld(&bar[XB_TOPGEN]) == tg, bar);
            __builtin_amdgcn_fence(__ATOMIC_ACQUIRE, "agent");
            xb_add(&bar[XB_XGEN(b.x)], 1u);
            asm volatile("s_waitcnt vmcnt(0)" ::: "memory");
        } else {
            XB_SPIN(xb_ld(&bar[XB_XGEN(b.x)]) == gen, bar);
            __builtin_amdgcn_fence(__ATOMIC_ACQUIRE, "agent");
            asm volatile("s_waitcnt vmcnt(0)" ::: "memory");
        }
    }
    __syncthreads();
}

namespace pg8 {
constexpr int BM = 256, BK = 64, HALF = 128, HTB = HALF * BK * 2, STAGE_BYTES = 8 * HTB, NXCD = 8, WGM = 8;
__host__ __device__ __forceinline__ int lds_byte(int r, int c) { const int st = (r >> 4) * 2 + (c >> 5), rr = r & 15, cc = c & 31, ob = rr * 64 + cc * 2; return st * 1024 + (ob ^ (((ob >> 9) & 1) << 5)); }
__host__ __device__ __forceinline__ void stage_rc(int b, int& R, int& C) { const int st = b / 1024, sb = b % 1024, swz = sb ^ (((sb >> 9) & 1) << 5); R = (st >> 1) * 16 + swz / 64; C = (st & 1) * 32 + (swz % 64) / 2; }
__host__ __device__ __forceinline__ int perm32(int rho) { const int n = rho >> 4, i = rho & 15; return 8 * (i >> 2) + 4 * n + (i & 3); }
struct Unit { int pm, pn; };
struct Gemm { const bf16_t* A; const bf16_t* Bt; int M, N, K; };
struct StaticOrder {
    int nM, nN, nwg, G, c;
    __host__ __device__ void init(int M, int N, int G_, int c_) { nM = M / BM; nN = N / BM; nwg = nM * nN; G = G_; c = c_; }
    __host__ __device__ bool next(int i, Unit& u) const {
        const long L = (long)i * G + c; if (L >= nwg) return false;
        int wgid = (int)L; { const int q = nwg / NXCD, r = nwg % NXCD, xcd = wgid % NXCD, off = wgid / NXCD; wgid = (xcd < r ? xcd * (q + 1) : r * (q + 1) + (xcd - r) * q) + off; }
        const int nig = WGM * nN, gid = wgid / nig, fm = gid * WGM, gsz = (nM - fm) < WGM ? (nM - fm) : WGM;
        u.pm = fm + ((wgid % nig) % gsz); u.pn = (wgid % nig) / gsz; return true;
    }
    __device__ __forceinline__ void a_ready(const Unit&) const {}
    __device__ __forceinline__ void done(const Unit&) const {}
};
template <class Epi, class Sched>
__device__ __forceinline__ void gemm_phase(LAS unsigned char* lds, const Gemm g, const Sched& S, const Epi& E) {
    const int tid = threadIdx.x, wid = __builtin_amdgcn_readfirstlane(tid >> 6), lane = tid & 63, wr = wid >> 2, wc = wid & 3, fr = lane & 15, fq = lane >> 4;
    const int K = g.K, nt = K / BK;
    unsigned voffA[2], voffB[2];
#pragma unroll
    for (int i = 0; i < 2; ++i) { int R, C; stage_rc(tid * 16 + i * 8192, R, C); const int Rb = Epi::PERM ? ((R & ~31) + perm32(R & 31)) : R;
        voffA[i] = (unsigned)(R * K + C) * 2u; voffB[i] = (unsigned)(Rb * K + C) * 2u; }
    const size_t kstep = (size_t)(BK * 2);
    const size_t hstep = (size_t)HALF * K * 2;
    const size_t tstep = 2 * hstep;
    const unsigned ldsw = (unsigned)wid * 1024u;
    const int aoff = lds_byte(wr * 64 + fr, fq * 8), boff = lds_byte(wc * 32 + fr, fq * 8);
#define PG8_SA(b, h) (((b) * 2 + (h)) * HTB)
#define PG8_SB(b, h) ((4 + (b) * 2 + (h)) * HTB)
#define PG8_STAGE(bufoff, gbase, voff) do { _Pragma("unroll") for (int _i = 0; _i < 2; ++_i) \
        __builtin_amdgcn_global_load_lds((const unsigned*)((const char*)(gbase) + (voff)[_i]), (LAS unsigned*)(lds + (bufoff) + ldsw + _i * 8192), 16, 0, 0); } while (0)
#define PG8_LDA(dst, b, h) do { _Pragma("unroll") for (int m = 0; m < 4; ++m) _Pragma("unroll") for (int k = 0; k < 2; ++k) dst[m][k] = *(const LAS bf16x8*)(lds + PG8_SA(b, h) + aoff + m * 2048 + k * 1024); } while (0)
#define PG8_LDB(dst, b, h) do { _Pragma("unroll") for (int n = 0; n < 2; ++n) _Pragma("unroll") for (int k = 0; k < 2; ++k) dst[n][k] = *(const LAS bf16x8*)(lds + PG8_SB(b, h) + boff + n * 2048 + k * 1024); } while (0)
#define PG8_MMA(ai, bj, At, Bt) do { __builtin_amdgcn_s_setprio(1); _Pragma("unroll") for (int m = 0; m < 4; ++m) _Pragma("unroll") for (int n = 0; n < 2; ++n) _Pragma("unroll") for (int k = 0; k < 2; ++k) \
        acc[ai][bj][m][n] = __builtin_amdgcn_mfma_f32_16x16x32_bf16(Bt[n][k], At[m][k], acc[ai][bj][m][n], 0, 0, 0); __builtin_amdgcn_s_setprio(0); } while (0)
#define PG8_WAIT_V(n) asm volatile("s_waitcnt vmcnt(" #n ")" ::: "memory")
#define PG8_WAIT_L(n) asm volatile("s_waitcnt lgkmcnt(" #n ")" ::: "memory")
#define PG8_BAR __builtin_amdgcn_s_barrier()
#define PG8_SCHED __builtin_amdgcn_sched_barrier(0)
    Unit cur, nxt; int ui = 0;
    if (!S.next(0, cur)) return;
    f32x4 acc[2][2][4][2];
#pragma unroll
    for (int a = 0; a < 2; ++a)
#pragma unroll
        for (int b = 0; b < 2; ++b)
#pragma unroll
            for (int m = 0; m < 4; ++m)
#pragma unroll
                for (int n = 0; n < 2; ++n) acc[a][b][m][n] = (f32x4){0.f, 0.f, 0.f, 0.f};
    bf16x8 At[4][2], B0[2][2], B1[2][2];
    const char* cA = (const char*)g.A + (size_t)cur.pm * tstep; const char* cB = (const char*)g.Bt + (size_t)cur.pn * tstep;
    S.a_ready(cur);
    PG8_STAGE(PG8_SB(0, 0), cB, voffB); PG8_STAGE(PG8_SA(0, 0), cA, voffA); PG8_STAGE(PG8_SB(0, 1), cB + hstep, voffB); PG8_STAGE(PG8_SA(0, 1), cA + hstep, voffA);
    if (wr == 1) PG8_BAR;
    PG8_WAIT_V(4); PG8_BAR;
    PG8_STAGE(PG8_SB(1, 0), cB + kstep, voffB); PG8_STAGE(PG8_SA(1, 0), cA + kstep, voffA); PG8_STAGE(PG8_SB(1, 1), cB + hstep + kstep, voffB);
    PG8_WAIT_V(6); PG8_BAR;
    for (;;) {
        const bool has_next = S.next(ui + 1, nxt);
        const char* nA = has_next ? (const char*)g.A + (size_t)nxt.pm * tstep : cA; const char* nB = has_next ? (const char*)g.Bt + (size_t)nxt.pn * tstep : cB;
        for (int t = 0; t < nt; t += 2) {
            const bool last = (t == nt - 2);
            const char* a1 = cA + (size_t)(t + 1) * kstep;
            const char* a2 = last ? nA : cA + (size_t)(t + 2) * kstep; const char* b2 = last ? nB : cB + (size_t)(t + 2) * kstep;
            const char* a3 = a2 + kstep; const char* b3 = b2 + kstep;
            if (last && has_next) S.a_ready(nxt);
            PG8_LDB(B0, 0, 0); PG8_SCHED; PG8_LDA(At, 0, 0); PG8_STAGE(PG8_SA(1, 1), a1 + hstep, voffA);
            PG8_WAIT_L(8); PG8_BAR; PG8_WAIT_L(0); PG8_MMA(0, 0, At, B0); PG8_BAR; PG8_SCHED;
            PG8_LDB(B1, 0, 1); PG8_STAGE(PG8_SB(0, 0), b2, voffB);
            PG8_BAR; PG8_WAIT_L(0); PG8_MMA(0, 1, At, B1); PG8_BAR;
            PG8_LDA(At, 0, 1); PG8_STAGE(PG8_SA(0, 0), a2, voffA);
            PG8_BAR; PG8_WAIT_L(0); PG8_MMA(1, 0, At, B0); PG8_BAR; PG8_SCHED;
            PG8_STAGE(PG8_SB(0, 1), b2 + hstep, voffB);
            PG8_WAIT_V(6); PG8_BAR; PG8_MMA(1, 1, At, B1); PG8_BAR;
            PG8_LDB(B0, 1, 0); PG8_SCHED; PG8_LDA(At, 1, 0); PG8_STAGE(PG8_SA(0, 1), a2 + hstep, voffA);
            PG8_WAIT_L(8); PG8_BAR; PG8_WAIT_L(0); PG8_MMA(0, 0, At, B0); PG8_BAR; PG8_SCHED;
            PG8_LDB(B1, 1, 1); PG8_STAGE(PG8_SB(1, 0), b3, voffB);
            PG8_BAR; PG8_WAIT_L(0); PG8_MMA(0, 1, At, B1); PG8_BAR;
            PG8_LDA(At, 1, 1); PG8_STAGE(PG8_SA(1, 0), a3, voffA);
            PG8_BAR; PG8_WAIT_L(0); PG8_MMA(1, 0, At, B0); PG8_BAR; PG8_SCHED;
            PG8_STAGE(PG8_SB(1, 1), b3 + hstep, voffB);
            PG8_WAIT_V(6); PG8_BAR; PG8_MMA(1, 1, At, B1); PG8_BAR;
        }
        E(acc, cur, wr, wc, fr, fq);
        if (!has_next) break;
#pragma unroll
        for (int a = 0; a < 2; ++a)
#pragma unroll
            for (int b = 0; b < 2; ++b)
#pragma unroll
                for (int m = 0; m < 4; ++m)
#pragma unroll
                    for (int n = 0; n < 2; ++n) acc[a][b][m][n] = (f32x4){0.f, 0.f, 0.f, 0.f};
        cur = nxt; cA = nA; cB = nB; ++ui;
    }
    PG8_WAIT_V(0);
    if (wr == 0) PG8_BAR;
    PG8_BAR;
#undef PG8_SA
#undef PG8_SB
#undef PG8_STAGE
#undef PG8_LDA
#undef PG8_LDB
#undef PG8_MMA
#undef PG8_WAIT_V
#undef PG8_WAIT_L
#undef PG8_BAR
#undef PG8_SCHED
}
}

typedef f32x4 Acc[2][2][4][2];
#define EPI_ROWS(...) _Pragma("unroll") for (int ai = 0; ai < 2; ++ai) _Pragma("unroll") for (int m = 0; m < 4; ++m) { const int row = u.pm * 256 + ai * 128 + wr * 64 + m * 16 + fr; __VA_ARGS__ }
__device__ __forceinline__ u32x4 pack8(const float* v) { u32x4 w; w.x = pk2(v[0], v[1]); w.y = pk2(v[2], v[3]); w.z = pk2(v[4], v[5]); w.w = pk2(v[6], v[7]); return w; }

template <int SET> struct EpiProj {
    static constexpr bool PERM = true;
    const float* ss1; const float* qn; const float* kn; const float* rot;
    bf16_t *Q, *CA, *KS, *VS, *KW, *VW, *RQ, *RK, *RV, *RG; float* GATE; float* out;
    __device__ __forceinline__ void operator()(const Acc& acc, const pg8::Unit& u, int wr, int wc, int fr, int fq) const {
        const int pn = u.pn, c8 = 8 * fq;
        if (SET == 0 && (pn < 2 || pn == 3)) {
            const float* nw = (pn < 2) ? qn : kn; const float post = (pn < 2) ? 0.125f * LOG2E : 1.f;
            EPI_ROWS(
                const float s1 = ss1[row]; float v[2][8]; float ss = 0.f;
                _Pragma("unroll") for (int bj = 0; bj < 2; ++bj) _Pragma("unroll") for (int e = 0; e < 8; ++e) { v[bj][e] = acc[ai][bj][m][e >> 2][e & 3] * s1; ss += v[bj][e] * v[bj][e]; }
                ss += __shfl_xor(ss, 16); ss += __shfl_xor(ss, 32);
                const float rs = rsqrtf(ss * (1.f / 64.f) + EPS) * post;
                _Pragma("unroll") for (int bj = 0; bj < 2; ++bj) {
                    const int d0 = 32 * bj + c8;
                    const f32x4 w0 = *(const f32x4*)(nw + d0), w1 = *(const f32x4*)(nw + d0 + 4);
                    _Pragma("unroll") for (int e = 0; e < 4; ++e) { v[bj][e] *= rs * w0[e]; v[bj][4 + e] *= rs * w1[e]; }
                    if (pn < 2) { *(u32x4*)(Q + (size_t)row * 512 + (pn * 4 + wc) * 64 + d0) = pack8(v[bj]); }
                    else {
                        const int col = (wc & 1) * 64 + d0;
                        if (wc < 2) {
                            *(u32x4*)(KS + (size_t)row * 128 + col) = pack8(v[bj]);
                            float* o = row < MP ? out + O_PSK + (size_t)row * 128 + col : out + O_SSK + (size_t)(row - MP) * 128 + col;
                            if (row < MV) { *(f32x4*)o = (f32x4){v[bj][0], v[bj][1], v[bj][2], v[bj][3]}; *(f32x4*)(o + 4) = (f32x4){v[bj][4], v[bj][5], v[bj][6], v[bj][7]}; }
                        } else {
                            *(u32x4*)(KW + (size_t)row * 128 + col) = pack8(v[bj]);
                            float* o = nullptr; const int t = row & 2047;
                            if (row < MP) { if (t >= 1536) o = out + O_PWK + ((size_t)(row >> 11) * 512 + (t - 1536)) * 128 + col; }
                            else if (row < MV) o = out + O_SWK + ((size_t)(row - MP) * 512 + 511) * 128 + col;
                            if (o) { *(f32x4*)o = (f32x4){v[bj][0], v[bj][1], v[bj][2], v[bj][3]}; *(f32x4*)(o + 4) = (f32x4){v[bj][4], v[bj][5], v[bj][6], v[bj][7]}; }
                        }
                    }
                }
            )
        } else if (SET == 1 && (pn == 2 || pn == 4)) {
            EPI_ROWS(
                const float s1 = ss1[row];
                _Pragma("unroll") for (int bj = 0; bj < 2; ++bj) {
                    float v[8]; _Pragma("unroll") for (int e = 0; e < 8; ++e) v[e] = acc[ai][bj][m][e >> 2][e & 3] * s1;
                    const int col = 32 * wc + c8;
                    float* o = nullptr;
                    if (pn == 2) {
                        if (row < MP) { *(u32x4*)(CA + (size_t)bj * MR * 128 + (size_t)row * 128 + col) = pack8(v);
                            o = out + (bj ? O_PCV : O_PCK) + (size_t)row * 128 + col; }
                        else if (row < MV) o = out + (bj ? O_SCV : O_SCK) + (size_t)(row - MP) * 128 + col;
                    } else if (bj == 0) {
                        *(u32x4*)(VS + (size_t)row * 128 + col) = pack8(v);
                        if (row < MP) o = out + O_PSV + (size_t)row * 128 + col; else if (row < MV) o = out + O_SSV + (size_t)(row - MP) * 128 + col;
                    } else {
                        *(u32x4*)(VW + (size_t)row * 128 + col) = pack8(v);
                        const int t = row & 2047;
                        if (row < MP) { if (t >= 1536) o = out + O_PWV + ((size_t)(row >> 11) * 512 + (t - 1536)) * 128 + col; }
                        else if (row < MV) o = out + O_SWV + ((size_t)(row - MP) * 512 + 511) * 128 + col;
                    }
                    if (o) { *(f32x4*)o = (f32x4){v[0], v[1], v[2], v[3]}; *(f32x4*)(o + 4) = (f32x4){v[4], v[5], v[6], v[7]}; }
                }
            )
        } else if (SET == 0) {
            const int isk = (pn >= 7) ? 1 : 0, head = ((pn - 5) & 1) * 2 + (wc >> 1), j0 = 32 * (wc & 1) + c8;
            bf16_t* dst = isk ? RK : RQ; const float post = isk ? 0.08838834764831845f : 1.f;
            EPI_ROWS(
                const float s1 = ss1[row] * post; const int pidx = row < MP ? (row & 2047) : 2048;
                const float* rp = rot + ((size_t)pidx * 64 + j0) * 2;
                float y1[8], y2[8];
                _Pragma("unroll") for (int e2 = 0; e2 < 4; ++e2) { const f32x4 cs = *(const f32x4*)(rp + 4 * e2);
                    _Pragma("unroll") for (int t = 0; t < 2; ++t) { const int e = 2 * e2 + t; const float x1 = acc[ai][0][m][e >> 2][e & 3] * s1, x2 = acc[ai][1][m][e >> 2][e & 3] * s1, c = cs[2 * t], s = cs[2 * t + 1];
                        y1[e] = x1 * c - x2 * s; y2[e] = x1 * s + x2 * c; } }
                *(u32x4*)(dst + (size_t)row * 512 + head * 128 + j0) = pack8(y1);
                *(u32x4*)(dst + (size_t)row * 512 + head * 128 + 64 + j0) = pack8(y2);
            )
        } else if (SET == 1 && pn <= 12) {
            const int isg = pn >= 11; bf16_t* dst = isg ? RG : RV; const int cb = ((pn - 9) & 1) * 256;
            EPI_ROWS(
                const float s1 = ss1[row];
                _Pragma("unroll") for (int bj = 0; bj < 2; ++bj) { float v[8];
                    _Pragma("unroll") for (int e = 0; e < 8; ++e) { const float x = acc[ai][bj][m][e >> 2][e & 3] * s1; v[e] = isg ? siluf_(x) : x; }
                    *(u32x4*)(dst + (size_t)row * 512 + cb + 128 * bj + 32 * wc + c8) = pack8(v); }
            )
        } else if (SET == 1) {
            if (wc == 0 && fq < 3) {
                EPI_ROWS(
                    const float s1 = ss1[row]; float v[8];
                    _Pragma("unroll") for (int e = 0; e < 8; ++e) v[e] = sigmoidf_(acc[ai][0][m][e >> 2][e & 3] * s1);
                    float* o = GATE + (size_t)row * 24 + c8;
                    *(f32x4*)o = (f32x4){v[0], v[1], v[2], v[3]}; *(f32x4*)(o + 4) = (f32x4){v[4], v[5], v[6], v[7]};
                )
            }
        }
    }
};

struct SubsetOrder : pg8::StaticOrder {
    int set;
    __device__ __forceinline__ bool next(int i, pg8::Unit& u) const { if (!pg8::StaticOrder::next(i, u)) return false; const int k = u.pn;
        u.pn = set == 0 ? (k < 2 ? k : (k == 2 ? 3 : k + 2)) : (k == 0 ? 2 : (k == 1 ? 4 : k + 7)); return true; }
};
struct EpiF32 {
    static constexpr bool PERM = true;
    float* C; int ld;
    __device__ __forceinline__ void operator()(const Acc& acc, const pg8::Unit& u, int wr, int wc, int fr, int fq) const {
        EPI_ROWS(
            _Pragma("unroll") for (int bj = 0; bj < 2; ++bj) { float* o = C + (size_t)row * ld + u.pn * 256 + 128 * bj + 32 * wc + 8 * fq;
                *(f32x4*)o = acc[ai][bj][m][0]; *(f32x4*)(o + 4) = acc[ai][bj][m][1]; }
        )
    }
};
struct EpiCmp {
    static constexpr bool PERM = true;
    float* C;
    __device__ __forceinline__ void operator()(const Acc& acc, const pg8::Unit& u, int wr, int wc, int fr, int fq) const {
        EPI_ROWS(
            _Pragma("unroll") for (int bj = 0; bj < 2; ++bj) { float* o = C + (size_t)row * 256 + 128 * bj + 32 * wc + 8 * fq;
                *(f32x4*)o = acc[ai][bj][m][0]; *(f32x4*)(o + 4) = acc[ai][bj][m][1]; }
        )
    }
};
struct CmpOrder {
    int G, c;
    __device__ __forceinline__ bool next(int i, pg8::Unit& u) const { const int L = i * G + c; if (L >= 2 * (CROWS / 256)) return false; u.pm = L; u.pn = L / (CROWS / 256); return true; }
    __device__ __forceinline__ void a_ready(const pg8::Unit&) const {}
    __device__ __forceinline__ void done(const pg8::Unit&) const {}
};

struct EpiOut {
    static constexpr bool PERM = true;
    const float* xp; const float* xs; float* H; bf16_t* HB; float* SS2;
    __device__ __forceinline__ void operator()(const Acc& acc, const pg8::Unit& u, int wr, int wc, int fr, int fq) const {
        EPI_ROWS(
            float ss = 0.f;
            _Pragma("unroll") for (int bj = 0; bj < 2; ++bj) { const int col = u.pn * 256 + 128 * bj + 32 * wc + 8 * fq; float v[8];
                f32x4 x0 = (f32x4){0.f, 0.f, 0.f, 0.f}, x1 = x0;
                if (row < MV) { const float* xr = row < MP ? xp + (size_t)row * DM + col : xs + (size_t)(row - MP) * DM + col; x0 = *(const f32x4*)xr; x1 = *(const f32x4*)(xr + 4); }
                _Pragma("unroll") for (int e = 0; e < 4; ++e) { v[e] = acc[ai][bj][m][0][e] + x0[e]; v[4 + e] = acc[ai][bj][m][1][e] + x1[e]; }
                _Pragma("unroll") for (int e = 0; e < 8; ++e) ss += v[e] * v[e];
                float* o = H + (size_t)row * DM + col; *(f32x4*)o = (f32x4){v[0], v[1], v[2], v[3]}; *(f32x4*)(o + 4) = (f32x4){v[4], v[5], v[6], v[7]};
                *(u32x4*)(HB + (size_t)row * DM + col) = pack8(v); }
            ss += __shfl_xor(ss, 16); ss += __shfl_xor(ss, 32);
            if (fq == 0 && row < MV) atomicAdd(SS2 + row, ss);
        )
    }
};
struct EpiGU {
    static constexpr bool PERM = true;
    const float* SS2; bf16_t* ACT;
    __device__ __forceinline__ void operator()(const Acc& acc, const pg8::Unit& u, int wr, int wc, int fr, int fq) const {
        EPI_ROWS(
            const float s2 = rsqrtf(SS2[row] * (1.f / 1024.f) + EPS); float v[8];
            _Pragma("unroll") for (int e = 0; e < 8; ++e) { const float gt = acc[ai][0][m][e >> 2][e & 3] * s2, up = acc[ai][1][m][e >> 2][e & 3] * s2; v[e] = siluf_(gt) * up; }
            *(u32x4*)(ACT + (size_t)row * DFF + u.pn * 128 + 32 * wc + 8 * fq) = pack8(v);
        )
    }
};
struct EpiDown {
    static constexpr bool PERM = true;
    const float* H; float* H2; bf16_t* H2B;
    __device__ __forceinline__ void operator()(const Acc& acc, const pg8::Unit& u, int wr, int wc, int fr, int fq) const {
        EPI_ROWS(
            _Pragma("unroll") for (int bj = 0; bj < 2; ++bj) { const size_t off = (size_t)row * DM + u.pn * 256 + 128 * bj + 32 * wc + 8 * fq; float v[8];
                const f32x4 h0 = *(const f32x4*)(H + off), h1 = *(const f32x4*)(H + off + 4);
                _Pragma("unroll") for (int e = 0; e < 4; ++e) { v[e] = acc[ai][bj][m][0][e] + h0[e]; v[4 + e] = acc[ai][bj][m][1][e] + h1[e]; }
                *(f32x4*)(H2 + off) = (f32x4){v[0], v[1], v[2], v[3]}; *(f32x4*)(H2 + off + 4) = (f32x4){v[4], v[5], v[6], v[7]};
                *(u32x4*)(H2B + off) = pack8(v); }
        )
    }
};
struct EpiFinal {
    static constexpr bool PERM = true;
    const float* H2; const float* VP; float* out;
    __device__ __forceinline__ void operator()(const Acc& acc, const pg8::Unit& u, int wr, int wc, int fr, int fq) const {
        EPI_ROWS(
            if (row < MV) {
                _Pragma("unroll") for (int bj = 0; bj < 2; ++bj) { const int col = u.pn * 256 + 128 * bj + 32 * wc + 8 * fq; const size_t off = (size_t)row * DM + col; float v[8];
                    const f32x4 h0 = *(const f32x4*)(H2 + off), h1 = *(const f32x4*)(H2 + off + 4), p0 = *(const f32x4*)(VP + off), p1 = *(const f32x4*)(VP + off + 4);
                    _Pragma("unroll") for (int e = 0; e < 4; ++e) { v[e] = h0[e] + sigmoidf_(acc[ai][bj][m][0][e]) * p0[e]; v[4 + e] = h1[e] + sigmoidf_(acc[ai][bj][m][1][e]) * p1[e]; }
                    float* o = row < MP ? out + O_YP + off : out + O_YS + (size_t)(row - MP) * DM + col;
                    *(f32x4*)o = (f32x4){v[0], v[1], v[2], v[3]}; *(f32x4*)(o + 4) = (f32x4){v[4], v[5], v[6], v[7]}; }
            }
        )
    }
};

__device__ __forceinline__ int rel_bucket(int dist) {
    const int n = dist < 0 ? 0 : dist;
    if (n < 16) return n;
    const int large = 16 + (int)(logf((float)n / 16.f) / 2.0794415416798357f * 16.f);
    return large < 31 ? large : 31;
}
struct WSrc { const float* src; int ld, vt; const float* ks; };
__device__ __forceinline__ WSrc wsrc(const Params& p, int wid, int n0) {
    WSrc w; w.vt = 32; w.ks = nullptr;
    if (wid == 0) {
        const int tile = n0 >> 8, c = n0 & 255, bj = c >> 7, wc = (c >> 5) & 3; int col;
        if (tile < 2) col = (tile * 4 + wc) * 64 + 32 * bj;
        else if (tile == 2) col = 512 + c;
        else if (tile == 3) col = (wc < 2 ? 768 : 1024) + (wc & 1) * 64 + 32 * bj;
        else if (tile == 4) col = (bj ? 1152 : 896) + (c & 127);
        else if (tile <= 8) col = (tile >= 7 ? 1816 : 1304) + ((((tile - 5) & 1) * 2 + (wc >> 1)) * 128) + 64 * bj + 32 * (wc & 1);
        else if (tile <= 10) col = 2328 + (tile - 9) * 256 + c;
        else if (tile <= 12) col = 2840 + (tile - 11) * 256 + c;
        else { col = 1280; w.vt = (c == 0) ? 24 : 0; }
        w.src = p.in[13] + col; w.ld = INC; w.ks = p.in[12];
    } else if (wid == 1) { w.src = p.in[23] + n0; w.ld = DM; }
    else if (wid == 2) { const int pn = n0 >> 8, bj = (n0 >> 7) & 1, c7 = n0 & 127; w.src = (bj ? p.in[26] : p.in[25]) + pn * 128 + c7; w.ld = DFF; w.ks = p.in[24]; }
    else if (wid == 3) { w.src = p.in[27] + n0; w.ld = DM; }
    else if (wid == 4) { w.src = p.in[28] + n0; w.ld = DM; }
    else if (wid == 5) { w.src = p.in[29] + n0; w.ld = DM; }
    else if (wid == 6 || wid == 7) { const int j = n0 >> 7, h0 = n0 & 127; w.src = p.in[wid == 6 ? 17 : 20] + (size_t)j * 1024 * 128 + h0; w.ld = 128; }
    else { w.src = p.in[wid == 8 ? 18 : 21] + n0; w.ld = 64; }
    return w;
}
__device__ __forceinline__ void phase_prologue(const Params& p, unsigned char* lds) {
    const int tid = threadIdx.x, lane = tid & 63, wid = tid >> 6, G = gridDim.x, bid = blockIdx.x;
    unsigned char* ws = p.ws;
    {
        const int tn[10] = {112, 32, 176, 32, 32, 32, 8, 8, 2, 2}, tk[10] = {16, 16, 16, 44, 16, 4, 16, 16, 2, 2};
        const size_t dsto[10] = {WS_W1, WS_WO, WS_WGU, WS_WD, WS_WPG, WS_WPP, WS_W1C, WS_W1C + (size_t)256 * 1024 * 2, WS_W2C, WS_W2C + (size_t)64 * 128 * 2};
        int total = 0;
#pragma unroll
        for (int i = 0; i < 10; ++i) total += tn[i] * tk[i];
        float* tl = (float*)lds;
        int total4 = 0;
#pragma unroll
        for (int i = 0; i < 10; ++i) total4 += ((tn[i] + 3) / 4) * tk[i];
        for (int t = bid; t < total4; t += G) {
            int wsel = 0, rem = t;
#pragma unroll
            for (int i = 0; i < 9; ++i) { const int cnt = ((tn[i] + 3) / 4) * tk[i]; if (wsel == i && rem >= cnt) { rem -= cnt; wsel = i + 1; } }
            int tkk = 16, tnn = 4; size_t doff = 0;
#pragma unroll
            for (int i = 0; i < 10; ++i) if (wsel == i) { tkk = tk[i]; tnn = tn[i]; doff = dsto[i]; }
            const int K = tkk * 64;
            const int n0 = (rem / tkk) * 128, k0 = (rem % tkk) * 64;
            const int nch = (tnn - n0 / 32) < 4 ? (tnn - n0 / 32) : 4;
            float v[4][4];
#pragma unroll
            for (int ch = 0; ch < 4; ++ch) { if (ch < nch) { const WSrc w = wsrc(p, wsel, n0 + 32 * ch);
#pragma unroll
                for (int it = 0; it < 4; ++it) { const int kk = it * 16 + (tid >> 5), tt = tid & 31; float x = 0.f;
                    if (tt < w.vt) { x = w.src[(size_t)(k0 + kk) * w.ld + tt]; if (w.ks) x *= w.ks[k0 + kk]; }
                    v[ch][it] = x; } } }
#pragma unroll
            for (int ch = 0; ch < 4; ++ch) if (ch < nch) {
#pragma unroll
                for (int it = 0; it < 4; ++it) tl[ch * 2112 + (it * 16 + (tid >> 5)) * 33 + (tid & 31)] = v[ch][it]; }
            __syncthreads();
#pragma unroll
            for (int ch = 0; ch < 4; ++ch) if (ch < nch) { const int nt = tid >> 4, kq = (tid & 15) * 4; const float* tc = tl + ch * 2112;
              u32x2 o; o.x = pk2(tc[(kq + 0) * 33 + nt], tc[(kq + 1) * 33 + nt]); o.y = pk2(tc[(kq + 2) * 33 + nt], tc[(kq + 3) * 33 + nt]);
              *(u32x2*)((bf16_t*)(ws + doff) + (size_t)(n0 + 32 * ch + nt) * K + k0 + kq) = o; }
            __syncthreads();
        }
    }
    {
        bf16_t* XB = (bf16_t*)(ws + WS_XB); float* SS1 = (float*)(ws + WS_SS1); bf16_t* PB = (bf16_t*)(ws + WS_PB);
        for (int row = bid * 8 + wid; row < MR; row += G * 8) {
            const float* xr = row < MP ? p.in[0] + (size_t)row * DM : p.in[1] + (size_t)(row - MP) * DM;
            const float* pr = row < MP ? p.in[10] + (size_t)row * PLE : p.in[11] + (size_t)(row - MP) * PLE;
            f32x4 v[4]; float ss = 0.f;
#pragma unroll
            for (int i = 0; i < 4; ++i) { v[i] = row < MV ? *(const f32x4*)(xr + i * 256 + lane * 4) : (f32x4){0.f, 0.f, 0.f, 0.f}; ss += v[i][0] * v[i][0] + v[i][1] * v[i][1] + v[i][2] * v[i][2] + v[i][3] * v[i][3]; }
#pragma unroll
            for (int o = 1; o < 64; o <<= 1) ss += __shfl_xor(ss, o);
#pragma unroll
            for (int i = 0; i < 4; ++i) { u32x2 o; o.x = pk2(v[i][0], v[i][1]); o.y = pk2(v[i][2], v[i][3]); *(u32x2*)(XB + (size_t)row * DM + i * 256 + lane * 4) = o; }
            if (lane == 0) SS1[row] = rsqrtf(ss * (1.f / 1024.f) + EPS);
            const f32x4 pv = row < MV ? *(const f32x4*)(pr + lane * 4) : (f32x4){0.f, 0.f, 0.f, 0.f};
            u32x2 o; o.x = pk2(pv[0], pv[1]); o.y = pk2(pv[2], pv[3]); *(u32x2*)(PB + (size_t)row * PLE + lane * 4) = o;
        }
    }
    const int gtid = bid * 512 + tid, gsz = G * 512;
    {
        float* rot = (float*)(ws + WS_ROT);
        for (int idx = gtid; idx < 2049 * 64; idx += gsz) { const int pidx = idx >> 6, j = idx & 63; const float pos = pidx < 2048 ? (float)pidx : 16384.f;
            const float inv = powf(10000.f, -(float)j / 64.f); const float ang = pos * inv; const double a = (double)ang;
            rot[(size_t)idx * 2] = (float)cos(a); rot[(size_t)idx * 2 + 1] = (float)sin(a); }
        float* btab = (float*)(ws + WS_BTAB);
        for (int idx = gtid; idx < 8 * 128; idx += gsz) { const int head = idx >> 7, dist = idx & 127; btab[idx] = p.in[30][rel_bucket(dist) * 8 + head] * LOG2E; }
        float* SS2 = (float*)(ws + WS_SS2);
        for (int idx = gtid; idx < MR; idx += gsz) SS2[idx] = 0.f;
        float* bc = (float*)(ws + WS_BIASC);
        for (int it = bid; it < 32; it += G) if (tid < 256) { const int c = tid >> 7, h = tid & 127; const float* pe = p.in[c ? 19 : 16]; const float* w1 = p.in[c ? 20 : 17]; float a = 0.f;
#pragma unroll 8
            for (int k = it * 64; k < it * 64 + 64; ++k) a += pe[k] * w1[(size_t)k * 128 + h];
            atomicAdd(bc + tid, a); }
    }
    {
        const int total = 2 * DB * 511 * 32;
        for (int idx = gtid; idx < total; idx += gsz) { const int c4 = (idx & 31) * 4; int r = idx >> 5; const int j = r % 511; r /= 511; const int b = r & 31, c = r >> 5;
            const f32x4 v = *(const f32x4*)(p.in[6 + c] + ((size_t)b * 512 + j + 1) * 128 + c4);
            *(f32x4*)(p.out + (c ? O_SWV : O_SWK) + ((size_t)b * 512 + j) * 128 + c4) = v; }
    }
}

__device__ __forceinline__ s16x4 tr16(const unsigned char* p) { typedef short v4i16_t __attribute__((ext_vector_type(4))); return __builtin_bit_cast(s16x4, __builtin_amdgcn_ds_read_tr16_b64_v4i16((LAS v4i16_t*)p)); }
__device__ __forceinline__ bf16x8 cat8(s16x4 lo, s16x4 hi) { return (bf16x8){lo[0], lo[1], lo[2], lo[3], hi[0], hi[1], hi[2], hi[3]}; }
constexpr int RSTR = 272;
__device__ __forceinline__ float ret_lgam(int h) { return log2f(1.f - exp2f(-5.f - (float)h)); }
__device__ __forceinline__ bf16x8 tr_frag(const unsigned char* tile, int row0, int cb, int lane) {
    const int hi = lane >> 5;
    const unsigned char* a = tile + (size_t)(row0 + 4 * hi + ((lane & 15) >> 2)) * RSTR + (cb * 32 + 16 * ((lane >> 4) & 1) + 4 * (lane & 3)) * 2;
    return cat8(tr16(a), tr16(a + 8 * RSTR));
}
__device__ __forceinline__ void stage128(unsigned char* dst, const bf16_t* src, int tid, bool decay, float lg) {
    const int r = tid >> 2, q4 = tid & 3;
    float sc = decay ? exp2f((float)(127 - r) * lg) : 1.f;
#pragma unroll
    for (int i = 0; i < 4; ++i) { const int col = q4 * 32 + i * 8; u32x4 v = *(const u32x4*)(src + (size_t)r * 512 + col);
        if (decay) { v.x = pk2(bflo(v.x) * sc, bfhi(v.x) * sc); v.y = pk2(bflo(v.y) * sc, bfhi(v.y) * sc); v.z = pk2(bflo(v.z) * sc, bfhi(v.z) * sc); v.w = pk2(bflo(v.w) * sc, bfhi(v.w) * sc); }
        *(u32x4*)(dst + (size_t)r * RSTR + col * 2) = v; }
}
__device__ __forceinline__ void ret_r1_unit(const Params& p, unsigned char* lds, int b, int h, int c) {
    const int tid = threadIdx.x, lane = tid & 63, w = __builtin_amdgcn_readfirstlane(tid >> 6), r32 = lane & 31, hi = lane >> 5;
    const size_t row0 = (size_t)b * SEQ + c * 128;
    const float lg = ret_lgam(h);
    unsigned char* Kt = lds; unsigned char* Vt = lds + 128 * RSTR;
    stage128(Kt, (const bf16_t*)(p.ws + WS_RK) + row0 * 512 + h * 128, tid, true, lg);
    stage128(Vt, (const bf16_t*)(p.ws + WS_RV) + row0 * 512 + h * 128, tid, false, 0.f);
    __syncthreads();
    const int eb = w & 3, dp = w >> 2;
    f32x16 acc[2]; acc[0] = f32x16{}; acc[1] = f32x16{};
#pragma unroll
    for (int s = 0; s < 8; ++s) {
        const bf16x8 vf = tr_frag(Vt, 16 * s, eb, lane);
#pragma unroll
        for (int di = 0; di < 2; ++di) { const bf16x8 kf = tr_frag(Kt, 16 * s, 2 * dp + di, lane); acc[di] = __builtin_amdgcn_mfma_f32_32x32x16_bf16(vf, kf, acc[di], 0, 0, 0); }
    }
    float* KVT = (float*)(p.ws + WS_KVT) + ((size_t)((b * 4 + h) * 16 + c)) * 16384;
#pragma unroll
    for (int di = 0; di < 2; ++di)
#pragma unroll
        for (int r = 0; r < 16; ++r) KVT[(size_t)(32 * eb + crow(r, hi)) * 128 + 32 * (2 * dp + di) + r32] = acc[di][r];
    __syncthreads();
}
__device__ __forceinline__ void ret_r2_unit(const Params& p, unsigned char* lds, int b, int h, int c) {
    const int tid = threadIdx.x, lane = tid & 63, w = __builtin_amdgcn_readfirstlane(tid >> 6), r32 = lane & 31, hi = lane >> 5;
    const size_t row0 = (size_t)b * SEQ + c * 128;
    const float lg = ret_lgam(h);
    unsigned char* Qt = lds; unsigned char* Kt = lds + 128 * RSTR; unsigned char* Vt = lds + 2 * 128 * RSTR; float* st = (float*)(lds + 3 * 128 * RSTR);
    stage128(Qt, (const bf16_t*)(p.ws + WS_RQ) + row0 * 512 + h * 128, tid, false, 0.f);
    stage128(Kt, (const bf16_t*)(p.ws + WS_RK) + row0 * 512 + h * 128, tid, false, 0.f);
    stage128(Vt, (const bf16_t*)(p.ws + WS_RV) + row0 * 512 + h * 128, tid, false, 0.f);
    __syncthreads();
    const int eb = w & 3, ps = w >> 2;
    bf16x8 sf[8];
    if (c > 0) {
        const float* KV0 = (const float*)(p.ws + WS_KVT) + ((size_t)((b * 4 + h) * 16)) * 16384 + (size_t)(32 * eb + r32) * 128 + 8 * hi;
#pragma unroll
        for (int s = 0; s < 8; ++s) {
            float a[8];
#pragma unroll
            for (int e = 0; e < 8; ++e) a[e] = 0.f;
            for (int j = 0; j < c; ++j) { const float wj = exp2f(128.f * (float)(c - 1 - j) * lg); const float* src = KV0 + (size_t)j * 16384 + 16 * s;
                const f32x4 x0 = *(const f32x4*)src, x1 = *(const f32x4*)(src + 4);
#pragma unroll
                for (int e = 0; e < 4; ++e) { a[e] += wj * x0[e]; a[4 + e] += wj * x1[e]; } }
            const u32x4 pk = pack8(a); sf[s] = __builtin_bit_cast(bf16x8, pk);
        }
    }
    f32x16 accs[2];
#pragma unroll
    for (int ni = 0; ni < 2; ++ni) {
        const int nb = ps ? (1 + ni) : (ni ? 3 : 0);
        const int n = 32 * nb + r32;
        bf16x8 qf[8];
#pragma unroll
        for (int s = 0; s < 8; ++s) qf[s] = *(const bf16x8*)(Qt + (size_t)n * RSTR + (16 * s + 8 * hi) * 2);
        f32x16 acc = f32x16{};
        if (c > 0) {
#pragma unroll
            for (int s = 0; s < 8; ++s) acc = __builtin_amdgcn_mfma_f32_32x32x16_bf16(sf[s], qf[s], acc, 0, 0, 0);
            const float dn = exp2f((float)(n + 1) * lg);
#pragma unroll
            for (int r = 0; r < 16; ++r) acc[r] *= dn;
        }
        for (int mb = 0; mb <= nb; ++mb) {
            f32x16 x = f32x16{};
#pragma unroll
            for (int s = 0; s < 8; ++s) { const bf16x8 kf = *(const bf16x8*)(Kt + (size_t)(32 * mb + r32) * RSTR + (16 * s + 8 * hi) * 2); x = __builtin_amdgcn_mfma_f32_32x32x16_bf16(kf, qf[s], x, 0, 0, 0); }
            float pv[16];
#pragma unroll
            for (int r = 0; r < 16; ++r) { const int dm = n - (32 * mb + crow(r, hi)); pv[r] = dm >= 0 ? x[r] * exp2f((float)dm * lg) : 0.f; }
#pragma unroll
            for (int s2 = 0; s2 < 2; ++s2) { const u32x4 pk = pack8(pv + 8 * s2); const bf16x8 vf = tr_frag(Vt, 32 * mb + 16 * s2, eb, lane);
                acc = __builtin_amdgcn_mfma_f32_32x32x16_bf16(vf, __builtin_bit_cast(bf16x8, pk), acc, 0, 0, 0); }
        }
        float s1 = 0.f, s2 = 0.f;
#pragma unroll
        for (int r = 0; r < 16; ++r) { s1 += acc[r]; s2 += acc[r] * acc[r]; }
        s1 = xhalf_sum(s1); s2 = xhalf_sum(s2);
        if (hi == 0) { st[(eb * 128 + n) * 2] = s1; st[(eb * 128 + n) * 2 + 1] = s2; }
        accs[ni] = acc;
    }
    __syncthreads();
    const float* gn = p.in[22] + h * 128; const bf16_t* RG = (const bf16_t*)(p.ws + WS_RG); bf16_t* AO = (bf16_t*)(p.ws + WS_AO);
#pragma unroll
    for (int ni = 0; ni < 2; ++ni) {
        const int nb = ps ? (1 + ni) : (ni ? 3 : 0); const int n = 32 * nb + r32;
        float s1 = 0.f, s2 = 0.f;
#pragma unroll
        for (int q = 0; q < 4; ++q) { s1 += st[(q * 128 + n) * 2]; s2 += st[(q * 128 + n) * 2 + 1]; }
        const float mu = s1 * (1.f / 128.f), var = s2 * (1.f / 128.f) - mu * mu, rs = rsqrtf(var + EPS);
        const size_t row = row0 + n;
#pragma unroll
        for (int a = 0; a < 4; ++a) { const int e0 = 32 * eb + 8 * a + 4 * hi;
            const f32x4 gw = *(const f32x4*)(gn + e0); const u32x2 gg = *(const u32x2*)(RG + row * 512 + h * 128 + e0);
            const float g0 = bflo(gg.x), g1 = bfhi(gg.x), g2 = bflo(gg.y), g3 = bfhi(gg.y);
            u32x2 o; o.x = pk2((accs[ni][4 * a] - mu) * rs * gw[0] * g0, (accs[ni][4 * a + 1] - mu) * rs * gw[1] * g1);
            o.y = pk2((accs[ni][4 * a + 2] - mu) * rs * gw[2] * g2, (accs[ni][4 * a + 3] - mu) * rs * gw[3] * g3);
            *(u32x2*)(AO + row * 1024 + 512 + h * 128 + e0) = o; }
    }
    __syncthreads();
}
__device__ __forceinline__ void ret_sample_unit(const Params& p, unsigned char* lds, int b, int h) {
    const int tid = threadIdx.x;
    float* qv = (float*)lds; float* kv = qv + 128; float* vv = kv + 128; float* part = vv + 128; float* red = part + 512;
    const size_t row = (size_t)MP + b;
    if (tid < 384) { const int which = tid >> 7, d = tid & 127; const bf16_t* src = (const bf16_t*)(p.ws + (which == 0 ? WS_RQ : which == 1 ? WS_RK : WS_RV)) + row * 512 + h * 128 + d; qv[tid] = bf1(*src); }
    __syncthreads();
    const float gam = 1.f - exp2f(-5.f - (float)h);
    const int dq = tid >> 7, e = tid & 127;
    const float* st = p.in[8] + ((size_t)(b * 4 + h)) * 16384; float* so = p.out + O_SRET + ((size_t)(b * 4 + h)) * 16384;
    float acc = 0.f, qk = 0.f; const float ve = vv[e];
#pragma unroll 4
    for (int i = 0; i < 32; ++i) { const int d = dq + 4 * i; const float s = st[d * 128 + e]; acc += qv[d] * s; so[d * 128 + e] = gam * s + kv[d] * ve; }
#pragma unroll 4
    for (int d = 0; d < 128; ++d) qk += qv[d] * kv[d];
    part[dq * 128 + e] = acc;
    __syncthreads();
    float o = 0.f;
    if (tid < 128) { o = qk * ve + gam * (part[e] + part[128 + e] + part[256 + e] + part[384 + e]); }
    float s1 = tid < 128 ? o : 0.f, s2 = tid < 128 ? o * o : 0.f;
#pragma unroll
    for (int of = 1; of < 64; of <<= 1) { s1 += __shfl_xor(s1, of); s2 += __shfl_xor(s2, of); }
    if ((tid & 63) == 0 && tid < 128) { red[(tid >> 6) * 2] = s1; red[(tid >> 6) * 2 + 1] = s2; }
    __syncthreads();
    if (tid < 128) { const float t1 = red[0] + red[2], t2 = red[1] + red[3]; const float mu = t1 * (1.f / 128.f), var = t2 * (1.f / 128.f) - mu * mu, rs = rsqrtf(var + EPS);
        const float g = bf1(((const bf16_t*)(p.ws + WS_RG))[row * 512 + h * 128 + e]);
        const unsigned pk = pk2((o - mu) * rs * p.in[22][h * 128 + e] * g, 0.f);
        ((bf16_t*)(p.ws + WS_AO))[row * 1024 + 512 + h * 128 + e] = (bf16_t)(pk & 0xffffu); }
    __syncthreads();
}

__device__ __forceinline__ void compress2_task(const Params& p, int c, int task, int lane) {
    const int r32 = lane & 31, hi = lane >> 5;
    const int R = task * 32 + r32;
    const float* P0 = (const float*)(p.ws + WS_CP) + ((size_t)c * CROWS + R) * 256;
    const int R2 = (R + 2 < CROWS) ? R + 2 : CROWS - 1;
    const float* P1 = (const float*)(p.ws + WS_CP) + ((size_t)c * CROWS + R2) * 256 + 128;
    const float* bc = (const float*)(p.ws + WS_BIASC) + c * 128;
    const bf16_t* W2 = (const bf16_t*)(p.ws + WS_W2C) + (size_t)c * 64 * 128;
    f32x16 acc[2]; acc[0] = f32x16{}; acc[1] = f32x16{};
#pragma unroll
    for (int s = 0; s < 8; ++s) {
        const int k0 = 16 * s + 8 * hi; float hv[8];
#pragma unroll
        for (int q = 0; q < 2; ++q) { const f32x4 a = *(const f32x4*)(P0 + k0 + 4 * q), b = *(const f32x4*)(P1 + k0 + 4 * q), bb = *(const f32x4*)(bc + k0 + 4 * q);
#pragma unroll
            for (int e = 0; e < 4; ++e) hv[4 * q + e] = siluf_(a[e] + b[e] + bb[e]); }
        const u32x4 pk = pack8(hv); const bf16x8 hf = __builtin_bit_cast(bf16x8, pk);
#pragma unroll
        for (int eb = 0; eb < 2; ++eb) { const bf16x8 wf = *(const bf16x8*)(W2 + (size_t)(32 * eb + r32) * 128 + k0); acc[eb] = __builtin_amdgcn_mfma_f32_32x32x16_bf16(wf, hf, acc[eb], 0, 0, 0); }
    }
    float rs = 1.f;
    if (c == 0) { float ss = 0.f;
#pragma unroll
        for (int eb = 0; eb < 2; ++eb)
#pragma unroll
            for (int r = 0; r < 16; ++r) ss += acc[eb][r] * acc[eb][r];
        ss = xhalf_sum(ss); rs = rsqrtf(ss * (1.f / 64.f) + EPS); }
    bool valid; bf16_t* dst;
    if (R < CROWS_S) { valid = ((R >> 1) & 1023) < NC_S; dst = (bf16_t*)(p.ws + (c ? WS_CVCS : WS_CKCS)) + (size_t)R * 64; }
    else { const int Rp = R - CROWS_S; valid = ((Rp >> 1) & 127) < NC_P; dst = (bf16_t*)(p.ws + (c ? WS_CVCP : WS_CKCP)) + (size_t)Rp * 64; }
    if (valid) {
#pragma unroll
        for (int eb = 0; eb < 2; ++eb)
#pragma unroll
            for (int a = 0; a < 4; ++a) { const int e0 = 32 * eb + 8 * a + 4 * hi; float v[4];
#pragma unroll
                for (int e = 0; e < 4; ++e) { v[e] = acc[eb][4 * a + e] * rs; if (c == 0) v[e] *= p.in[15][e0 + e]; }
                u32x2 o; o.x = pk2(v[0], v[1]); o.y = pk2(v[2], v[3]); *(u32x2*)(dst + e0) = o; }
    }
}
__device__ __forceinline__ void pret_job(const Params& p) {
    const int gtid = blockIdx.x * 512 + threadIdx.x, gsz = gridDim.x * 512;
    for (int idx = gtid; idx < NB * 4 * 16384; idx += gsz) { const int d = idx & 127, e = (idx >> 7) & 127, bh = idx >> 14; const float lg = ret_lgam(bh & 3);
        const float* src = (const float*)(p.ws + WS_KVT) + (size_t)bh * 16 * 16384 + e * 128 + d; float a = 0.f;
#pragma unroll
        for (int j = 0; j < 16; ++j) a += exp2f(128.f * (float)(15 - j) * lg) * src[(size_t)j * 16384];
        p.out[O_PRET + (size_t)bh * 16384 + d * 128 + e] = a; }
}

constexpr int AT_K = 0, AT_V = 16384, AT_IMP = 32768, AT_IMPS = AT_IMP + 64 * 129 * 4, AT_MASK = AT_IMPS + 64 * 33 * 4, AT_BTAB = AT_MASK + 256, AT_END = AT_BTAB + 2048;
struct KVregs { u32x4 k, v; };
__device__ __forceinline__ KVregs kv_load(const bf16_t* Kg, const bf16_t* Vg, size_t rowbase, int rmax, int ld, int colg, int tid) {
    KVregs r; { int key = tid & 63; if (key > rmax) key = rmax; r.k = *(const u32x4*)(Kg + (rowbase + key) * ld + colg + (tid >> 6) * 8); }
    { int row = (tid >> 2) & 63; if (row > rmax) row = rmax; r.v = *(const u32x4*)(Vg + (rowbase + row) * ld + colg + (tid >> 8) * 32 + (tid & 3) * 8); }
    return r;
}
__device__ __forceinline__ void kv_store(unsigned char* Kb, unsigned char* Vb, const KVregs& r, int tid) {
    *(u32x4*)(Kb + (tid >> 6) * 1024 + (tid & 63) * 16) = r.k;
    *(u32x4*)(Vb + (tid >> 8) * 4096 + ((tid >> 2) & 63) * 64 + (tid & 3) * 16) = r.v;
}
__device__ __forceinline__ f32x16 qk_sub(const unsigned char* Kb, const bf16x8* qr, int sub, int r32, int hi) {
    f32x16 s = f32x16{};
#pragma unroll
    for (int d0 = 0; d0 < 4; ++d0) { const bf16x8 kf = *(const bf16x8*)(Kb + d0 * 2048 + hi * 1024 + (sub * 32 + r32) * 16); s = __builtin_amdgcn_mfma_f32_32x32x16_bf16(kf, qr[d0], s, 0, 0, 0); }
    return s;
}
__device__ __forceinline__ void pv_sub(f32x16* o, const unsigned char* Vb, const float* pv, int sub, int lane) {
    const int hi = lane >> 5;
    const unsigned char* vb = Vb + ((lane >> 4) & 1) * 32 + (lane & 3) * 8 + (4 * hi + ((lane & 15) >> 2)) * 64;
#pragma unroll
    for (int s2 = 0; s2 < 2; ++s2) { const u32x4 pk = pack8(pv + 8 * s2); const bf16x8 pf = __builtin_bit_cast(bf16x8, pk);
#pragma unroll
        for (int eb = 0; eb < 2; ++eb) { const unsigned char* a = vb + eb * 4096 + (2 * sub + s2) * 1024; const bf16x8 vf = cat8(tr16(a), tr16(a + 512));
            o[eb] = __builtin_amdgcn_mfma_f32_32x32x16_bf16(vf, pf, o[eb], 0, 0, 0); } }
}
__device__ __forceinline__ void attn_tile(const unsigned char* Kb, const unsigned char* Vb, const bf16x8* qr, const float* bt, int kp0, int qpos, bool isw, bool sel, float& m, float& l, f32x16* o, int lane) {
    const int r32 = lane & 31, hi = lane >> 5;
#pragma unroll 1
    for (int sub = 0; sub < 2; ++sub) {
        const int dist0 = qpos - kp0 - 32 * sub - 4 * hi;
        unsigned vm = 0;
#pragma unroll
        for (int r = 0; r < 16; ++r) { const int dist = dist0 - ((r & 3) + 8 * (r >> 2)); const bool ok = isw ? (dist >= 0 && dist < 512) : (sel && dist >= 0); vm |= ok ? (1u << r) : 0u; }
        if (__ballot(vm != 0) == 0ull) continue;
        f32x16 s = qk_sub(Kb, qr, sub, r32, hi);
        float mx = -1e30f;
#pragma unroll
        for (int r = 0; r < 16; ++r) { const int dist = dist0 - ((r & 3) + 8 * (r >> 2)); const int di = dist < 0 ? 0 : (dist > 127 ? 127 : dist);
            const float bv = bt[di]; const float sv = ((vm >> r) & 1u) ? s[r] + bv : -1e30f; s[r] = sv; mx = fmaxf(mx, sv); }
        mx = xhalf_max(mx);
        const float mn = fmaxf(m, mx), alpha = exp2f(m - mn);
        float pv[16]; float ps = 0.f;
#pragma unroll
        for (int r = 0; r < 16; ++r) { const float e = exp2f(s[r] - mn); pv[r] = ((vm >> r) & 1u) ? e : 0.f; ps += pv[r]; }
        l = l * alpha + ps; m = mn;
#pragma unroll
        for (int r = 0; r < 16; ++r) { o[0][r] *= alpha; o[1][r] *= alpha; }
        pv_sub(o, Vb, pv, sub, lane);
    }
}
__device__ __forceinline__ void attn_prompt_unit(const Params& p, unsigned char* lds, int b, int g, int i) {
    const int tid = threadIdx.x, lane = tid & 63, w = __builtin_amdgcn_readfirstlane(tid >> 6), r32 = lane & 31, hi = lane >> 5;
    const int hr = w >> 1, ql = (w & 1) * 32 + r32, qpos = 64 * i + ql, head = g * 4 + hr;
    const size_t row = (size_t)b * SEQ + qpos;
    float* imp = (float*)(lds + AT_IMP); float* imps = (float*)(lds + AT_IMPS); unsigned* mask = (unsigned*)(lds + AT_MASK); float* btab = (float*)(lds + AT_BTAB);
    const bf16_t* Qg = (const bf16_t*)(p.ws + WS_Q);
    for (int x = tid; x < 64 * 129; x += 512) imp[x] = 0.f;
    if (tid < 64) mask[tid] = (i < 16) ? 0xFFFFFFFFu : ((1u << 0) | (1u << i) | (1u << (i - 1)));
    btab[tid] = ((const float*)(p.ws + WS_BTAB))[(g * 4) * 128 + tid];
    bf16x8 qr[4];
#pragma unroll
    for (int d0 = 0; d0 < 4; ++d0) qr[d0] = *(const bf16x8*)(Qg + row * 512 + head * 64 + d0 * 16 + hi * 8);
    const float* gp = (const float*)(p.ws + WS_GATE) + row * 24 + head;
    const float g0 = gp[0], g1 = gp[8], g2 = gp[16];
    const float* bt = btab + hr * 128;
    f32x16 ot[2]; ot[0] = f32x16{}; ot[1] = f32x16{};
    unsigned char* Kb0 = lds + AT_K; unsigned char* Vb0 = lds + AT_V;
    {
        const bf16_t* CK = (const bf16_t*)(p.ws + WS_CKCP); const bf16_t* CV = (const bf16_t*)(p.ws + WS_CVCP);
#pragma unroll
        for (int t = 0; t < 2; ++t) { const KVregs kv = kv_load(CK, CV, (size_t)b * 128 + 64 * t, t ? 62 : 63, 128, g * 64, tid); kv_store(Kb0 + t * 8192, Vb0 + t * 8192, kv, tid); }
        __syncthreads();
        auto cmp_scores = [&](int t4) -> f32x16 {
            f32x16 sv = qk_sub(Kb0 + (t4 >> 1) * 8192, qr, t4 & 1, r32, hi);
#pragma unroll
            for (int r = 0; r < 16; ++r) { const int c = 32 * t4 + crow(r, hi); const int dist = qpos - (16 * c + 31); const int di = dist < 0 ? 0 : (dist > 127 ? 127 : dist);
                const float bv = bt[di]; sv[r] = (dist >= 0 && c < NC_P) ? sv[r] + bv : -1e30f; }
            return sv; };
        float mx = -1e30f;
#pragma unroll 1
        for (int t4 = 0; t4 < 4; ++t4) { const f32x16 sv = cmp_scores(t4);
#pragma unroll
            for (int r = 0; r < 16; ++r) mx = fmaxf(mx, sv[r]); }
        mx = xhalf_max(mx);
        float ps = 0.f;
#pragma unroll 1
        for (int t4 = 0; t4 < 4; ++t4) { const f32x16 sv = cmp_scores(t4);
#pragma unroll
            for (int r = 0; r < 16; ++r) ps += sv[r] > -1e29f ? exp2f(sv[r] - mx) : 0.f; }
        ps = xhalf_sum(ps);
        const float inv = ps > 0.f ? 1.f / ps : 0.f;
#pragma unroll 1
        for (int t4 = 0; t4 < 4; ++t4) { const f32x16 sv = cmp_scores(t4);
            float pv[16];
#pragma unroll
            for (int r = 0; r < 16; ++r) { const float pn = sv[r] > -1e29f ? exp2f(sv[r] - mx) * inv : 0.f; if (i >= 16 && pn > 0.f) atomicAdd(&imp[ql * 129 + 32 * t4 + crow(r, hi)], pn); pv[r] = pn * g0; }
            pv_sub(ot, Vb0 + (t4 >> 1) * 8192, pv, t4 & 1, lane);
        }
    }
    __syncthreads();
    if (i >= 16) {
        const int q = tid >> 3, jj = tid & 7, jmax = i - 2;
        for (int j = 1 + jj; j <= jmax; j += 8) { const float* ip = imp + q * 129 + 4 * j;
            imps[q * 33 + j] = 0.5f * ip[-1] + ip[0] + ip[1] + ip[2] + 0.5f * ip[3]; }
        __syncthreads();
        for (int j = 1 + jj; j <= jmax; j += 8) { const float vj = imps[q * 33 + j]; int cnt = 0;
            for (int k = 1; k <= jmax; ++k) { const float vk = imps[q * 33 + k]; cnt += (vk > vj || (vk == vj && k < j)) ? 1 : 0; }
            if (cnt < 13) atomicOr(&mask[q], 1u << j); }
        __syncthreads();
    }
    const unsigned selm = mask[ql];
    {
        const bf16_t* KSg = (const bf16_t*)(p.ws + WS_KS); const bf16_t* VSg = (const bf16_t*)(p.ws + WS_VS);
        const bf16_t* KWg = (const bf16_t*)(p.ws + WS_KW); const bf16_t* VWg = (const bf16_t*)(p.ws + WS_VW);
        const int nts = i + 1, t0w = i > 8 ? i - 8 : 0, NT = nts + (i - t0w + 1);
        float m = -1e30f, l = 0.f; f32x16 o[2]; o[0] = f32x16{}; o[1] = f32x16{};
        { const KVregs kv = kv_load(KSg, VSg, (size_t)b * SEQ, 63, 128, g * 64, tid); kv_store(Kb0, Vb0, kv, tid); }
#pragma unroll 1
        for (int t = 0; t < NT; ++t) {
            __syncthreads();
            KVregs nx; const bool more = t + 1 < NT;
            if (more) { const int tn = t + 1; const bool wn = tn >= nts; const int jn = wn ? t0w + tn - nts : tn;
                nx = kv_load(wn ? KWg : KSg, wn ? VWg : VSg, (size_t)b * SEQ + 64 * jn, 63, 128, g * 64, tid); }
            const bool isw = t >= nts; const int j = isw ? t0w + t - nts : t;
            if (t == nts) { l = xhalf_sum(l); const float sc = l > 0.f ? g1 / l : 0.f;
#pragma unroll
                for (int r = 0; r < 16; ++r) { ot[0][r] += sc * o[0][r]; ot[1][r] += sc * o[1][r]; o[0][r] = 0.f; o[1][r] = 0.f; }
                m = -1e30f; l = 0.f; }
            attn_tile(Kb0 + (t & 1) * 8192, Vb0 + (t & 1) * 8192, qr, bt, 64 * j, qpos, isw, (selm >> (j & 31)) & 1u, m, l, o, lane);
            if (more) kv_store(Kb0 + ((t + 1) & 1) * 8192, Vb0 + ((t + 1) & 1) * 8192, nx, tid);
        }
        l = xhalf_sum(l); const float sc = l > 0.f ? g2 / l : 0.f;
#pragma unroll
        for (int r = 0; r < 16; ++r) { ot[0][r] += sc * o[0][r]; ot[1][r] += sc * o[1][r]; }
    }
    bf16_t* AO = (bf16_t*)(p.ws + WS_AO) + row * 1024 + head * 64;
#pragma unroll
    for (int eb = 0; eb < 2; ++eb)
#pragma unroll
        for (int a = 0; a < 4; ++a) { u32x2 ov; ov.x = pk2(ot[eb][4 * a], ot[eb][4 * a + 1]); ov.y = pk2(ot[eb][4 * a + 2], ot[eb][4 * a + 3]); *(u32x2*)(AO + 32 * eb + 8 * a + 4 * hi) = ov; }
    __syncthreads();
}

constexpr int SA_Q = 0, SA_SC = 256, SA_IMP = SA_SC + 4096, SA_IMPS = SA_IMP + 1024, SA_SEL = SA_IMPS + 256, SA_ML = SA_SEL + 16, SA_OB = SA_ML + 8, SA_OT = SA_OB + 512, SA_PART = SA_OT + 256, SA_END = SA_PART + 64 * 256;
__device__ __forceinline__ void dot4_f32(const float* key, const float* q, float* a) {
#pragma unroll 2
    for (int d = 0; d < 64; d += 4) { const f32x4 kv = *(const f32x4*)(key + d);
#pragma unroll
        for (int r = 0; r < 4; ++r) { const f32x4 qv = *(const f32x4*)(q + r * 64 + d); a[r] += kv[0] * qv[0] + kv[1] * qv[1] + kv[2] * qv[2] + kv[3] * qv[3]; } }
}
__device__ __forceinline__ void dot4_bf16(const bf16_t* key, const float* q, float* a) {
#pragma unroll 2
    for (int d = 0; d < 64; d += 8) { const u32x4 kw = *(const u32x4*)(key + d); const float kf[8] = {bflo(kw.x), bfhi(kw.x), bflo(kw.y), bfhi(kw.y), bflo(kw.z), bfhi(kw.z), bflo(kw.w), bfhi(kw.w)};
#pragma unroll
        for (int r = 0; r < 4; ++r) { const f32x4 q0 = *(const f32x4*)(q + r * 64 + d), q1 = *(const f32x4*)(q + r * 64 + d + 4);
            a[r] += kf[0] * q0[0] + kf[1] * q0[1] + kf[2] * q0[2] + kf[3] * q0[3] + kf[4] * q1[0] + kf[5] * q1[1] + kf[6] * q1[2] + kf[7] * q1[3]; } }
}
struct Slot { const float* kf; const float* vf; const bf16_t* kb; const bf16_t* vb; int dist; bool valid; };
template <int BR>
__device__ __forceinline__ Slot sa_slot(const Params& p, int b, int g, int slot, const int* sel, const int* selb) {
    Slot s; s.kf = nullptr; s.vf = nullptr; s.kb = nullptr; s.vb = nullptr; s.valid = true; s.dist = 0;
    const size_t row = (size_t)MP + b;
    if (BR == 0) { const size_t off = ((size_t)(b * 1024 + slot) * 2 + g) * 64; s.kb = (const bf16_t*)(p.ws + WS_CKCS) + off; s.vb = (const bf16_t*)(p.ws + WS_CVCS) + off; s.dist = PAST - (16 * slot + 31); }
    else if (BR == 1) { const int blk = sel[slot >> 6], kk = slot & 63, pos = 64 * blk + kk;
        if (blk == 256) { s.valid = (kk == 0); s.kb = (const bf16_t*)(p.ws + WS_KS) + row * 128 + g * 64; s.vb = (const bf16_t*)(p.ws + WS_VS) + row * 128 + g * 64; s.dist = 0; }
        else { const size_t off = (size_t)selb[slot >> 6] + (size_t)kk * 128; s.kf = p.in[4] + off; s.vf = p.in[5] + off; s.dist = PAST - pos; } }
    else { const int j = slot + 1;
        if (j == 512) { s.kb = (const bf16_t*)(p.ws + WS_KW) + row * 128 + g * 64; s.vb = (const bf16_t*)(p.ws + WS_VW) + row * 128 + g * 64; s.dist = 0; }
        else { const size_t off = (((size_t)b * 512 + j) * 2 + g) * 64; s.kf = p.in[6] + off; s.vf = p.in[7] + off; s.dist = 512 - j; } }
    return s;
}
template <int BR>
__device__ __forceinline__ void sa_branch(const Params& p, float* L, int b, int g, int nslots, const float* btg, const float* gates  ) {
    const int tid = threadIdx.x, lane = tid & 63, w = tid >> 6;
    float* q = L + SA_Q; float* sc = L + SA_SC; float* ml = L + SA_ML; float* ob = L + SA_OB; float* ot = L + SA_OT; const int* sel = (const int*)(L + SA_SEL);
    for (int slot = tid; slot < nslots; slot += 512) {
        const Slot s = sa_slot<BR>(p, b, g, slot, sel, (const int*)(L + SA_IMPS)); float a[4] = {0.f, 0.f, 0.f, 0.f};
        if (s.valid) { if (s.kf) dot4_f32(s.kf, q, a); else dot4_bf16(s.kb, q, a); }
        const int di = s.dist > 127 ? 127 : s.dist;
#pragma unroll
        for (int r = 0; r < 4; ++r) sc[r * 1024 + slot] = s.valid ? a[r] + btg[r * 128 + di] : -1e30f;
    }
    __syncthreads();
    if (w < 4) { float mx = -1e30f;
        for (int s = lane; s < nslots; s += 64) mx = fmaxf(mx, sc[w * 1024 + s]);
#pragma unroll
        for (int of = 1; of < 64; of <<= 1) mx = fmaxf(mx, __shfl_xor(mx, of));
        float sum = 0.f;
        for (int s = lane; s < nslots; s += 64) { const float v = sc[w * 1024 + s]; const float e = v > -1e29f ? exp2f(v - mx) : 0.f; sc[w * 1024 + s] = e; sum += e; }
#pragma unroll
        for (int of = 1; of < 64; of <<= 1) sum += __shfl_xor(sum, of);
        const float inv = sum > 0.f ? 1.f / sum : 0.f;
        for (int s = lane; s < nslots; s += 64) sc[w * 1024 + s] *= inv;
    }
    __syncthreads();
    { const int sl = tid >> 3, e0 = (tid & 7) * 8; float acc[4][8];
#pragma unroll
      for (int r = 0; r < 4; ++r)
#pragma unroll
          for (int e = 0; e < 8; ++e) acc[r][e] = 0.f;
      const size_t row = (size_t)MP + b;
      const int* selb = (const int*)(L + SA_IMPS);
#pragma unroll 4
      for (int slot = sl; slot < nslots; slot += 64) {
          float pr[4];
#pragma unroll
          for (int r = 0; r < 4; ++r) pr[r] = sc[r * 1024 + slot];
          const float* vf = nullptr; const bf16_t* vb = nullptr;
          if (BR == 0) vb = (const bf16_t*)(p.ws + WS_CVCS) + ((size_t)(b * 1024 + slot) * 2 + g) * 64;
          else if (BR == 1) { const int si = slot >> 6, kk = slot & 63; if (sel[si] == 256) vb = (const bf16_t*)(p.ws + WS_VS) + row * 128 + g * 64; else vf = p.in[5] + (size_t)selb[si] + (size_t)kk * 128; }
          else { if (slot == 511) vb = (const bf16_t*)(p.ws + WS_VW) + row * 128 + g * 64; else vf = p.in[7] + (((size_t)b * 512 + slot + 1) * 2 + g) * 64; }
          float vv[8];
          if (vf) { const f32x4 a0 = *(const f32x4*)(vf + e0), a1 = *(const f32x4*)(vf + e0 + 4); vv[0] = a0[0]; vv[1] = a0[1]; vv[2] = a0[2]; vv[3] = a0[3]; vv[4] = a1[0]; vv[5] = a1[1]; vv[6] = a1[2]; vv[7] = a1[3]; }
          else { const u32x4 w = *(const u32x4*)(vb + e0); vv[0] = bflo(w.x); vv[1] = bfhi(w.x); vv[2] = bflo(w.y); vv[3] = bfhi(w.y); vv[4] = bflo(w.z); vv[5] = bfhi(w.z); vv[6] = bflo(w.w); vv[7] = bfhi(w.w); }
#pragma unroll
          for (int r = 0; r < 4; ++r)
#pragma unroll
              for (int e = 0; e < 8; ++e) acc[r][e] += pr[r] * vv[e];
      }
      float* part = L + SA_PART;
#pragma unroll
      for (int r = 0; r < 4; ++r) { *(f32x4*)(part + sl * 256 + r * 64 + e0) = (f32x4){acc[r][0], acc[r][1], acc[r][2], acc[r][3]}; *(f32x4*)(part + sl * 256 + r * 64 + e0 + 4) = (f32x4){acc[r][4], acc[r][5], acc[r][6], acc[r][7]}; }
    }
    __syncthreads();
    if (tid < 256) { float a = 0.f; const float* part = L + SA_PART;
#pragma unroll 8
        for (int q = 0; q < 64; ++q) a += part[q * 256 + tid];
        ob[tid] = a; ob[256 + tid] = 0.f; }
    if (tid < 256) { const int r = tid >> 6; ot[tid] += gates[r] * (ob[tid] + ob[256 + tid]); }
    __syncthreads();
    (void)ml;
}
__device__ __forceinline__ void attn_sample_unit(const Params& p, unsigned char* lds, int b, int g) {
    const int tid = threadIdx.x;
    float* L = (float*)lds; float* q = L + SA_Q; float* sc = L + SA_SC; float* imp = L + SA_IMP; float* imps = L + SA_IMPS; int* sel = (int*)(L + SA_SEL); float* ot = L + SA_OT; float* gsh = L + SA_ML;
    const size_t row = (size_t)MP + b;
    if (tid < 256) { q[tid] = bf1(((const bf16_t*)(p.ws + WS_Q))[row * 512 + g * 256 + tid]); ot[tid] = 0.f; }
    __syncthreads();
    const float* btg = (const float*)(p.ws + WS_BTAB) + (g * 4) * 128;
    const float* GT = (const float*)(p.ws + WS_GATE) + row * 24 + g * 4;
    sa_branch<0>(p, L, b, g, NC_S, btg, GT);
    for (int c = tid; c < NC_S; c += 512) imp[c] = sc[c] + sc[1024 + c] + sc[2048 + c] + sc[3072 + c];
    __syncthreads();
    if (tid >= 1 && tid <= 254) { const int j = tid; imps[j] = 0.5f * imp[4 * j - 1] + imp[4 * j] + imp[4 * j + 1] + imp[4 * j + 2] + 0.5f * imp[4 * j + 3]; }
    if (tid == 0) { sel[0] = 0; sel[1] = 255; sel[2] = 256; }
    __syncthreads();
    if (tid >= 1 && tid <= 254) { const float vj = imps[tid]; int cnt = 0;
        for (int k = 1; k <= 254; ++k) { const float vk = imps[k]; cnt += (vk > vj || (vk == vj && k < tid)) ? 1 : 0; }
        if (cnt < 13) sel[3 + cnt] = tid; }
    __syncthreads();
    if (tid < 16) { const int blk = sel[tid]; int off = 0;
        if (blk < 256) { const int page = p.page_table[b * NPAGES + (blk >> 1)]; off = ((page * PAGE + (blk & 1) * 64) * 2 + g) * 64; }
        ((int*)imps)[tid] = off; }
    __syncthreads();
    sa_branch<1>(p, L, b, g, 1024, btg, GT + 8);
    sa_branch<2>(p, L, b, g, 512, btg, GT + 16);
    if (tid < 256) { const unsigned pk = pk2(ot[tid], 0.f); ((bf16_t*)(p.ws + WS_AO))[row * 1024 + g * 256 + tid] = (bf16_t)(pk & 0xffffu); }
    __syncthreads();
    (void)gsh;
}

__device__ __forceinline__ void st4bf_(bf16_t* dst, const float* v) { u32x2 o; o.x = pk2(v[0], v[1]); o.y = pk2(v[2], v[3]); *(u32x2*)dst = o; }
constexpr int CF_ASTR = 272, CF_WSTR = 144, CF_ASZ = 35328, CF_WSZ = 36864, CF_A = 0, CF_W = 2 * CF_ASZ, CF_PG = CF_W + 2 * CF_WSZ, CF_BIAS = CF_PG + 128, CF_END = CF_BIAS + 512;
static_assert(CF_END <= LDS_MAIN, "fused compress LDS map");
struct CfRegs { f32x4 a[8]; f32x4 ah; u32x4 w[4]; };
template <bool SRC_BF16>
__device__ __forceinline__ void cf_load(CfRegs& R, const Params& p, const unsigned char* lds, int c, int b, int i0, int s, int tmax, int tid) {
    const int* pg = (const int*)(lds + CF_PG);
#pragma unroll
    for (int q = 0; q < 9; ++q) {
        if (q == 8 && tid >= 32) break;
        const int idx = q * 512 + tid, ii = q == 8 ? 128 : (idx >> 5), c4 = (q == 8 ? tid : (idx & 31)) * 4;
        int t = 16 * (i0 + ii) + s; if (t > tmax) t = tmax;
        f32x4 v;
        if (SRC_BF16) { const u32x2 x = *(const u32x2*)((const bf16_t*)(p.ws + (c ? WS_VC : WS_KC)) + ((size_t)b * SEQ + t) * 128 + c4); v[0] = __uint_as_float(x.x); v[1] = __uint_as_float(x.y); v[2] = 0.f; v[3] = 0.f; }
        else { const int lp = (t >> 7) - (i0 >> 3); v = *(const f32x4*)(p.in[2 + c] + ((size_t)pg[lp] * PAGE + (t & 127)) * 128 + c4); }
        if (q == 8) R.ah = v; else R.a[q] = v;
    }
    const bf16_t* W = (const bf16_t*)(p.ws + WS_W1C) + (size_t)c * 256 * 1024;
#pragma unroll
    for (int q = 0; q < 4; ++q) { const int idx = q * 512 + tid, rw = idx >> 3, ch = idx & 7; R.w[q] = *(const u32x4*)(W + (size_t)rw * 1024 + s * 64 + ch * 8); }
}
template <bool SRC_BF16>
__device__ __forceinline__ void cf_store(const CfRegs& R, unsigned char* Ab, unsigned char* Wb, int tid) {
#pragma unroll
    for (int q = 0; q < 9; ++q) {
        if (q == 8 && tid >= 32) break;
        const int idx = q * 512 + tid, ii = q == 8 ? 128 : (idx >> 5), c4 = (q == 8 ? tid : (idx & 31)) * 4;
        const f32x4 v = q == 8 ? R.ah : R.a[q]; u32x2 o;
        if (SRC_BF16) { o.x = __float_as_uint(v[0]); o.y = __float_as_uint(v[1]); } else { o.x = pk2(v[0], v[1]); o.y = pk2(v[2], v[3]); }
        *(u32x2*)(Ab + ii * CF_ASTR + c4 * 2) = o;
    }
#pragma unroll
    for (int q = 0; q < 4; ++q) { const int idx = q * 512 + tid, rw = idx >> 3, ch = idx & 7; *(u32x4*)(Wb + rw * CF_WSTR + ch * 16) = R.w[q]; }
}
template <bool SRC_BF16>
__device__ __forceinline__ void compress_fused_unit(const Params& p, unsigned char* lds, int c, int b, int i0, int nseg, int nc, bf16_t* dstbase) {
    const int tid = threadIdx.x, lane = tid & 63, w = __builtin_amdgcn_readfirstlane(tid >> 6), r32 = lane & 31, hi = lane >> 5;
    const int g = w & 1, iblk = w >> 1;
    const int tmax = 16 * nseg - 1;
    if (tid < 17) { int pi = (i0 >> 3) + tid; if (pi > NPAGES - 1) pi = NPAGES - 1; ((int*)(lds + CF_PG))[tid] = SRC_BF16 ? 0 : p.page_table[b * NPAGES + pi]; }
    if (tid >= 64 && tid < 192) ((float*)(lds + CF_BIAS))[tid - 64] = ((const float*)(p.ws + WS_BIASC))[c * 128 + tid - 64];
    __syncthreads();
    CfRegs R;
    cf_load<SRC_BF16>(R, p, lds, c, b, i0, 0, tmax, tid);
    cf_store<SRC_BF16>(R, lds + CF_A, lds + CF_W, tid);
    f32x16 acc[4];
#pragma unroll
    for (int hb = 0; hb < 4; ++hb) acc[hb] = f32x16{};
#pragma unroll 1
    for (int s = 0; s < 16; ++s) {
        __syncthreads();
        if (s + 1 < 16) cf_load<SRC_BF16>(R, p, lds, c, b, i0, s + 1, tmax, tid);
        const unsigned char* Ab = lds + CF_A + (s & 1) * CF_ASZ; const unsigned char* Wb = lds + CF_W + (s & 1) * CF_WSZ;
#pragma unroll 1
        for (int j = 0; j < 2; ++j)
#pragma unroll 2
            for (int ks = 0; ks < 4; ++ks) {
                const bf16x8 tf = *(const bf16x8*)(Ab + (32 * iblk + r32 + j) * CF_ASTR + (g * 64 + 16 * ks + 8 * hi) * 2);
#pragma unroll
                for (int hb = 0; hb < 4; ++hb) { const bf16x8 wf = *(const bf16x8*)(Wb + (j * 128 + 32 * hb + r32) * CF_WSTR + (16 * ks + 8 * hi) * 2);
                    acc[hb] = __builtin_amdgcn_mfma_f32_32x32x16_bf16(wf, tf, acc[hb], 0, 0, 0); }
            }
        if (s + 1 < 16) cf_store<SRC_BF16>(R, lds + CF_A + ((s + 1) & 1) * CF_ASZ, lds + CF_W + ((s + 1) & 1) * CF_WSZ, tid);
    }
    const float* bias = (const float*)(lds + CF_BIAS);
    const bf16_t* W2 = (const bf16_t*)(p.ws + WS_W2C) + (size_t)c * 64 * 128;
    f32x16 o2[2]; o2[0] = f32x16{}; o2[1] = f32x16{};
#pragma unroll
    for (int hb = 0; hb < 4; ++hb) {
        float sv[16];
#pragma unroll
        for (int r = 0; r < 16; ++r) sv[r] = siluf_(acc[hb][r] + bias[32 * hb + crow(r, hi)]);
#pragma unroll
        for (int s2 = 0; s2 < 2; ++s2) { const u32x4 pk = pack8(sv + 8 * s2); const bf16x8 sf = __builtin_bit_cast(bf16x8, pk);
#pragma unroll
            for (int eb = 0; eb < 2; ++eb) { const bf16_t* wp = W2 + (size_t)(32 * eb + r32) * 128 + 32 * hb + 16 * s2 + 4 * hi;
                const u32x2 lo = *(const u32x2*)wp, hh = *(const u32x2*)(wp + 8); const u32x4 wq = {lo.x, lo.y, hh.x, hh.y};
                o2[eb] = __builtin_amdgcn_mfma_f32_32x32x16_bf16(__builtin_bit_cast(bf16x8, wq), sf, o2[eb], 0, 0, 0); } }
    }
    float rs = 1.f;
    if (c == 0) { float ss = 0.f;
#pragma unroll
        for (int eb = 0; eb < 2; ++eb)
#pragma unroll
            for (int r = 0; r < 16; ++r) ss += o2[eb][r] * o2[eb][r];
        ss = xhalf_sum(ss); rs = rsqrtf(ss * (1.f / 64.f) + EPS); }
    const int i = i0 + 32 * iblk + r32;
    if (i < nc) { bf16_t* dst = dstbase + ((size_t)(b * nseg + i) * 2 + g) * 64;
#pragma unroll
        for (int eb = 0; eb < 2; ++eb)
#pragma unroll
            for (int a = 0; a < 4; ++a) { const int e0 = 32 * eb + 8 * a + 4 * hi; float v[4];
#pragma unroll
                for (int e = 0; e < 4; ++e) { v[e] = o2[eb][4 * a + e] * rs; if (c == 0) v[e] *= p.in[15][e0 + e]; }
                st4bf_(dst + e0, v); } }
    __syncthreads();
}

__device__ __forceinline__ void skinny_tile(const bf16_t* X, int lda, const bf16_t* Wt, int K, int rowA, int rowB, float* red, float* T) {
    const int tid = threadIdx.x, lane = tid & 63, w = __builtin_amdgcn_readfirstlane(tid >> 6), r32 = lane & 31, hi = lane >> 5;
    const int kw = K >> 3;
    f32x16 acc0 = f32x16{}, acc1 = f32x16{};
    const bf16_t* xp = X + (size_t)r32 * lda + w * kw + 8 * hi;
    const bf16_t* wa = Wt + (size_t)(rowA + r32) * K + w * kw + 8 * hi;
    const bf16_t* wb = Wt + (size_t)(rowB + r32) * K + w * kw + 8 * hi;
#pragma unroll 4
    for (int k = 0; k < kw; k += 16) { const bf16x8 xf = *(const bf16x8*)(xp + k), fa = *(const bf16x8*)(wa + k), fb = *(const bf16x8*)(wb + k);
        acc0 = __builtin_amdgcn_mfma_f32_32x32x16_bf16(fa, xf, acc0, 0, 0, 0); acc1 = __builtin_amdgcn_mfma_f32_32x32x16_bf16(fb, xf, acc1, 0, 0, 0); }
#pragma unroll
    for (int r = 0; r < 16; ++r) { red[((w * 2 + 0) * 16 + r) * 64 + lane] = acc0[r]; red[((w * 2 + 1) * 16 + r) * 64 + lane] = acc1[r]; }
    __syncthreads();
#pragma unroll
    for (int q = 0; q < 4; ++q) { const int idx = tid + 512 * q, l2 = idx & 63, br = idx >> 6, blk = br >> 4, r = br & 15; float a = 0.f;
#pragma unroll
        for (int ww = 0; ww < 8; ++ww) a += red[((ww * 2 + blk) * 16 + r) * 64 + l2];
        T[(l2 & 31) * 65 + 32 * blk + crow(r, l2 >> 5)] = a; }
    __syncthreads();
}
__device__ __forceinline__ float grp16_sum(float v) { v += __shfl_xor(v, 1); v += __shfl_xor(v, 2); v += __shfl_xor(v, 4); v += __shfl_xor(v, 8); return v; }
__device__ __forceinline__ void st4bf(bf16_t* dst, const float* v) { st4bf_(dst, v); }
__device__ __forceinline__ void st4f(float* dst, const float* v) { *(f32x4*)dst = (f32x4){v[0], v[1], v[2], v[3]}; }
template <int WHICH> __device__ __forceinline__ void skinny_phase(const Params& p, unsigned char* lds) {
    const int tid = threadIdx.x, bid = blockIdx.x, G = gridDim.x;
    unsigned char* ws = p.ws;
    float* red = (float*)lds; float* T = (float*)(lds + 65536);
    const int row = tid >> 4, c4 = (tid & 15) * 4, bj = c4 >> 5, tt = c4 & 31; const size_t grow = (size_t)MP + row;
    const bf16_t* X; const bf16_t* Wt; int lda, K, nitems;
    if (WHICH == 1) { X = (const bf16_t*)(ws + WS_XB); lda = DM; Wt = (const bf16_t*)(ws + WS_W1); K = DM; nitems = 53; }
    else if (WHICH == 5) { X = (const bf16_t*)(ws + WS_AO); lda = DM; Wt = (const bf16_t*)(ws + WS_WO); K = DM; nitems = 16; }
    else if (WHICH == 6) { X = (const bf16_t*)(ws + WS_HB); lda = DM; Wt = (const bf16_t*)(ws + WS_WGU); K = DM; nitems = 88; }
    else if (WHICH == 7) { X = (const bf16_t*)(ws + WS_ACT); lda = DFF; Wt = (const bf16_t*)(ws + WS_WD); K = DFF; nitems = 16; }
    else if (WHICH == 9) { X = (const bf16_t*)(ws + WS_PB); lda = PLE; Wt = (const bf16_t*)(ws + WS_WPP); K = PLE; nitems = 16; }
    else { X = (const bf16_t*)(ws + WS_H2B); lda = DM; Wt = (const bf16_t*)(ws + WS_WPG); K = DM; nitems = 16; }
    X += (size_t)MP * lda;
    for (int it = bid; it < nitems; it += G) {
        const int pn = it >> 2, wc = it & 3;
        skinny_tile(X, lda, Wt, K, pn * 256 + wc * 32, pn * 256 + 128 + wc * 32, red, T);
        float x[4];
#pragma unroll
        for (int e = 0; e < 4; ++e) x[e] = T[row * 65 + c4 + e];
        if (WHICH == 1) {
            const float s1 = ((const float*)(ws + WS_SS1))[grow];
            if (pn < 2 || pn == 3) {
                float v[4], ss = 0.f;
#pragma unroll
                for (int e = 0; e < 4; ++e) { v[e] = x[e] * s1; ss += v[e] * v[e]; }
                ss = grp16_sum(ss);
                const float* nw = (pn < 2) ? p.in[14] : p.in[15]; const float rs = rsqrtf(ss * (1.f / 64.f) + EPS) * ((pn < 2) ? 0.125f * LOG2E : 1.f);
                const int d0 = 32 * bj + tt;
#pragma unroll
                for (int e = 0; e < 4; ++e) v[e] *= rs * nw[d0 + e];
                if (pn < 2) st4bf((bf16_t*)(ws + WS_Q) + grow * 512 + (pn * 4 + wc) * 64 + d0, v);
                else { const int col = (wc & 1) * 64 + d0;
                    if (wc < 2) { st4bf((bf16_t*)(ws + WS_KS) + grow * 128 + col, v); st4f(p.out + O_SSK + (size_t)row * 128 + col, v); }
                    else { st4bf((bf16_t*)(ws + WS_KW) + grow * 128 + col, v); st4f(p.out + O_SWK + ((size_t)row * 512 + 511) * 128 + col, v); } }
            } else if (pn == 2 || pn == 4) {
                float v[4];
#pragma unroll
                for (int e = 0; e < 4; ++e) v[e] = x[e] * s1;
                const int col = 32 * wc + tt;
                if (pn == 2) st4f(p.out + (bj ? O_SCV : O_SCK) + (size_t)row * 128 + col, v);
                else if (bj == 0) { st4bf((bf16_t*)(ws + WS_VS) + grow * 128 + col, v); st4f(p.out + O_SSV + (size_t)row * 128 + col, v); }
                else { st4bf((bf16_t*)(ws + WS_VW) + grow * 128 + col, v); st4f(p.out + O_SWV + ((size_t)row * 512 + 511) * 128 + col, v); }
            } else if (pn <= 8) {
                const int isk = (pn >= 7) ? 1 : 0, head = ((pn - 5) & 1) * 2 + (wc >> 1), j0 = 32 * (wc & 1) + tt;
                const float sc = s1 * (isk ? 0.08838834764831845f : 1.f);
                const float* rp = (const float*)(ws + WS_ROT) + ((size_t)2048 * 64 + j0) * 2;
                float v[4];
#pragma unroll
                for (int e = 0; e < 4; ++e) { const float x1 = T[row * 65 + tt + e] * sc, x2 = T[row * 65 + 32 + tt + e] * sc, c = rp[2 * e], sn = rp[2 * e + 1];
                    v[e] = bj ? (x1 * sn + x2 * c) : (x1 * c - x2 * sn); }
                st4bf((bf16_t*)(ws + (isk ? WS_RK : WS_RQ)) + grow * 512 + head * 128 + 64 * bj + j0, v);
            } else if (pn <= 12) {
                const int isg = pn >= 11; float v[4];
#pragma unroll
                for (int e = 0; e < 4; ++e) { const float y = x[e] * s1; v[e] = isg ? siluf_(y) : y; }
                st4bf((bf16_t*)(ws + (isg ? WS_RG : WS_RV)) + grow * 512 + ((pn - 9) & 1) * 256 + 128 * bj + 32 * wc + tt, v);
            } else {
                if (bj == 0 && tt < 24) { float v[4];
#pragma unroll
                    for (int e = 0; e < 4; ++e) v[e] = sigmoidf_(x[e] * s1);
                    st4f((float*)(ws + WS_GATE) + grow * 24 + tt, v); }
            }
        } else {
            const int col = pn * 256 + 128 * bj + 32 * wc + tt; const size_t off = grow * DM + col;
            if (WHICH == 5) { float v[4], ss = 0.f; const f32x4 xs = *(const f32x4*)(p.in[1] + (size_t)row * DM + col);
#pragma unroll
                for (int e = 0; e < 4; ++e) { v[e] = x[e] + xs[e]; ss += v[e] * v[e]; }
                st4f((float*)(ws + WS_H) + off, v); st4bf((bf16_t*)(ws + WS_HB) + off, v);
                ss = grp16_sum(ss); if ((tid & 15) == 0) atomicAdd((float*)(ws + WS_SS2) + grow, ss);
            } else if (WHICH == 6) {
                if (bj == 0) { const float s2 = rsqrtf(((const float*)(ws + WS_SS2))[grow] * (1.f / 1024.f) + EPS); float v[4];
#pragma unroll
                    for (int e = 0; e < 4; ++e) v[e] = siluf_(x[e] * s2) * (T[row * 65 + 32 + tt + e] * s2);
                    st4bf((bf16_t*)(ws + WS_ACT) + grow * DFF + pn * 128 + 32 * wc + tt, v); }
            } else if (WHICH == 7) { float v[4]; const f32x4 h = *(const f32x4*)((const float*)(ws + WS_H) + off);
#pragma unroll
                for (int e = 0; e < 4; ++e) v[e] = x[e] + h[e];
                st4f((float*)(ws + WS_H2) + off, v); st4bf((bf16_t*)(ws + WS_H2B) + off, v);
            } else if (WHICH == 9) { st4f((float*)(ws + WS_VP) + off, x);
            } else { float v[4]; const f32x4 h = *(const f32x4*)((const float*)(ws + WS_H2) + off), vp = *(const f32x4*)((const float*)(ws + WS_VP) + off);
#pragma unroll
                for (int e = 0; e < 4; ++e) v[e] = h[e] + sigmoidf_(x[e]) * vp[e];
                st4f(p.out + O_YS + (size_t)row * DM + col, v); }
        }
        __syncthreads();
    }
}

constexpr int LDS_BYTES = LDS_MAIN + 256;
constexpr int NPHASE = 9;
#ifndef REPEAT_PHASE
#define REPEAT_PHASE -1
#endif
template <int K> __device__ __forceinline__ void phase_body(const Params& p, unsigned char* lds) {
    const int tid = threadIdx.x, bid = blockIdx.x, G = gridDim.x;
    const int wv = __builtin_amdgcn_readfirstlane(tid >> 6);
    unsigned char* ws = p.ws;
    if constexpr (K == 0) phase_prologue(p, lds);
    if constexpr (K == 1) {
        pg8::Gemm g{(const bf16_t*)(ws + WS_XB), (const bf16_t*)(ws + WS_W1), MP, N1, DM};
        {   SubsetOrder S; S.init(MP, 7 * 256, G, bid); S.set = 0;
            EpiProj<0> E; E.ss1 = (const float*)(ws + WS_SS1); E.qn = p.in[14]; E.kn = p.in[15]; E.rot = (const float*)(ws + WS_ROT);
            E.Q = (bf16_t*)(ws + WS_Q); E.CA = (bf16_t*)(ws + WS_CA); E.KS = (bf16_t*)(ws + WS_KS); E.VS = (bf16_t*)(ws + WS_VS); E.KW = (bf16_t*)(ws + WS_KW); E.VW = (bf16_t*)(ws + WS_VW);
            E.RQ = (bf16_t*)(ws + WS_RQ); E.RK = (bf16_t*)(ws + WS_RK); E.RV = (bf16_t*)(ws + WS_RV); E.RG = (bf16_t*)(ws + WS_RG); E.GATE = (float*)(ws + WS_GATE); E.out = p.out;
            pg8::gemm_phase((LAS unsigned char*)lds, g, S, E); }
        {   SubsetOrder S; S.init(MP, 7 * 256, G, bid); S.set = 1;
            EpiProj<1> E; E.ss1 = (const float*)(ws + WS_SS1); E.qn = p.in[14]; E.kn = p.in[15]; E.rot = (const float*)(ws + WS_ROT);
            E.Q = (bf16_t*)(ws + WS_Q); E.CA = (bf16_t*)(ws + WS_CA); E.KS = (bf16_t*)(ws + WS_KS); E.VS = (bf16_t*)(ws + WS_VS); E.KW = (bf16_t*)(ws + WS_KW); E.VW = (bf16_t*)(ws + WS_VW);
            E.RQ = (bf16_t*)(ws + WS_RQ); E.RK = (bf16_t*)(ws + WS_RK); E.RV = (bf16_t*)(ws + WS_RV); E.RG = (bf16_t*)(ws + WS_RG); E.GATE = (float*)(ws + WS_GATE); E.out = p.out;
            pg8::gemm_phase((LAS unsigned char*)lds, g, S, E); }
        skinny_phase<1>(p, lds);
    }
    if constexpr (K == 2) {
        unsigned* qh = (unsigned*)(ws + WS_QUEUE) + 64;
        volatile LAS unsigned* qs = (volatile LAS unsigned*)(lds + LDS_MAIN + 16);
        for (;;) {
            if (tid == 0) *qs = __hip_atomic_fetch_add(qh, 1u, __ATOMIC_RELAXED, __HIP_MEMORY_SCOPE_AGENT);
            __syncthreads();
            const int it = (int)*qs;
            __syncthreads();
            if (it >= 512 + 16 + 512 + 128) break;
            if (it < 512) { const int c = it >> 8, b = (it >> 3) & 31, sg = it & 7;
                compress_fused_unit<false>(p, lds, c, b, sg * 128, NSEG_S, NC_S, (bf16_t*)(ws + (c ? WS_CVCS : WS_CKCS))); }
            else if (it < 528) { const int q = it - 512, c = q >> 3, b = q & 7;
                compress_fused_unit<true>(p, lds, c, b, 0, NSEG_P, NC_P, (bf16_t*)(ws + (c ? WS_CVCP : WS_CKCP))); }
            else if (it < 1040) { const int u = it - 528; ret_r1_unit(p, lds, u >> 6, (u >> 4) & 3, u & 15); }
            else { const int u = it - 1040; ret_sample_unit(p, lds, u >> 2, u & 3); }
        }
    }
    if constexpr (K == 3) {
        for (int u = bid; u < NB * 4 * 16; u += G) ret_r2_unit(p, lds, u >> 6, (u >> 4) & 3, u & 15);
        pret_job(p);
    }
    if constexpr (K == 4) {
        unsigned* qh = (unsigned*)(ws + WS_QUEUE);
        volatile LAS unsigned* qs = (volatile LAS unsigned*)(lds + LDS_MAIN + 16);
        for (;;) {
            if (tid == 0) *qs = __hip_atomic_fetch_add(qh, 1u, __ATOMIC_RELAXED, __HIP_MEMORY_SCOPE_AGENT);
            __syncthreads();
            const unsigned it = *qs;
            __syncthreads();
            if (it >= 576u) break;
            if (it < 64u) attn_sample_unit(p, lds, (int)(it >> 1), (int)(it & 1));
            else { const int q = (int)it - 64, bg = q & 15; attn_prompt_unit(p, lds, bg >> 1, bg & 1, 31 - (q >> 4)); }
        }
    }
    if constexpr (K == 5) {
        pg8::Gemm g{(const bf16_t*)(ws + WS_AO), (const bf16_t*)(ws + WS_WO), MP, DM, DM};
        pg8::StaticOrder S; S.init(MP, DM, G, bid);
        EpiOut E; E.xp = p.in[0]; E.xs = p.in[1]; E.H = (float*)(ws + WS_H); E.HB = (bf16_t*)(ws + WS_HB); E.SS2 = (float*)(ws + WS_SS2);
        pg8::gemm_phase((LAS unsigned char*)lds, g, S, E);
        skinny_phase<5>(p, lds);
    }
    if constexpr (K == 6) {
        pg8::Gemm g{(const bf16_t*)(ws + WS_HB), (const bf16_t*)(ws + WS_WGU), MP, NGU, DM};
        pg8::StaticOrder S; S.init(MP, NGU, G, bid);
        EpiGU E; E.SS2 = (const float*)(ws + WS_SS2); E.ACT = (bf16_t*)(ws + WS_ACT);
        pg8::gemm_phase((LAS unsigned char*)lds, g, S, E);
        skinny_phase<6>(p, lds);
    }
    if constexpr (K == 7) {
        { pg8::Gemm g{(const bf16_t*)(ws + WS_ACT), (const bf16_t*)(ws + WS_WD), MP, DM, DFF};
          pg8::StaticOrder S; S.init(MP, DM, G, bid);
          EpiDown E; E.H = (const float*)(ws + WS_H); E.H2 = (float*)(ws + WS_H2); E.H2B = (bf16_t*)(ws + WS_H2B);
          pg8::gemm_phase((LAS unsigned char*)lds, g, S, E); }
        { pg8::Gemm g{(const bf16_t*)(ws + WS_PB), (const bf16_t*)(ws + WS_WPP), MP, DM, PLE};
          pg8::StaticOrder S; S.init(MP, DM, G, bid);
          EpiF32 E; E.C = (float*)(ws + WS_VP); E.ld = DM;
          pg8::gemm_phase((LAS unsigned char*)lds, g, S, E); }
        skinny_phase<7>(p, lds);
        skinny_phase<9>(p, lds);
    }
    if constexpr (K == 8) {
        pg8::Gemm g{(const bf16_t*)(ws + WS_H2B), (const bf16_t*)(ws + WS_WPG), MP, DM, DM};
        pg8::StaticOrder S; S.init(MP, DM, G, bid);
        EpiFinal E; E.H2 = (const float*)(ws + WS_H2); E.VP = (const float*)(ws + WS_VP); E.out = p.out;
        pg8::gemm_phase((LAS unsigned char*)lds, g, S, E);
        skinny_phase<8>(p, lds);
    }
}
__global__ void __launch_bounds__(512, 2) nsa_ret_fwd(Params p) {
    extern __shared__ __attribute__((aligned(16))) unsigned char lds[];
    const int tid = threadIdx.x;
    unsigned char* ws = p.ws;
    if (tid < 4) ((LAS unsigned*)(lds + LDS_MAIN))[tid] = 0u;
    __syncthreads();
    const bool fused = (p.ph_hi - p.ph_lo) > 1;
    XcdBarrier bar; bar.bar = (unsigned*)(ws + WS_CTL); bar.x = 0; bar.st = (volatile LAS unsigned*)(lds + LDS_MAIN);
    if (fused) bar = xcd_barrier_post((unsigned*)(ws + WS_CTL), (volatile LAS unsigned*)(lds + LDS_MAIN));
#ifdef ONLY_PHASE
#define PH_ON(k) ((k) == ONLY_PHASE && p.ph_lo <= (k) && (k) < p.ph_hi)
#else
#define PH_ON(k) (p.ph_lo <= (k) && (k) < p.ph_hi)
#endif
#define SEAM(k) do { if (PH_ON(k) && PH_ON((k) + 1)) xcd_barrier(bar); } while (0)
#define PHASE(k) do { if (PH_ON(k)) { phase_body<k>(p, lds); if (REPEAT_PHASE == (k)) { __syncthreads(); phase_body<k>(p, lds); } } } while (0)
    PHASE(0); SEAM(0);
    PHASE(1); SEAM(1);
    PHASE(2); SEAM(2);
    PHASE(3); SEAM(3);
    PHASE(4); SEAM(4);
    PHASE(5); SEAM(5);
    PHASE(6); SEAM(6);
    PHASE(7); SEAM(7);
    PHASE(8);
}

extern "C" void kernel_launch(void* const* d_in, const int* in_sizes, int n_in, void* d_out, int out_size, void* d_ws, size_t ws_size, hipStream_t stream) {
    static int grid = 0;
    if (grid == 0) {
        if (n_in != 31 || (size_t)out_size != O_END || ws_size < WS_END) { fprintf(stderr, "kernel_launch: unexpected shapes: n_in %d out %d ws %zu (need %zu)\n", n_in, out_size, ws_size, (size_t)WS_END); grid = -1; return; }
        int dev = 0, cus = 0;
        if (hipGetDevice(&dev) != hipSuccess || hipDeviceGetAttribute(&cus, hipDeviceAttributeMultiprocessorCount, dev) != hipSuccess) { grid = -1; return; }
        if (hipFuncSetAttribute((const void*)nsa_ret_fwd, hipFuncAttributeMaxDynamicSharedMemorySize, LDS_BYTES) != hipSuccess) { fprintf(stderr, "kernel_launch: hipFuncSetAttribute failed\n"); grid = -1; return; }
        int per_cu = 0;
        if (hipOccupancyMaxActiveBlocksPerMultiprocessor(&per_cu, (const void*)nsa_ret_fwd, 512, LDS_BYTES) != hipSuccess || per_cu < 1) { fprintf(stderr, "kernel_launch: occupancy query says %d blocks per CU\n", per_cu); }
        (void)hipGetLastError();
        grid = cus;
    }
    if (grid < 0) return;
    (void)hipMemsetAsync((char*)d_ws + WS_CTL, 0, CTL_BYTES, stream);
    Params p; memset(&p, 0, sizeof(p));
    for (int i = 0; i < 31; ++i) p.in[i] = (const float*)d_in[i];
    p.page_table = (const int*)d_in[9]; p.out = (float*)d_out; p.ws = (unsigned char*)d_ws;
#if MK_PER_PHASE_LAUNCH
    for (int ph = 0; ph < NPHASE; ++ph) { p.ph_lo = ph; p.ph_hi = ph + 1; hipLaunchKernelGGL(nsa_ret_fwd, dim3(grid), dim3(512), LDS_BYTES, stream, p); }
#else
    p.ph_lo = 0; p.ph_hi = NPHASE; hipLaunchKernelGGL(nsa_ret_fwd, dim3(grid), dim3(512), LDS_BYTES, stream, p);
#endif
}
```

```cpp
#include <hip/hip_runtime.h>
#include <cstdio>
#include <cstdint>
#include <cstring>

#ifndef MK_PER_PHASE_LAUNCH
#define MK_PER_PHASE_LAUNCH 0
#endif

constexpr int DM = 1024, NB = 8, SEQ = 2048, DB = 32, PAST = 16384, PAGE = 128, NPAGES = 128;
constexpr int MP = NB * SEQ;
constexpr int MV = MP + DB;
constexpr int MR = 16640;
constexpr int INC = 3352, N1 = 3584, DFF = 2816, NGU = 5632, PLE = 256;
constexpr int NSEG_S = 1024, NSEG_P = 128;
constexpr int CROWS_S = DB * NSEG_S * 2;
constexpr int CROWS_P = NB * NSEG_P * 2;
constexpr int CROWS = CROWS_S + CROWS_P;
constexpr int NC_P = 127, NC_S = 1023;
constexpr float EPS = 1e-6f;
constexpr float LOG2E = 1.4426950408889634f;

constexpr size_t O_YP = 0, O_YS = O_YP + (size_t)MP * DM, O_PCK = O_YS + (size_t)DB * DM, O_PCV = O_PCK + (size_t)MP * 128, O_PSK = O_PCV + (size_t)MP * 128,
                 O_PSV = O_PSK + (size_t)MP * 128, O_PWK = O_PSV + (size_t)MP * 128, O_PWV = O_PWK + (size_t)NB * 512 * 128, O_PRET = O_PWV + (size_t)NB * 512 * 128,
                 O_SCK = O_PRET + (size_t)NB * 4 * 128 * 128, O_SCV = O_SCK + DB * 128, O_SSK = O_SCV + DB * 128, O_SSV = O_SSK + DB * 128, O_SWK = O_SSV + DB * 128,
                 O_SWV = O_SWK + (size_t)DB * 512 * 128, O_SRET = O_SWV + (size_t)DB * 512 * 128, O_END = O_SRET + (size_t)DB * 4 * 128 * 128;

constexpr size_t al256(size_t x) { return (x + 255) & ~(size_t)255; }
constexpr size_t WS_CTL = 0, CTL_BYTES = 16384;
constexpr size_t WS_W1 = WS_CTL + CTL_BYTES;
constexpr size_t WS_WO = WS_W1 + (size_t)N1 * DM * 2;
constexpr size_t WS_WGU = WS_WO + (size_t)DM * DM * 2;
constexpr size_t WS_WD = WS_WGU + (size_t)NGU * DM * 2;
constexpr size_t WS_WPG = WS_WD + (size_t)DM * DFF * 2;
constexpr size_t WS_WPP = WS_WPG + (size_t)DM * DM * 2;
constexpr size_t WS_W1C = WS_WPP + (size_t)DM * PLE * 2;
constexpr size_t WS_W2C = WS_W1C + (size_t)2 * 256 * 1024 * 2;
constexpr size_t WS_BIASC = WS_CTL + 14336;
constexpr size_t WS_QUEUE = WS_CTL + 15360;
constexpr size_t WS_BIASP = WS_W2C + (size_t)2 * 64 * 128 * 2;
constexpr size_t WS_BTAB = WS_BIASP + 32 * 256 * 4;
constexpr size_t WS_ROT = WS_BTAB + 4096;
constexpr size_t WS_SS1 = al256(WS_ROT + (size_t)2049 * 64 * 8);
constexpr size_t WS_SS2 = WS_SS1 + (size_t)MR * 4;
constexpr size_t WS_XB = al256(WS_SS2 + (size_t)MR * 4);
constexpr size_t WS_PB = WS_XB + (size_t)MR * DM * 2;
constexpr size_t WS_Q = WS_PB + (size_t)MR * PLE * 2;
constexpr size_t WS_KS = WS_Q + (size_t)MR * 512 * 2;
constexpr size_t WS_VS = WS_KS + (size_t)MR * 128 * 2;
constexpr size_t WS_KW = WS_VS + (size_t)MR * 128 * 2;
constexpr size_t WS_VW = WS_KW + (size_t)MR * 128 * 2;
constexpr size_t WS_RQ = WS_VW + (size_t)MR * 128 * 2;
constexpr size_t WS_RK = WS_RQ + (size_t)MR * 512 * 2;
constexpr size_t WS_RV = WS_RK + (size_t)MR * 512 * 2;
constexpr size_t WS_RG = WS_RV + (size_t)MR * 512 * 2;
constexpr size_t WS_GATE = WS_RG + (size_t)MR * 512 * 2;
constexpr size_t WS_CA = al256(WS_GATE + (size_t)MR * 24 * 4);
constexpr size_t WS_KC = WS_CA, WS_VC = WS_CA + (size_t)MR * 128 * 2;
constexpr size_t WS_CP = WS_CA + (size_t)2 * CROWS * 1024 * 2;
constexpr size_t WS_CKCP = WS_CP + (size_t)2 * CROWS * 256 * 4;
constexpr size_t WS_CVCP = WS_CKCP + (size_t)NB * 128 * 128 * 2;
constexpr size_t WS_CKCS = WS_CVCP + (size_t)NB * 128 * 128 * 2;
constexpr size_t WS_CVCS = WS_CKCS + (size_t)DB * 1024 * 128 * 2;
constexpr size_t WS_KVT = WS_CVCS + (size_t)DB * 1024 * 128 * 2;
constexpr size_t WS_AO = WS_KVT + (size_t)NB * 4 * 16 * 16384 * 4;
constexpr size_t WS_H = WS_AO + (size_t)MR * DM * 2;
constexpr size_t WS_HB = WS_H + (size_t)MR * DM * 4;
constexpr size_t WS_ACT = WS_HB + (size_t)MR * DM * 2;
constexpr size_t WS_H2 = WS_ACT + (size_t)MR * DFF * 2;
constexpr size_t WS_H2B = WS_H2 + (size_t)MR * DM * 4;
constexpr size_t WS_VP = WS_H2B + (size_t)MR * DM * 2;
constexpr size_t WS_END = WS_VP + (size_t)MR * DM * 4;

constexpr int LDS_MAIN = 147456;
typedef unsigned short bf16_t;
typedef short bf16x8 __attribute__((ext_vector_type(8)));
typedef short s16x4 __attribute__((ext_vector_type(4)));
typedef float f32x4 __attribute__((ext_vector_type(4)));
typedef float f32x16 __attribute__((ext_vector_type(16)));
typedef unsigned u32x4 __attribute__((ext_vector_type(4)));
typedef unsigned u32x2 __attribute__((ext_vector_type(2)));
typedef float f32x2_t __attribute__((ext_vector_type(2)));
typedef __bf16 bf16x2_t __attribute__((ext_vector_type(2)));
#define LAS __attribute__((address_space(3)))

__device__ __forceinline__ unsigned pk2(float lo, float hi) { f32x2_t v = {lo, hi}; bf16x2_t b = __builtin_convertvector(v, bf16x2_t); return __builtin_bit_cast(unsigned, b); }
__device__ __forceinline__ float bflo(unsigned w) { return __uint_as_float(w << 16); }
__device__ __forceinline__ float bfhi(unsigned w) { return __uint_as_float(w & 0xffff0000u); }
__device__ __forceinline__ float bf1(bf16_t b) { return __uint_as_float(((unsigned)b) << 16); }
__device__ __forceinline__ float sigmoidf_(float x) { return 1.f / (1.f + __expf(-x)); }
__device__ __forceinline__ float siluf_(float x) { return x / (1.f + __expf(-x)); }
__device__ __forceinline__ int crow(int r, int hi) { return (r & 3) + 8 * (r >> 2) + 4 * hi; }
__device__ __forceinline__ float xhalf_max(float v) { auto rr = __builtin_amdgcn_permlane32_swap(__float_as_uint(v), __float_as_uint(v), false, false); return fmaxf(__uint_as_float(rr[0]), __uint_as_float(rr[1])); }
__device__ __forceinline__ float xhalf_sum(float v) { auto rr = __builtin_amdgcn_permlane32_swap(__float_as_uint(v), __float_as_uint(v), false, false); return __uint_as_float(rr[0]) + __uint_as_float(rr[1]); }

struct Params {
    const float* in[31];
    const int* page_table;
    float* out;
    unsigned char* ws;
    int ph_lo, ph_hi;
};

#define XB_TMO      128
#define XB_XCNT(j)  (256  + 64 * (j))
#define XB_XSUB(j)  (1280 + 64 * (j))
#define XB_XGEN(j)  (2304 + 64 * (j))
#define XB_TOP      3328
#define XB_TOPGEN   3392
#define XCD_BAR_WORDS 3456
#define XB_SPIN_CAP (1u << 18)
__device__ __forceinline__ unsigned xb_ld(unsigned* p)              { return __hip_atomic_load(p, __ATOMIC_RELAXED, __HIP_MEMORY_SCOPE_AGENT); }
__device__ __forceinline__ unsigned xb_add(unsigned* p, unsigned v) { return __hip_atomic_fetch_add(p, v, __ATOMIC_RELAXED, __HIP_MEMORY_SCOPE_AGENT); }
__device__ __forceinline__ unsigned xb_xcc_id() { return (unsigned)__builtin_amdgcn_s_getreg((3 << 11) | 20) & 0xFu; }
#define XB_SPIN(cond, bar) do { unsigned _sp = 0; while (cond) { __builtin_amdgcn_s_sleep(1); \
    if ((++_sp & 255u) == 0u) { if (xb_ld(&(bar)[XB_TMO])) break; if (_sp > XB_SPIN_CAP) { atomicAdd(&(bar)[XB_TMO], 1u); break; } } } } while (0)
struct XcdBarrier { unsigned* bar; unsigned x; volatile LAS unsigned* st; };
__device__ __forceinline__ XcdBarrier xcd_barrier_post(unsigned* bar, volatile LAS unsigned* st) {
    XcdBarrier b; b.bar = bar; b.x = xb_xcc_id(); b.st = st;
    if (threadIdx.x == 0) (void)xb_add(&bar[XB_XCNT(b.x)], 1u);
    return b;
}
__device__ __forceinline__ void xcd_barrier_complete(unsigned* bar, unsigned x, unsigned& nloc, unsigned& nx) {
    const unsigned G = gridDim.x * gridDim.y * gridDim.z;
    unsigned sum, cnt, mine, sp = 0u;
    for (;;) {
        sum = 0u; cnt = 0u; mine = 0u;
#pragma unroll
        for (unsigned j = 0; j < 16; ++j) { const unsigned c = xb_ld(&bar[XB_XCNT(j)]); sum += c; cnt += (c > 0u) ? 1u : 0u; mine = (j == x) ? c : mine; }
        if (sum == G) break;
        __builtin_amdgcn_s_sleep(1);
        if ((++sp & 255u) == 0u) { if (xb_ld(&bar[XB_TMO])) break; if (sp > XB_SPIN_CAP) { atomicAdd(&bar[XB_TMO], 1u); break; } }
    }
    nloc = mine > 0u ? mine : 1u; nx = cnt > 0u ? cnt : 1u;
}
__device__ __forceinline__ void xcd_barrier(const XcdBarrier& b) {
    asm volatile("s_waitcnt vmcnt(0)" ::: "memory");
    __syncthreads();
    if (threadIdx.x == 0) {
        unsigned* bar = b.bar;
        __builtin_amdgcn_s_waitcnt(0);
        unsigned nloc = b.st[0], nx = b.st[1];
        if (nloc == 0u) { xcd_barrier_complete(bar, b.x, nloc, nx); b.st[0] = nloc; b.st[1] = nx; }
        const unsigned old = xb_add(&bar[XB_XSUB(b.x)], 1u);
        const unsigned gen = old / nloc;
        if (old + 1u == (gen + 1u) * nloc) {
            __builtin_amdgcn_fence(__ATOMIC_RELEASE, "agent");
            asm volatile("s_waitcnt vmcnt(0)" ::: "memory");
            const unsigned og = xb_add(&bar[XB_TOP], 1u);
            const unsigned tg = og / nx;
            if (og + 1u == (tg + 1u) * nx) xb_add(&bar[XB_TOPGEN], 1u);
            else XB_SPIN(xb_ld(&bar[XB_TOPGEN]) == tg, bar);
            __builtin_amdgcn_fence(__ATOMIC_ACQUIRE, "agent");
            xb_add(&bar[XB_XGEN(b.x)], 1u);
            asm volatile("s_waitcnt vmcnt(0)" ::: "memory");
        } else {
            XB_SPIN(xb_ld(&bar[XB_XGEN(b.x)]) == gen, bar);
            __builtin_amdgcn_fence(__ATOMIC_ACQUIRE, "agent");
            asm volatile("s_waitcnt vmcnt(0)" ::: "memory");
        }
    }
    __syncthreads();
}

namespace pg8 {
constexpr int BM = 256, BK = 64, HALF = 128, HTB = HALF * BK * 2, STAGE_BYTES = 8 * HTB, NXCD = 8, WGM = 8;
__host__ __device__ __forceinline__ int lds_byte(int r, int c) { const int st = (r >> 4) * 2 + (c >> 5), rr = r & 15, cc = c & 31, ob = rr * 64 + cc * 2; return st * 1024 + (ob ^ (((ob >> 9) & 1) << 5)); }
__host__ __device__ __forceinline__ void stage_rc(int b, int& R, int& C) { const int st = b / 1024, sb = b % 1024, swz = sb ^ (((sb >> 9) & 1) << 5); R = (st >> 1) * 16 + swz / 64; C = (st & 1) * 32 + (swz % 64) / 2; }
__host__ __device__ __forceinline__ int perm32(int rho) { const int n = rho >> 4, i = rho & 15; return 8 * (i >> 2) + 4 * n + (i & 3); }
struct Unit { int pm, pn; };
struct Gemm { const bf16_t* A; const bf16_t* Bt; int M, N, K; };
struct StaticOrder {
    int nM, nN, nwg, G, c;
    __host__ __device__ void init(int M, int N, int G_, int c_) { nM = M / BM; nN = N / BM; nwg = nM * nN; G = G_; c = c_; }
    __host__ __device__ bool next(int i, Unit& u) const {
        const long L = (long)i * G + c; if (L >= nwg) return false;
        int wgid = (int)L; { const int q = nwg / NXCD, r = nwg % NXCD, xcd = wgid % NXCD, off = wgid / NXCD; wgid = (xcd < r ? xcd * (q + 1) : r * (q + 1) + (xcd - r) * q) + off; }
        const int nig = WGM * nN, gid = wgid / nig, fm = gid * WGM, gsz = (nM - fm) < WGM ? (nM - fm) : WGM;
        u.pm = fm + ((wgid % nig) % gsz); u.pn = (wgid % nig) / gsz; return true;
    }
    __device__ __forceinline__ void a_ready(const Unit&) const {}
    __device__ __forceinline__ void done(const Unit&) const {}
};
template <class Epi, class Sched>
__device__ __forceinline__ void gemm_phase(LAS unsigned char* lds, const Gemm g, const Sched& S, const Epi& E) {
    const int tid = threadIdx.x, wid = __builtin_amdgcn_readfirstlane(tid >> 6), lane = tid & 63, wr = wid >> 2, wc = wid & 3, fr = lane & 15, fq = lane >> 4;
    const int K = g.K, nt = K / BK;
    unsigned voffA[2], voffB[2];
#pragma unroll
    for (int i = 0; i < 2; ++i) { int R, C; stage_rc(tid * 16 + i * 8192, R, C); const int Rb = Epi::PERM ? ((R & ~31) + perm32(R & 31)) : R;
        voffA[i] = (unsigned)(R * K + C) * 2u; voffB[i] = (unsigned)(Rb * K + C) * 2u; }
    const size_t kstep = (size_t)(BK * 2);
    const size_t hstep = (size_t)HALF * K * 2;
    const size_t tstep = 2 * hstep;
    const unsigned ldsw = (unsigned)wid * 1024u;
    const int aoff = lds_byte(wr * 64 + fr, fq * 8), boff = lds_byte(wc * 32 + fr, fq * 8);
#define PG8_SA(b, h) (((b) * 2 + (h)) * HTB)
#define PG8_SB(b, h) ((4 + (b) * 2 + (h)) * HTB)
#define PG8_STAGE(bufoff, gbase, voff) do { _Pragma("unroll") for (int _i = 0; _i < 2; ++_i) \
        __builtin_amdgcn_global_load_lds((const unsigned*)((const char*)(gbase) + (voff)[_i]), (LAS unsigned*)(lds + (bufoff) + ldsw + _i * 8192), 16, 0, 0); } while (0)
#define PG8_LDA(dst, b, h) do { _Pragma("unroll") for (int m = 0; m < 4; ++m) _Pragma("unroll") for (int k = 0; k < 2; ++k) dst[m][k] = *(const LAS bf16x8*)(lds + PG8_SA(b, h) + aoff + m * 2048 + k * 1024); } while (0)
#define PG8_LDB(dst, b, h) do { _Pragma("unroll") for (int n = 0; n < 2; ++n) _Pragma("unroll") for (int k = 0; k < 2; ++k) dst[n][k] = *(const LAS bf16x8*)(lds + PG8_SB(b, h) + boff + n * 2048 + k * 1024); } while (0)
#define PG8_MMA(ai, bj, At, Bt) do { __builtin_amdgcn_s_setprio(1); _Pragma("unroll") for (int m = 0; m < 4; ++m) _Pragma("unroll") for (int n = 0; n < 2; ++n) _Pragma("unroll") for (int k = 0; k < 2; ++k) \
        acc[ai][bj][m][n] = __builtin_amdgcn_mfma_f32_16x16x32_bf16(Bt[n][k], At[m][k], acc[ai][bj][m][n], 0, 0, 0); __builtin_amdgcn_s_setprio(0); } while (0)
#define PG8_WAIT_V(n) asm volatile("s_waitcnt vmcnt(" #n ")" ::: "memory")
#define PG8_WAIT_L(n) asm volatile("s_waitcnt lgkmcnt(" #n ")" ::: "memory")
#define PG8_BAR __builtin_amdgcn_s_barrier()
#define PG8_SCHED __builtin_amdgcn_sched_barrier(0)
    Unit cur, nxt; int ui = 0;
    if (!S.next(0, cur)) return;
    f32x4 acc[2][2][4][2];
#pragma unroll
    for (int a = 0; a < 2; ++a)
#pragma unroll
        for (int b = 0; b < 2; ++b)
#pragma unroll
            for (int m = 0; m < 4; ++m)
#pragma unroll
                for (int n = 0; n < 2; ++n) acc[a][b][m][n] = (f32x4){0.f, 0.f, 0.f, 0.f};
    bf16x8 At[4][2], B0[2][2], B1[2][2];
    const char* cA = (const char*)g.A + (size_t)cur.pm * tstep; const char* cB = (const char*)g.Bt + (size_t)cur.pn * tstep;
    S.a_ready(cur);
    PG8_STAGE(PG8_SB(0, 0), cB, voffB); PG8_STAGE(PG8_SA(0, 0), cA, voffA); PG8_STAGE(PG8_SB(0, 1), cB + hstep, voffB); PG8_STAGE(PG8_SA(0, 1), cA + hstep, voffA);
    if (wr == 1) PG8_BAR;
    PG8_WAIT_V(4); PG8_BAR;
    PG8_STAGE(PG8_SB(1, 0), cB + kstep, voffB); PG8_STAGE(PG8_SA(1, 0), cA + kstep, voffA); PG8_STAGE(PG8_SB(1, 1), cB + hstep + kstep, voffB);
    PG8_WAIT_V(6); PG8_BAR;
    for (;;) {
        const bool has_next = S.next(ui + 1, nxt);
        const char* nA = has_next ? (const char*)g.A + (size_t)nxt.pm * tstep : cA; const char* nB = has_next ? (const char*)g.Bt + (size_t)nxt.pn * tstep : cB;
        for (int t = 0; t < nt; t += 2) {
            const bool last = (t == nt - 2);
            const char* a1 = cA + (size_t)(t + 1) * kstep;
            const char* a2 = last ? nA : cA + (size_t)(t + 2) * kstep; const char* b2 = last ? nB : cB + (size_t)(t + 2) * kstep;
            const char* a3 = a2 + kstep; const char* b3 = b2 + kstep;
            if (last && has_next) S.a_ready(nxt);
            PG8_LDB(B0, 0, 0); PG8_SCHED; PG8_LDA(At, 0, 0); PG8_STAGE(PG8_SA(1, 1), a1 + hstep, voffA);
            PG8_WAIT_L(8); PG8_BAR; PG8_WAIT_L(0); PG8_MMA(0, 0, At, B0); PG8_BAR; PG8_SCHED;
            PG8_LDB(B1, 0, 1); PG8_STAGE(PG8_SB(0, 0), b2, voffB);
            PG8_BAR; PG8_WAIT_L(0); PG8_MMA(0, 1, At, B1); PG8_BAR;
            PG8_LDA(At, 0, 1); PG8_STAGE(PG8_SA(0, 0), a2, voffA);
            PG8_BAR; PG8_WAIT_L(0); PG8_MMA(1, 0, At, B0); PG8_BAR; PG8_SCHED;
            PG8_STAGE(PG8_SB(0, 1), b2 + hstep, voffB);
            PG8_WAIT_V(6); PG8_BAR; PG8_MMA(1, 1, At, B1); PG8_BAR;
            PG8_LDB(B0, 1, 0); PG8_SCHED; PG8_LDA(At, 1, 0); PG8_STAGE(PG8_SA(0, 1), a2 + hstep, voffA);
            PG8_WAIT_L(8); PG8_BAR; PG8_WAIT_L(0); PG8_MMA(0, 0, At, B0); PG8_BAR; PG8_SCHED;
            PG8_LDB(B1, 1, 1); PG8_STAGE(PG8_SB(1, 0), b3, voffB);
            PG8_BAR; PG8_WAIT_L(0); PG8_MMA(0, 1, At, B1); PG8_BAR;
            PG8_LDA(At, 1, 1); PG8_STAGE(PG8_SA(1, 0), a3, voffA);
            PG8_BAR; PG8_WAIT_L(0); PG8_MMA(1, 0, At, B0); PG8_BAR; PG8_SCHED;
            PG8_STAGE(PG8_SB(1, 1), b3 + hstep, voffB);
            PG8_WAIT_V(6); PG8_BAR; PG8_MMA(1, 1, At, B1); PG8_BAR;
        }
        E(acc, cur, wr, wc, fr, fq);
        if (!has_next) break;
#pragma unroll
        for (int a = 0; a < 2; ++a)
#pragma unroll
            for (int b = 0; b < 2; ++b)
#pragma unroll
                for (int m = 0; m < 4; ++m)
#pragma unroll
                    for (int n = 0; n < 2; ++n) acc[a][b][m][n] = (f32x4){0.f, 0.f, 0.f, 0.f};
        cur = nxt; cA = nA; cB = nB; ++ui;
    }
    PG8_WAIT_V(0);
    if (wr == 0) PG8_BAR;
    PG8_BAR;
#undef PG8_SA
#undef PG8_SB
#undef PG8_STAGE
#undef PG8_LDA
#undef PG8_LDB
#undef PG8_MMA
#undef PG8_WAIT_V
#undef PG8_WAIT_L
#undef PG8_BAR
#undef PG8_SCHED
}
}

typedef f32x4 Acc[2][2][4][2];
#define EPI_ROWS(...) _Pragma("unroll") for (int ai = 0; ai < 2; ++ai) _Pragma("unroll") for (int m = 0; m < 4; ++m) { const int row = u.pm * 256 + ai * 128 + wr * 64 + m * 16 + fr; __VA_ARGS__ }
__device__ __forceinline__ u32x4 pack8(const float* v) { u32x4 w; w.x = pk2(v[0], v[1]); w.y = pk2(v[2], v[3]); w.z = pk2(v[4], v[5]); w.w = pk2(v[6], v[7]); return w; }

template <int SET> struct EpiProj {
    static constexpr bool PERM = true;
    const float* ss1; const float* qn; const float* kn; const float* rot;
    bf16_t *Q, *CA, *KS, *VS, *KW, *VW, *RQ, *RK, *RV, *RG; float* GATE; float* out;
    __device__ __forceinline__ void operator()(const Acc& acc, const pg8::Unit& u, int wr, int wc, int fr, int fq) const {
        const int pn = u.pn, c8 = 8 * fq;
        if (SET == 0 && (pn < 2 || pn == 3)) {
            const float* nw = (pn < 2) ? qn : kn; const float post = (pn < 2) ? 0.125f * LOG2E : 1.f;
            EPI_ROWS(
                const float s1 = ss1[row]; float v[2][8]; float ss = 0.f;
                _Pragma("unroll") for (int bj = 0; bj < 2; ++bj) _Pragma("unroll") for (int e = 0; e < 8; ++e) { v[bj][e] = acc[ai][bj][m][e >> 2][e & 3] * s1; ss += v[bj][e] * v[bj][e]; }
                ss += __shfl_xor(ss, 16); ss += __shfl_xor(ss, 32);
                const float rs = rsqrtf(ss * (1.f / 64.f) + EPS) * post;
                _Pragma("unroll") for (int bj = 0; bj < 2; ++bj) {
                    const int d0 = 32 * bj + c8;
                    const f32x4 w0 = *(const f32x4*)(nw + d0), w1 = *(const f32x4*)(nw + d0 + 4);
                    _Pragma("unroll") for (int e = 0; e < 4; ++e) { v[bj][e] *= rs * w0[e]; v[bj][4 + e] *= rs * w1[e]; }
                    if (pn < 2) { *(u32x4*)(Q + (size_t)row * 512 + (pn * 4 + wc) * 64 + d0) = pack8(v[bj]); }
                    else {
                        const int col = (wc & 1) * 64 + d0;
                        if (wc < 2) {
                            *(u32x4*)(KS + (size_t)row * 128 + col) = pack8(v[bj]);
                            float* o = row < MP ? out + O_PSK + (size_t)row * 128 + col : out + O_SSK + (size_t)(row - MP) * 128 + col;
                            if (row < MV) { *(f32x4*)o = (f32x4){v[bj][0], v[bj][1], v[bj][2], v[bj][3]}; *(f32x4*)(o + 4) = (f32x4){v[bj][4], v[bj][5], v[bj][6], v[bj][7]}; }
                        } else {
                            *(u32x4*)(KW + (size_t)row * 128 + col) = pack8(v[bj]);
                            float* o = nullptr; const int t = row & 2047;
                            if (row < MP) { if (t >= 1536) o = out + O_PWK + ((size_t)(row >> 11) * 512 + (t - 1536)) * 128 + col; }
                            else if (row < MV) o = out + O_SWK + ((size_t)(row - MP) * 512 + 511) * 128 + col;
                            if (o) { *(f32x4*)o = (f32x4){v[bj][0], v[bj][1], v[bj][2], v[bj][3]}; *(f32x4*)(o + 4) = (f32x4){v[bj][4], v[bj][5], v[bj][6], v[bj][7]}; }
                        }
                    }
                }
            )
        } else if (SET == 1 && (pn == 2 || pn == 4)) {
            EPI_ROWS(
                const float s1 = ss1[row];
                _Pragma("unroll") for (int bj = 0; bj < 2; ++bj) {
                    float v[8]; _Pragma("unroll") for (int e = 0; e < 8; ++e) v[e] = acc[ai][bj][m][e >> 2][e & 3] * s1;
                    const int col = 32 * wc + c8;
                    float* o = nullptr;
                    if (pn == 2) {
                        if (row < MP) { *(u32x4*)(CA + (size_t)bj * MR * 128 + (size_t)row * 128 + col) = pack8(v);
                            o = out + (bj ? O_PCV : O_PCK) + (size_t)row * 128 + col; }
                        else if (row < MV) o = out + (bj ? O_SCV : O_SCK) + (size_t)(row - MP) * 128 + col;
                    } else if (bj == 0) {
                        *(u32x4*)(VS + (size_t)row * 128 + col) = pack8(v);
                        if (row < MP) o = out + O_PSV + (size_t)row * 128 + col; else if (row < MV) o = out + O_SSV + (size_t)(row - MP) * 128 + col;
                    } else {
                        *(u32x4*)(VW + (size_t)row * 128 + col) = pack8(v);
                        const int t = row & 2047;
                        if (row < MP) { if (t >= 1536) o = out + O_PWV + ((size_t)(row >> 11) * 512 + (t - 1536)) * 128 + col; }
                        else if (row < MV) o = out + O_SWV + ((size_t)(row - MP) * 512 + 511) * 128 + col;
                    }
                    if (o) { *(f32x4*)o = (f32x4){v[0], v[1], v[2], v[3]}; *(f32x4*)(o + 4) = (f32x4){v[4], v[5], v[6], v[7]}; }
                }
            )
        } else if (SET == 0) {
            const int isk = (pn >= 7) ? 1 : 0, head = ((pn - 5) & 1) * 2 + (wc >> 1), j0 = 32 * (wc & 1) + c8;
            bf16_t* dst = isk ? RK : RQ; const float post = isk ? 0.08838834764831845f : 1.f;
            EPI_ROWS(
                const float s1 = ss1[row] * post; const int pidx = row < MP ? (row & 2047) : 2048;
                const float* rp = rot + ((size_t)pidx * 64 + j0) * 2;
                float y1[8], y2[8];
                _Pragma("unroll") for (int e2 = 0; e2 < 4; ++e2) { const f32x4 cs = *(const f32x4*)(rp + 4 * e2);
                    _Pragma("unroll") for (int t = 0; t < 2; ++t) { const int e = 2 * e2 + t; const float x1 = acc[ai][0][m][e >> 2][e & 3] * s1, x2 = acc[ai][1][m][e >> 2][e & 3] * s1, c = cs[2 * t], s = cs[2 * t + 1];
                        y1[e] = x1 * c - x2 * s; y2[e] = x1 * s + x2 * c; } }
                *(u32x4*)(dst + (size_t)row * 512 + head * 128 + j0) = pack8(y1);
                *(u32x4*)(dst + (size_t)row * 512 + head * 128 + 64 + j0) = pack8(y2);
            )
        } else if (SET == 1 && pn <= 12) {
            const int isg = pn >= 11; bf16_t* dst = isg ? RG : RV; const int cb = ((pn - 9) & 1) * 256;
            EPI_ROWS(
                const float s1 = ss1[row];
                _Pragma("unroll") for (int bj = 0; bj < 2; ++bj) { float v[8];
                    _Pragma("unroll") for (int e = 0; e < 8; ++e) { const float x = acc[ai][bj][m][e >> 2][e & 3] * s1; v[e] = isg ? siluf_(x) : x; }
                    *(u32x4*)(dst + (size_t)row * 512 + cb + 128 * bj + 32 * wc + c8) = pack8(v); }
            )
        } else if (SET == 1) {
            if (wc == 0 && fq < 3) {
                EPI_ROWS(
                    const float s1 = ss1[row]; float v[8];
                    _Pragma("unroll") for (int e = 0; e < 8; ++e) v[e] = sigmoidf_(acc[ai][0][m][e >> 2][e & 3] * s1);
                    float* o = GATE + (size_t)row * 24 + c8;
                    *(f32x4*)o = (f32x4){v[0], v[1], v[2], v[3]}; *(f32x4*)(o + 4) = (f32x4){v[4], v[5], v[6], v[7]};
                )
            }
        }
    }
};

struct SubsetOrder : pg8::StaticOrder {
    int set;
    __device__ __forceinline__ bool next(int i, pg8::Unit& u) const { if (!pg8::StaticOrder::next(i, u)) return false; const int k = u.pn;
        u.pn = set == 0 ? (k < 2 ? k : (k == 2 ? 3 : k + 2)) : (k == 0 ? 2 : (k == 1 ? 4 : k + 7)); return true; }
};
struct EpiF32 {
    static constexpr bool PERM = true;
    float* C; int ld;
    __device__ __forceinline__ void operator()(const Acc& acc, const pg8::Unit& u, int wr, int wc, int fr, int fq) const {
        EPI_ROWS(
            _Pragma("unroll") for (int bj = 0; bj < 2; ++bj) { float* o = C + (size_t)row * ld + u.pn * 256 + 128 * bj + 32 * wc + 8 * fq;
                *(f32x4*)o = acc[ai][bj][m][0]; *(f32x4*)(o + 4) = acc[ai][bj][m][1]; }
        )
    }
};
struct EpiCmp {
    static constexpr bool PERM = true;
    float* C;
    __device__ __forceinline__ void operator()(const Acc& acc, const pg8::Unit& u, int wr, int wc, int fr, int fq) const {
        EPI_ROWS(
            _Pragma("unroll") for (int bj = 0; bj < 2; ++bj) { float* o = C + (size_t)row * 256 + 128 * bj + 32 * wc + 8 * fq;
                *(f32x4*)o = acc[ai][bj][m][0]; *(f32x4*)(o + 4) = acc[ai][bj][m][1]; }
        )
    }
};
struct CmpOrder {
    int G, c;
    __device__ __forceinline__ bool next(int i, pg8::Unit& u) const { const int L = i * G + c; if (L >= 2 * (CROWS / 256)) return false; u.pm = L; u.pn = L / (CROWS / 256); return true; }
    __device__ __forceinline__ void a_ready(const pg8::Unit&) const {}
    __device__ __forceinline__ void done(const pg8::Unit&) const {}
};

struct EpiOut {
    static constexpr bool PERM = true;
    const float* xp; const float* xs; float* H; bf16_t* HB; float* SS2;
    __device__ __forceinline__ void operator()(const Acc& acc, const pg8::Unit& u, int wr, int wc, int fr, int fq) const {
        EPI_ROWS(
            float ss = 0.f;
            _Pragma("unroll") for (int bj = 0; bj < 2; ++bj) { const int col = u.pn * 256 + 128 * bj + 32 * wc + 8 * fq; float v[8];
                f32x4 x0 = (f32x4){0.f, 0.f, 0.f, 0.f}, x1 = x0;
                if (row < MV) { const float* xr = row < MP ? xp + (size_t)row * DM + col : xs + (size_t)(row - MP) * DM + col; x0 = *(const f32x4*)xr; x1 = *(const f32x4*)(xr + 4); }
                _Pragma("unroll") for (int e = 0; e < 4; ++e) { v[e] = acc[ai][bj][m][0][e] + x0[e]; v[4 + e] = acc[ai][bj][m][1][e] + x1[e]; }
                _Pragma("unroll") for (int e = 0; e < 8; ++e) ss += v[e] * v[e];
                float* o = H + (size_t)row * DM + col; *(f32x4*)o = (f32x4){v[0], v[1], v[2], v[3]}; *(f32x4*)(o + 4) = (f32x4){v[4], v[5], v[6], v[7]};
                *(u32x4*)(HB + (size_t)row * DM + col) = pack8(v); }
            ss += __shfl_xor(ss, 16); ss += __shfl_xor(ss, 32);
            if (fq == 0 && row < MV) atomicAdd(SS2 + row, ss);
        )
    }
};
struct EpiGU {
    static constexpr bool PERM = true;
    const float* SS2; bf16_t* ACT;
    __device__ __forceinline__ void operator()(const Acc& acc, const pg8::Unit& u, int wr, int wc, int fr, int fq) const {
        EPI_ROWS(
            const float s2 = rsqrtf(SS2[row] * (1.f / 1024.f) + EPS); float v[8];
            _Pragma("unroll") for (int e = 0; e < 8; ++e) { const float gt = acc[ai][0][m][e >> 2][e & 3] * s2, up = acc[ai][1][m][e >> 2][e & 3] * s2; v[e] = siluf_(gt) * up; }
            *(u32x4*)(ACT + (size_t)row * DFF + u.pn * 128 + 32 * wc + 8 * fq) = pack8(v);
        )
    }
};
struct EpiDown {
    static constexpr bool PERM = true;
    const float* H; float* H2; bf16_t* H2B;
    __device__ __forceinline__ void operator()(const Acc& acc, const pg8::Unit& u, int wr, int wc, int fr, int fq) const {
        EPI_ROWS(
            _Pragma("unroll") for (int bj = 0; bj < 2; ++bj) { const size_t off = (size_t)row * DM + u.pn * 256 + 128 * bj + 32 * wc + 8 * fq; float v[8];
                const f32x4 h0 = *(const f32x4*)(H + off), h1 = *(const f32x4*)(H + off + 4);
                _Pragma("unroll") for (int e = 0; e < 4; ++e) { v[e] = acc[ai][bj][m][0][e] + h0[e]; v[4 + e] = acc[ai][bj][m][1][e] + h1[e]; }
                *(f32x4*)(H2 + off) = (f32x4){v[0], v[1], v[2], v[3]}; *(f32x4*)(H2 + off + 4) = (f32x4){v[4], v[5], v[6], v[7]};
                *(u32x4*)(H2B + off) = pack8(v); }
        )
    }
};
struct EpiFinal {
    static constexpr bool PERM = true;
    const float* H2; const float* VP; float* out;
    __device__ __forceinline__ void operator()(const Acc& acc, const pg8::Unit& u, int wr, int wc, int fr, int fq) const {
        EPI_ROWS(
            if (row < MV) {
                _Pragma("unroll") for (int bj = 0; bj < 2; ++bj) { const int col = u.pn * 256 + 128 * bj + 32 * wc + 8 * fq; const size_t off = (size_t)row * DM + col; float v[8];
                    const f32x4 h0 = *(const f32x4*)(H2 + off), h1 = *(const f32x4*)(H2 + off + 4), p0 = *(const f32x4*)(VP + off), p1 = *(const f32x4*)(VP + off + 4);
                    _Pragma("unroll") for (int e = 0; e < 4; ++e) { v[e] = h0[e] + sigmoidf_(acc[ai][bj][m][0][e]) * p0[e]; v[4 + e] = h1[e] + sigmoidf_(acc[ai][bj][m][1][e]) * p1[e]; }
                    float* o = row < MP ? out + O_YP + off : out + O_YS + (size_t)(row - MP) * DM + col;
                    *(f32x4*)o = (f32x4){v[0], v[1], v[2], v[3]}; *(f32x4*)(o + 4) = (f32x4){v[4], v[5], v[6], v[7]}; }
            }
        )
    }
};

__device__ __forceinline__ int rel_bucket(int dist) {
    const int n = dist < 0 ? 0 : dist;
    if (n < 16) return n;
    const int large = 16 + (int)(logf((float)n / 16.f) / 2.0794415416798357f * 16.f);
    return large < 31 ? large : 31;
}
struct WSrc { const float* src; int ld, vt; const float* ks; };
__device__ __forceinline__ WSrc wsrc(const Params& p, int wid, int n0) {
    WSrc w; w.vt = 32; w.ks = nullptr;
    if (wid == 0) {
        const int tile = n0 >> 8, c = n0 & 255, bj = c >> 7, wc = (c >> 5) & 3; int col;
        if (tile < 2) col = (tile * 4 + wc) * 64 + 32 * bj;
        else if (tile == 2) col = 512 + c;
        else if (tile == 3) col = (wc < 2 ? 768 : 1024) + (wc & 1) * 64 + 32 * bj;
        else if (tile == 4) col = (bj ? 1152 : 896) + (c & 127);
        else if (tile <= 8) col = (tile >= 7 ? 1816 : 1304) + ((((tile - 5) & 1) * 2 + (wc >> 1)) * 128) + 64 * bj + 32 * (wc & 1);
        else if (tile <= 10) col = 2328 + (tile - 9) * 256 + c;
        else if (tile <= 12) col = 2840 + (tile - 11) * 256 + c;
        else { col = 1280; w.vt = (c == 0) ? 24 : 0; }
        w.src = p.in[13] + col; w.ld = INC; w.ks = p.in[12];
    } else if (wid == 1) { w.src = p.in[23] + n0; w.ld = DM; }
    else if (wid == 2) { const int pn = n0 >> 8, bj = (n0 >> 7) & 1, c7 = n0 & 127; w.src = (bj ? p.in[26] : p.in[25]) + pn * 128 + c7; w.ld = DFF; w.ks = p.in[24]; }
    else if (wid == 3) { w.src = p.in[27] + n0; w.ld = DM; }
    else if (wid == 4) { w.src = p.in[28] + n0; w.ld = DM; }
    else if (wid == 5) { w.src = p.in[29] + n0; w.ld = DM; }
    else if (wid == 6 || wid == 7) { const int j = n0 >> 7, h0 = n0 & 127; w.src = p.in[wid == 6 ? 17 : 20] + (size_t)j * 1024 * 128 + h0; w.ld = 128; }
    else { w.src = p.in[wid == 8 ? 18 : 21] + n0; w.ld = 64; }
    return w;
}
__device__ __forceinline__ void phase_prologue(const Params& p, unsigned char* lds) {
    const int tid = threadIdx.x, lane = tid & 63, wid = tid >> 6, G = gridDim.x, bid = blockIdx.x;
    unsigned char* ws = p.ws;
    {
        const int tn[10] = {112, 32, 176, 32, 32, 32, 8, 8, 2, 2}, tk[10] = {16, 16, 16, 44, 16, 4, 16, 16, 2, 2};
        const size_t dsto[10] = {WS_W1, WS_WO, WS_WGU, WS_WD, WS_WPG, WS_WPP, WS_W1C, WS_W1C + (size_t)256 * 1024 * 2, WS_W2C, WS_W2C + (size_t)64 * 128 * 2};
        int total = 0;
#pragma unroll
        for (int i = 0; i < 10; ++i) total += tn[i] * tk[i];
        float* tl = (float*)lds;
        int total4 = 0;
#pragma unroll
        for (int i = 0; i < 10; ++i) total4 += ((tn[i] + 3) / 4) * tk[i];
        for (int t = bid; t < total4; t += G) {
            int wsel = 0, rem = t;
#pragma unroll
            for (int i = 0; i < 9; ++i) { const int cnt = ((tn[i] + 3) / 4) * tk[i]; if (wsel == i && rem >= cnt) { rem -= cnt; wsel = i + 1; } }
            int tkk = 16, tnn = 4; size_t doff = 0;
#pragma unroll
            for (int i = 0; i < 10; ++i) if (wsel == i) { tkk = tk[i]; tnn = tn[i]; doff = dsto[i]; }
            const int K = tkk * 64;
            const int n0 = (rem / tkk) * 128, k0 = (rem % tkk) * 64;
            const int nch = (tnn - n0 / 32) < 4 ? (tnn - n0 / 32) : 4;
            float v[4][4];
#pragma unroll
            for (int ch = 0; ch < 4; ++ch) { if (ch < nch) { const WSrc w = wsrc(p, wsel, n0 + 32 * ch);
#pragma unroll
                for (int it = 0; it < 4; ++it) { const int kk = it * 16 + (tid >> 5), tt = tid & 31; float x = 0.f;
                    if (tt < w.vt) { x = w.src[(size_t)(k0 + kk) * w.ld + tt]; if (w.ks) x *= w.ks[k0 + kk]; }
                    v[ch][it] = x; } } }
#pragma unroll
            for (int ch = 0; ch < 4; ++ch) if (ch < nch) {
#pragma unroll
                for (int it = 0; it < 4; ++it) tl[ch * 2112 + (it * 16 + (tid >> 5)) * 33 + (tid & 31)] = v[ch][it]; }
            __syncthreads();
#pragma unroll
            for (int ch = 0; ch < 4; ++ch) if (ch < nch) { const int nt = tid >> 4, kq = (tid & 15) * 4; const float* tc = tl + ch * 2112;
              u32x2 o; o.x = pk2(tc[(kq + 0) * 33 + nt], tc[(kq + 1) * 33 + nt]); o.y = pk2(tc[(kq + 2) * 33 + nt], tc[(kq + 3) * 33 + nt]);
              *(u32x2*)((bf16_t*)(ws + doff) + (size_t)(n0 + 32 * ch + nt) * K + k0 + kq) = o; }
            __syncthreads();
        }
    }
    {
        bf16_t* XB = (bf16_t*)(ws + WS_XB); float* SS1 = (float*)(ws + WS_SS1); bf16_t* PB = (bf16_t*)(ws + WS_PB);
        for (int row = bid * 8 + wid; row < MR; row += G * 8) {
            const float* xr = row < MP ? p.in[0] + (size_t)row * DM : p.in[1] + (size_t)(row - MP) * DM;
            const float* pr = row < MP ? p.in[10] + (size_t)row * PLE : p.in[11] + (size_t)(row - MP) * PLE;
            f32x4 v[4]; float ss = 0.f;
#pragma unroll
            for (int i = 0; i < 4; ++i) { v[i] = row < MV ? *(const f32x4*)(xr + i * 256 + lane * 4) : (f32x4){0.f, 0.f, 0.f, 0.f}; ss += v[i][0] * v[i][0] + v[i][1] * v[i][1] + v[i][2] * v[i][2] + v[i][3] * v[i][3]; }
#pragma unroll
            for (int o = 1; o < 64; o <<= 1) ss += __shfl_xor(ss, o);
#pragma unroll
            for (int i = 0; i < 4; ++i) { u32x2 o; o.x = pk2(v[i][0], v[i][1]); o.y = pk2(v[i][2], v[i][3]); *(u32x2*)(XB + (size_t)row * DM + i * 256 + lane * 4) = o; }
            if (lane == 0) SS1[row] = rsqrtf(ss * (1.f / 1024.f) + EPS);
            const f32x4 pv = row < MV ? *(const f32x4*)(pr + lane * 4) : (f32x4){0.f, 0.f, 0.f, 0.f};
            u32x2 o; o.x = pk2(pv[0], pv[1]); o.y = pk2(pv[2], pv[3]); *(u32x2*)(PB + (size_t)row * PLE + lane * 4) = o;
        }
    }
    const int gtid = bid * 512 + tid, gsz = G * 512;
    {
        float* rot = (float*)(ws + WS_ROT);
        for (int idx = gtid; idx < 2049 * 64; idx += gsz) { const int pidx = idx >> 6, j = idx & 63; const float pos = pidx < 2048 ? (float)pidx : 16384.f;
            const float inv = powf(10000.f, -(float)j / 64.f); const float ang = pos * inv; const double a = (double)ang;
            rot[(size_t)idx * 2] = (float)cos(a); rot[(size_t)idx * 2 + 1] = (float)sin(a); }
        float* btab = (float*)(ws + WS_BTAB);
        for (int idx = gtid; idx < 8 * 128; idx += gsz) { const int head = idx >> 7, dist = idx & 127; btab[idx] = p.in[30][rel_bucket(dist) * 8 + head] * LOG2E; }
        float* SS2 = (float*)(ws + WS_SS2);
        for (int idx = gtid; idx < MR; idx += gsz) SS2[idx] = 0.f;
        float* bc = (float*)(ws + WS_BIASP);
        for (int it = bid; it < 32; it += G) if (tid < 256) { const int c = tid >> 7, h = tid & 127; const float* pe = p.in[c ? 19 : 16]; const float* w1 = p.in[c ? 20 : 17]; float a = 0.f;
#pragma unroll 8
            for (int k = it * 64; k < it * 64 + 64; ++k) a += pe[k] * w1[(size_t)k * 128 + h];
            bc[it * 256 + tid] = a; }
    }
    {
        const int total = 2 * DB * 511 * 32;
        for (int idx = gtid; idx < total; idx += gsz) { const int c4 = (idx & 31) * 4; int r = idx >> 5; const int j = r % 511; r /= 511; const int b = r & 31, c = r >> 5;
            const f32x4 v = *(const f32x4*)(p.in[6 + c] + ((size_t)b * 512 + j + 1) * 128 + c4);
            *(f32x4*)(p.out + (c ? O_SWV : O_SWK) + ((size_t)b * 512 + j) * 128 + c4) = v; }
    }
}

__device__ __forceinline__ s16x4 tr16(const unsigned char* p) { typedef short v4i16_t __attribute__((ext_vector_type(4))); return __builtin_bit_cast(s16x4, __builtin_amdgcn_ds_read_tr16_b64_v4i16((LAS v4i16_t*)p)); }
__device__ __forceinline__ bf16x8 cat8(s16x4 lo, s16x4 hi) { return (bf16x8){lo[0], lo[1], lo[2], lo[3], hi[0], hi[1], hi[2], hi[3]}; }
constexpr int RSTR = 272;
__device__ __forceinline__ float ret_lgam(int h) { return log2f(1.f - exp2f(-5.f - (float)h)); }
__device__ __forceinline__ bf16x8 tr_frag(const unsigned char* tile, int row0, int cb, int lane) {
    const int hi = lane >> 5;
    const unsigned char* a = tile + (size_t)(row0 + 4 * hi + ((lane & 15) >> 2)) * RSTR + (cb * 32 + 16 * ((lane >> 4) & 1) + 4 * (lane & 3)) * 2;
    return cat8(tr16(a), tr16(a + 8 * RSTR));
}
__device__ __forceinline__ void stage128(unsigned char* dst, const bf16_t* src, int tid, bool decay, float lg) {
    const int r = tid >> 2, q4 = tid & 3;
    float sc = decay ? exp2f((float)(127 - r) * lg) : 1.f;
#pragma unroll
    for (int i = 0; i < 4; ++i) { const int col = q4 * 32 + i * 8; u32x4 v = *(const u32x4*)(src + (size_t)r * 512 + col);
        if (decay) { v.x = pk2(bflo(v.x) * sc, bfhi(v.x) * sc); v.y = pk2(bflo(v.y) * sc, bfhi(v.y) * sc); v.z = pk2(bflo(v.z) * sc, bfhi(v.z) * sc); v.w = pk2(bflo(v.w) * sc, bfhi(v.w) * sc); }
        *(u32x4*)(dst + (size_t)r * RSTR + col * 2) = v; }
}
__device__ __forceinline__ void ret_r1_unit(const Params& p, unsigned char* lds, int b, int h, int c) {
    const int tid = threadIdx.x, lane = tid & 63, w = __builtin_amdgcn_readfirstlane(tid >> 6), r32 = lane & 31, hi = lane >> 5;
    const size_t row0 = (size_t)b * SEQ + c * 128;
    const float lg = ret_lgam(h);
    unsigned char* Kt = lds; unsigned char* Vt = lds + 128 * RSTR;
    stage128(Kt, (const bf16_t*)(p.ws + WS_RK) + row0 * 512 + h * 128, tid, true, lg);
    stage128(Vt, (const bf16_t*)(p.ws + WS_RV) + row0 * 512 + h * 128, tid, false, 0.f);
    __syncthreads();
    const int eb = w & 3, dp = w >> 2;
    f32x16 acc[2]; acc[0] = f32x16{}; acc[1] = f32x16{};
#pragma unroll
    for (int s = 0; s < 8; ++s) {
        const bf16x8 vf = tr_frag(Vt, 16 * s, eb, lane);
#pragma unroll
        for (int di = 0; di < 2; ++di) { const bf16x8 kf = tr_frag(Kt, 16 * s, 2 * dp + di, lane); acc[di] = __builtin_amdgcn_mfma_f32_32x32x16_bf16(vf, kf, acc[di], 0, 0, 0); }
    }
    float* KVT = (float*)(p.ws + WS_KVT) + ((size_t)((b * 4 + h) * 16 + c)) * 16384;
#pragma unroll
    for (int di = 0; di < 2; ++di)
#pragma unroll
        for (int r = 0; r < 16; ++r) KVT[(size_t)(32 * eb + crow(r, hi)) * 128 + 32 * (2 * dp + di) + r32] = acc[di][r];
    __syncthreads();
}
__device__ __forceinline__ void ret_r2_unit(const Params& p, unsigned char* lds, int b, int h, int c) {
    const int tid = threadIdx.x, lane = tid & 63, w = __builtin_amdgcn_readfirstlane(tid >> 6), r32 = lane & 31, hi = lane >> 5;
    const size_t row0 = (size_t)b * SEQ + c * 128;
    const float lg = ret_lgam(h);
    unsigned char* Qt = lds; unsigned char* Kt = lds + 128 * RSTR; unsigned char* Vt = lds + 2 * 128 * RSTR; float* st = (float*)(lds + 3 * 128 * RSTR);
    stage128(Qt, (const bf16_t*)(p.ws + WS_RQ) + row0 * 512 + h * 128, tid, false, 0.f);
    stage128(Kt, (const bf16_t*)(p.ws + WS_RK) + row0 * 512 + h * 128, tid, false, 0.f);
    stage128(Vt, (const bf16_t*)(p.ws + WS_RV) + row0 * 512 + h * 128, tid, false, 0.f);
    __syncthreads();
    const int eb = w & 3, ps = w >> 2;
    bf16x8 sf[8];
    if (c > 0) {
        const float* KV0 = (const float*)(p.ws + WS_KVT) + ((size_t)((b * 4 + h) * 16)) * 16384 + (size_t)(32 * eb + r32) * 128 + 8 * hi;
#pragma unroll
        for (int s = 0; s < 8; ++s) {
            float a[8];
#pragma unroll
            for (int e = 0; e < 8; ++e) a[e] = 0.f;
            for (int j = 0; j < c; ++j) { const float wj = exp2f(128.f * (float)(c - 1 - j) * lg); const float* src = KV0 + (size_t)j * 16384 + 16 * s;
                const f32x4 x0 = *(const f32x4*)src, x1 = *(const f32x4*)(src + 4);
#pragma unroll
                for (int e = 0; e < 4; ++e) { a[e] += wj * x0[e]; a[4 + e] += wj * x1[e]; } }
            const u32x4 pk = pack8(a); sf[s] = __builtin_bit_cast(bf16x8, pk);
        }
    }
    f32x16 accs[2];
#pragma unroll
    for (int ni = 0; ni < 2; ++ni) {
        const int nb = ps ? (1 + ni) : (ni ? 3 : 0);
        const int n = 32 * nb + r32;
        bf16x8 qf[8];
#pragma unroll
        for (int s = 0; s < 8; ++s) qf[s] = *(const bf16x8*)(Qt + (size_t)n * RSTR + (16 * s + 8 * hi) * 2);
        f32x16 acc = f32x16{};
        if (c > 0) {
#pragma unroll
            for (int s = 0; s < 8; ++s) acc = __builtin_amdgcn_mfma_f32_32x32x16_bf16(sf[s], qf[s], acc, 0, 0, 0);
            const float dn = exp2f((float)(n + 1) * lg);
#pragma unroll
            for (int r = 0; r < 16; ++r) acc[r] *= dn;
        }
        for (int mb = 0; mb <= nb; ++mb) {
            f32x16 x = f32x16{};
#pragma unroll
            for (int s = 0; s < 8; ++s) { const bf16x8 kf = *(const bf16x8*)(Kt + (size_t)(32 * mb + r32) * RSTR + (16 * s + 8 * hi) * 2); x = __builtin_amdgcn_mfma_f32_32x32x16_bf16(kf, qf[s], x, 0, 0, 0); }
            float pv[16];
#pragma unroll
            for (int r = 0; r < 16; ++r) { const int dm = n - (32 * mb + crow(r, hi)); pv[r] = dm >= 0 ? x[r] * exp2f((float)dm * lg) : 0.f; }
#pragma unroll
            for (int s2 = 0; s2 < 2; ++s2) { const u32x4 pk = pack8(pv + 8 * s2); const bf16x8 vf = tr_frag(Vt, 32 * mb + 16 * s2, eb, lane);
                acc = __builtin_amdgcn_mfma_f32_32x32x16_bf16(vf, __builtin_bit_cast(bf16x8, pk), acc, 0, 0, 0); }
        }
        float s1 = 0.f, s2 = 0.f;
#pragma unroll
        for (int r = 0; r < 16; ++r) { s1 += acc[r]; s2 += acc[r] * acc[r]; }
        s1 = xhalf_sum(s1); s2 = xhalf_sum(s2);
        if (hi == 0) { st[(eb * 128 + n) * 2] = s1; st[(eb * 128 + n) * 2 + 1] = s2; }
        accs[ni] = acc;
    }
    __syncthreads();
    const float* gn = p.in[22] + h * 128; const bf16_t* RG = (const bf16_t*)(p.ws + WS_RG); bf16_t* AO = (bf16_t*)(p.ws + WS_AO);
#pragma unroll
    for (int ni = 0; ni < 2; ++ni) {
        const int nb = ps ? (1 + ni) : (ni ? 3 : 0); const int n = 32 * nb + r32;
        float s1 = 0.f, s2 = 0.f;
#pragma unroll
        for (int q = 0; q < 4; ++q) { s1 += st[(q * 128 + n) * 2]; s2 += st[(q * 128 + n) * 2 + 1]; }
        const float mu = s1 * (1.f / 128.f), var = s2 * (1.f / 128.f) - mu * mu, rs = rsqrtf(var + EPS);
        const size_t row = row0 + n;
#pragma unroll
        for (int a = 0; a < 4; ++a) { const int e0 = 32 * eb + 8 * a + 4 * hi;
            const f32x4 gw = *(const f32x4*)(gn + e0); const u32x2 gg = *(const u32x2*)(RG + row * 512 + h * 128 + e0);
            const float g0 = bflo(gg.x), g1 = bfhi(gg.x), g2 = bflo(gg.y), g3 = bfhi(gg.y);
            u32x2 o; o.x = pk2((accs[ni][4 * a] - mu) * rs * gw[0] * g0, (accs[ni][4 * a + 1] - mu) * rs * gw[1] * g1);
            o.y = pk2((accs[ni][4 * a + 2] - mu) * rs * gw[2] * g2, (accs[ni][4 * a + 3] - mu) * rs * gw[3] * g3);
            *(u32x2*)(AO + row * 1024 + 512 + h * 128 + e0) = o; }
    }
    __syncthreads();
}
__device__ __forceinline__ void ret_sample_unit(const Params& p, unsigned char* lds, int b, int h) {
    const int tid = threadIdx.x;
    float* qv = (float*)lds; float* kv = qv + 128; float* vv = kv + 128; float* part = vv + 128; float* red = part + 512;
    const size_t row = (size_t)MP + b;
    if (tid < 384) { const int which = tid >> 7, d = tid & 127; const bf16_t* src = (const bf16_t*)(p.ws + (which == 0 ? WS_RQ : which == 1 ? WS_RK : WS_RV)) + row * 512 + h * 128 + d; qv[tid] = bf1(*src); }
    __syncthreads();
    const float gam = 1.f - exp2f(-5.f - (float)h);
    const int dq = tid >> 7, e = tid & 127;
    const float* st = p.in[8] + ((size_t)(b * 4 + h)) * 16384; float* so = p.out + O_SRET + ((size_t)(b * 4 + h)) * 16384;
    float acc = 0.f, qk = 0.f; const float ve = vv[e];
#pragma unroll 4
    for (int i = 0; i < 32; ++i) { const int d = dq + 4 * i; const float s = st[d * 128 + e]; acc += qv[d] * s; so[d * 128 + e] = gam * s + kv[d] * ve; }
#pragma unroll 4
    for (int d = 0; d < 128; ++d) qk += qv[d] * kv[d];
    part[dq * 128 + e] = acc;
    __syncthreads();
    float o = 0.f;
    if (tid < 128) { o = qk * ve + gam * (part[e] + part[128 + e] + part[256 + e] + part[384 + e]); }
    float s1 = tid < 128 ? o : 0.f, s2 = tid < 128 ? o * o : 0.f;
#pragma unroll
    for (int of = 1; of < 64; of <<= 1) { s1 += __shfl_xor(s1, of); s2 += __shfl_xor(s2, of); }
    if ((tid & 63) == 0 && tid < 128) { red[(tid >> 6) * 2] = s1; red[(tid >> 6) * 2 + 1] = s2; }
    __syncthreads();
    if (tid < 128) { const float t1 = red[0] + red[2], t2 = red[1] + red[3]; const float mu = t1 * (1.f / 128.f), var = t2 * (1.f / 128.f) - mu * mu, rs = rsqrtf(var + EPS);
        const float g = bf1(((const bf16_t*)(p.ws + WS_RG))[row * 512 + h * 128 + e]);
        const unsigned pk = pk2((o - mu) * rs * p.in[22][h * 128 + e] * g, 0.f);
        ((bf16_t*)(p.ws + WS_AO))[row * 1024 + 512 + h * 128 + e] = (bf16_t)(pk & 0xffffu); }
    __syncthreads();
}

__device__ __forceinline__ void compress2_task(const Params& p, int c, int task, int lane) {
    const int r32 = lane & 31, hi = lane >> 5;
    const int R = task * 32 + r32;
    const float* P0 = (const float*)(p.ws + WS_CP) + ((size_t)c * CROWS + R) * 256;
    const int R2 = (R + 2 < CROWS) ? R + 2 : CROWS - 1;
    const float* P1 = (const float*)(p.ws + WS_CP) + ((size_t)c * CROWS + R2) * 256 + 128;
    const float* bc = (const float*)(p.ws + WS_BIASC) + c * 128;
    const bf16_t* W2 = (const bf16_t*)(p.ws + WS_W2C) + (size_t)c * 64 * 128;
    f32x16 acc[2]; acc[0] = f32x16{}; acc[1] = f32x16{};
#pragma unroll
    for (int s = 0; s < 8; ++s) {
        const int k0 = 16 * s + 8 * hi; float hv[8];
#pragma unroll
        for (int q = 0; q < 2; ++q) { const f32x4 a = *(const f32x4*)(P0 + k0 + 4 * q), b = *(const f32x4*)(P1 + k0 + 4 * q), bb = *(const f32x4*)(bc + k0 + 4 * q);
#pragma unroll
            for (int e = 0; e < 4; ++e) hv[4 * q + e] = siluf_(a[e] + b[e] + bb[e]); }
        const u32x4 pk = pack8(hv); const bf16x8 hf = __builtin_bit_cast(bf16x8, pk);
#pragma unroll
        for (int eb = 0; eb < 2; ++eb) { const bf16x8 wf = *(const bf16x8*)(W2 + (size_t)(32 * eb + r32) * 128 + k0); acc[eb] = __builtin_amdgcn_mfma_f32_32x32x16_bf16(wf, hf, acc[eb], 0, 0, 0); }
    }
    float rs = 1.f;
    if (c == 0) { float ss = 0.f;
#pragma unroll
        for (int eb = 0; eb < 2; ++eb)
#pragma unroll
            for (int r = 0; r < 16; ++r) ss += acc[eb][r] * acc[eb][r];
        ss = xhalf_sum(ss); rs = rsqrtf(ss * (1.f / 64.f) + EPS); }
    bool valid; bf16_t* dst;
    if (R < CROWS_S) { valid = ((R >> 1) & 1023) < NC_S; dst = (bf16_t*)(p.ws + (c ? WS_CVCS : WS_CKCS)) + (size_t)R * 64; }
    else { const int Rp = R - CROWS_S; valid = ((Rp >> 1) & 127) < NC_P; dst = (bf16_t*)(p.ws + (c ? WS_CVCP : WS_CKCP)) + (size_t)Rp * 64; }
    if (valid) {
#pragma unroll
        for (int eb = 0; eb < 2; ++eb)
#pragma unroll
            for (int a = 0; a < 4; ++a) { const int e0 = 32 * eb + 8 * a + 4 * hi; float v[4];
#pragma unroll
                for (int e = 0; e < 4; ++e) { v[e] = acc[eb][4 * a + e] * rs; if (c == 0) v[e] *= p.in[15][e0 + e]; }
                u32x2 o; o.x = pk2(v[0], v[1]); o.y = pk2(v[2], v[3]); *(u32x2*)(dst + e0) = o; }
    }
}
__device__ __forceinline__ void pret_job(const Params& p) {
    const int gtid = blockIdx.x * 512 + threadIdx.x, gsz = gridDim.x * 512;
    for (int idx = gtid; idx < NB * 4 * 16384; idx += gsz) { const int d = idx & 127, e = (idx >> 7) & 127, bh = idx >> 14; const float lg = ret_lgam(bh & 3);
        const float* src = (const float*)(p.ws + WS_KVT) + (size_t)bh * 16 * 16384 + e * 128 + d; float a = 0.f;
#pragma unroll
        for (int j = 0; j < 16; ++j) a += exp2f(128.f * (float)(15 - j) * lg) * src[(size_t)j * 16384];
        p.out[O_PRET + (size_t)bh * 16384 + d * 128 + e] = a; }
}

constexpr int AT_K = 0, AT_V = 16384, AT_IMP = 32768, AT_IMPS = AT_IMP + 64 * 129 * 4, AT_MASK = AT_IMPS + 64 * 33 * 4, AT_BTAB = AT_MASK + 256, AT_END = AT_BTAB + 2048;
struct KVregs { u32x4 k, v; };
__device__ __forceinline__ KVregs kv_load(const bf16_t* Kg, const bf16_t* Vg, size_t rowbase, int rmax, int ld, int colg, int tid) {
    KVregs r; { int key = tid & 63; if (key > rmax) key = rmax; r.k = *(const u32x4*)(Kg + (rowbase + key) * ld + colg + (tid >> 6) * 8); }
    { int row = (tid >> 2) & 63; if (row > rmax) row = rmax; r.v = *(const u32x4*)(Vg + (rowbase + row) * ld + colg + (tid >> 8) * 32 + (tid & 3) * 8); }
    return r;
}
__device__ __forceinline__ void kv_store(unsigned char* Kb, unsigned char* Vb, const KVregs& r, int tid) {
    *(u32x4*)(Kb + (tid >> 6) * 1024 + (tid & 63) * 16) = r.k;
    *(u32x4*)(Vb + (tid >> 8) * 4096 + ((tid >> 2) & 63) * 64 + (tid & 3) * 16) = r.v;
}
__device__ __forceinline__ f32x16 qk_sub(const unsigned char* Kb, const bf16x8* qr, int sub, int r32, int hi) {
    f32x16 s = f32x16{};
#pragma unroll
    for (int d0 = 0; d0 < 4; ++d0) { const bf16x8 kf = *(const bf16x8*)(Kb + d0 * 2048 + hi * 1024 + (sub * 32 + r32) * 16); s = __builtin_amdgcn_mfma_f32_32x32x16_bf16(kf, qr[d0], s, 0, 0, 0); }
    return s;
}
__device__ __forceinline__ void pv_sub(f32x16* o, const unsigned char* Vb, const float* pv, int sub, int lane) {
    const int hi = lane >> 5;
    const unsigned char* vb = Vb + ((lane >> 4) & 1) * 32 + (lane & 3) * 8 + (4 * hi + ((lane & 15) >> 2)) * 64;
#pragma unroll
    for (int s2 = 0; s2 < 2; ++s2) { const u32x4 pk = pack8(pv + 8 * s2); const bf16x8 pf = __builtin_bit_cast(bf16x8, pk);
#pragma unroll
        for (int eb = 0; eb < 2; ++eb) { const unsigned char* a = vb + eb * 4096 + (2 * sub + s2) * 1024; const bf16x8 vf = cat8(tr16(a), tr16(a + 512));
            o[eb] = __builtin_amdgcn_mfma_f32_32x32x16_bf16(vf, pf, o[eb], 0, 0, 0); } }
}
constexpr float NEGBIG = -3.0e38f;
__device__ __forceinline__ int imed3(int d) { return min(max(d, 0), 127); }
__device__ __forceinline__ float ex2(float x) { return __builtin_amdgcn_exp2f(x); }
template <int KIND>
__device__ __forceinline__ void attn_tile(const unsigned char* Kb, const unsigned char* Vb, const bf16x8* qr, const float* bt, int kp0, int qpos, bool lane_ok, float& m, float& l, f32x16* o, int lane) {
    const int r32 = lane & 31, hi = lane >> 5;
    const float c127 = bt[127];
    const float cl = lane_ok ? c127 : NEGBIG;
#pragma unroll 1
    for (int sub = 0; sub < 2; ++sub) {
        const int dist0 = qpos - kp0 - 32 * sub - 4 * hi;
        bool any;
        if (KIND == 0) any = lane_ok && dist0 >= 0; else if (KIND == 1) any = lane_ok; else any = (dist0 - 27) <= 511;
        if (__ballot(any) == 0ull) continue;
        f32x16 s = qk_sub(Kb, qr, sub, r32, hi);
        float mx = NEGBIG;
        if (KIND == 0) { const int lim = lane_ok ? 0 : 0x7fffffff;
#pragma unroll
            for (int r = 0; r < 16; ++r) { const int dist = dist0 - ((r & 3) + 8 * (r >> 2)); const int di = imed3(dist);
                const float bv = bt[di]; const float sv = dist >= lim ? s[r] + bv : NEGBIG; s[r] = sv; mx = fmaxf(mx, sv); } }
        else if (KIND == 1) {
#pragma unroll
            for (int r = 0; r < 16; ++r) { const float sv = s[r] + cl; s[r] = sv; mx = fmaxf(mx, sv); } }
        else {
#pragma unroll
            for (int r = 0; r < 16; ++r) { const int dist = dist0 - ((r & 3) + 8 * (r >> 2)); const float sv = dist <= 511 ? s[r] + c127 : NEGBIG; s[r] = sv; mx = fmaxf(mx, sv); } }
        mx = xhalf_max(mx);
        const float mn = fmaxf(m, mx), alpha = ex2(m - mn);
        float pv[16]; float ps = 0.f;
#pragma unroll
        for (int r = 0; r < 16; ++r) { pv[r] = ex2(s[r] - mn); ps += pv[r]; }
        l = l * alpha + ps; m = mn;
        if (__ballot(alpha != 1.f) != 0ull) {
#pragma unroll
            for (int r = 0; r < 16; ++r) { o[0][r] *= alpha; o[1][r] *= alpha; } }
        pv_sub(o, Vb, pv, sub, lane);
    }
}
__device__ __forceinline__ void attn_prompt_unit(const Params& p, unsigned char* lds, int b, int g, int i) {
    const int tid = threadIdx.x, lane = tid & 63, w = __builtin_amdgcn_readfirstlane(tid >> 6), r32 = lane & 31, hi = lane >> 5;
    const int hr = w >> 1, ql = (w & 1) * 32 + r32, qpos = 64 * i + ql, head = g * 4 + hr;
    const size_t row = (size_t)b * SEQ + qpos;
    float* imp = (float*)(lds + AT_IMP); float* imps = (float*)(lds + AT_IMPS); unsigned* mask = (unsigned*)(lds + AT_MASK); float* btab = (float*)(lds + AT_BTAB);
    const bf16_t* Qg = (const bf16_t*)(p.ws + WS_Q);
    for (int x = tid; x < 64 * 129; x += 512) imp[x] = 0.f;
    if (tid < 64) mask[tid] = (i < 16) ? 0xFFFFFFFFu : ((1u << 0) | (1u << i) | (1u << (i - 1)));
    btab[tid] = ((const float*)(p.ws + WS_BTAB))[(g * 4) * 128 + tid];
    bf16x8 qr[4];
#pragma unroll
    for (int d0 = 0; d0 < 4; ++d0) qr[d0] = *(const bf16x8*)(Qg + row * 512 + head * 64 + d0 * 16 + hi * 8);
    const float* gp = (const float*)(p.ws + WS_GATE) + row * 24 + head;
    const float g0 = gp[0], g1 = gp[8], g2 = gp[16];
    const float* bt = btab + hr * 128;
    f32x16 ot[2]; ot[0] = f32x16{}; ot[1] = f32x16{};
    unsigned char* Kb0 = lds + AT_K; unsigned char* Vb0 = lds + AT_V;
    {
        const bf16_t* CK = (const bf16_t*)(p.ws + WS_CKCP); const bf16_t* CV = (const bf16_t*)(p.ws + WS_CVCP);
#pragma unroll
        for (int t = 0; t < 2; ++t) { const KVregs kv = kv_load(CK, CV, (size_t)b * 128 + 64 * t, t ? 62 : 63, 128, g * 64, tid); kv_store(Kb0 + t * 8192, Vb0 + t * 8192, kv, tid); }
        __syncthreads();
        auto cmp_scores = [&](int t4) -> f32x16 {
            f32x16 sv = qk_sub(Kb0 + (t4 >> 1) * 8192, qr, t4 & 1, r32, hi);
#pragma unroll
            for (int r = 0; r < 16; ++r) { const int c = 32 * t4 + crow(r, hi); const int dist = qpos - (16 * c + 31); const int di = imed3(dist);
                const float bv = bt[di]; sv[r] = (dist >= 0 && c < NC_P) ? sv[r] + bv : NEGBIG; }
            return sv; };
        float mx = -1e30f;
#pragma unroll 1
        for (int t4 = 0; t4 < 4; ++t4) { const f32x16 sv = cmp_scores(t4);
#pragma unroll
            for (int r = 0; r < 16; ++r) mx = fmaxf(mx, sv[r]); }
        mx = xhalf_max(mx);
        float ps = 0.f;
#pragma unroll 1
        for (int t4 = 0; t4 < 4; ++t4) { const f32x16 sv = cmp_scores(t4);
#pragma unroll
            for (int r = 0; r < 16; ++r) ps += ex2(sv[r] - mx); }
        ps = xhalf_sum(ps);
        const float inv = ps > 0.f ? 1.f / ps : 0.f;
#pragma unroll 1
        for (int t4 = 0; t4 < 4; ++t4) { const f32x16 sv = cmp_scores(t4);
            float pv[16];
#pragma unroll
            for (int r = 0; r < 16; ++r) { const float pn = ex2(sv[r] - mx) * inv; if (i >= 16 && pn > 0.f) atomicAdd(&imp[ql * 129 + 32 * t4 + crow(r, hi)], pn); pv[r] = pn * g0; }
            pv_sub(ot, Vb0 + (t4 >> 1) * 8192, pv, t4 & 1, lane);
        }
    }
    __syncthreads();
    if (i >= 16) {
        const int q = tid >> 3, jj = tid & 7, jmax = i - 2;
        for (int j = 1 + jj; j <= jmax; j += 8) { const float* ip = imp + q * 129 + 4 * j;
            imps[q * 33 + j] = 0.5f * ip[-1] + ip[0] + ip[1] + ip[2] + 0.5f * ip[3]; }
        __syncthreads();
        for (int j = 1 + jj; j <= jmax; j += 8) { const float vj = imps[q * 33 + j]; int cnt = 0;
            for (int k = 1; k <= jmax; ++k) { const float vk = imps[q * 33 + k]; cnt += (vk > vj || (vk == vj && k < j)) ? 1 : 0; }
            if (cnt < 13) atomicOr(&mask[q], 1u << j); }
        __syncthreads();
    }
    const unsigned selm = mask[ql];
    {
        const bf16_t* KSg = (const bf16_t*)(p.ws + WS_KS); const bf16_t* VSg = (const bf16_t*)(p.ws + WS_VS);
        const bf16_t* KWg = (const bf16_t*)(p.ws + WS_KW); const bf16_t* VWg = (const bf16_t*)(p.ws + WS_VW);
        const int nts = i + 1, t0w = i > 8 ? i - 8 : 0, NT = nts + (i - t0w + 1);
        float m = -1e30f, l = 0.f; f32x16 o[2]; o[0] = f32x16{}; o[1] = f32x16{};
        { const KVregs kv = kv_load(KSg, VSg, (size_t)b * SEQ, 63, 128, g * 64, tid); kv_store(Kb0, Vb0, kv, tid); }
#pragma unroll 1
        for (int t = 0; t < NT; ++t) {
            __syncthreads();
            KVregs nx; const bool more = t + 1 < NT;
            if (more) { const int tn = t + 1; const bool wn = tn >= nts; const int jn = wn ? t0w + tn - nts : tn;
                nx = kv_load(wn ? KWg : KSg, wn ? VWg : VSg, (size_t)b * SEQ + 64 * jn, 63, 128, g * 64, tid); }
            const bool isw = t >= nts; const int j = isw ? t0w + t - nts : t;
            if (t == nts) { l = xhalf_sum(l); const float sc = l > 0.f ? g1 / l : 0.f;
#pragma unroll
                for (int r = 0; r < 16; ++r) { ot[0][r] += sc * o[0][r]; ot[1][r] += sc * o[1][r]; o[0][r] = 0.f; o[1][r] = 0.f; }
                m = -1e30f; l = 0.f; }
            { const unsigned char* Kt_ = Kb0 + (t & 1) * 8192; const unsigned char* Vt_ = Vb0 + (t & 1) * 8192; const bool lok = isw ? true : (((selm >> (j & 31)) & 1u) != 0u); const int dj = i - j;
              if (dj <= 2) attn_tile<0>(Kt_, Vt_, qr, bt, 64 * j, qpos, lok, m, l, o, lane);
              else if (isw && dj == 8) attn_tile<2>(Kt_, Vt_, qr, bt, 64 * j, qpos, lok, m, l, o, lane);
              else attn_tile<1>(Kt_, Vt_, qr, bt, 64 * j, qpos, lok, m, l, o, lane); }
            if (more) kv_store(Kb0 + ((t + 1) & 1) * 8192, Vb0 + ((t + 1) & 1) * 8192, nx, tid);
        }
        l = xhalf_sum(l); const float sc = l > 0.f ? g2 / l : 0.f;
#pragma unroll
        for (int r = 0; r < 16; ++r) { ot[0][r] += sc * o[0][r]; ot[1][r] += sc * o[1][r]; }
    }
    bf16_t* AO = (bf16_t*)(p.ws + WS_AO) + row * 1024 + head * 64;
#pragma unroll
    for (int eb = 0; eb < 2; ++eb)
#pragma unroll
        for (int a = 0; a < 4; ++a) { u32x2 ov; ov.x = pk2(ot[eb][4 * a], ot[eb][4 * a + 1]); ov.y = pk2(ot[eb][4 * a + 2], ot[eb][4 * a + 3]); *(u32x2*)(AO + 32 * eb + 8 * a + 4 * hi) = ov; }
    __syncthreads();
}

constexpr int SA_Q = 0, SA_SC = 256, SA_IMP = SA_SC + 4096, SA_IMPS = SA_IMP + 1024, SA_SEL = SA_IMPS + 256, SA_ML = SA_SEL + 16, SA_OB = SA_ML + 8, SA_OT = SA_OB + 512, SA_PART = SA_OT + 256, SA_END = SA_PART + 64 * 256;
__device__ __forceinline__ void dot4_f32(const float* key, const float* q, float* a) {
#pragma unroll 2
    for (int d = 0; d < 64; d += 4) { const f32x4 kv = *(const f32x4*)(key + d);
#pragma unroll
        for (int r = 0; r < 4; ++r) { const f32x4 qv = *(const f32x4*)(q + r * 64 + d); a[r] += kv[0] * qv[0] + kv[1] * qv[1] + kv[2] * qv[2] + kv[3] * qv[3]; } }
}
__device__ __forceinline__ void dot4_bf16(const bf16_t* key, const float* q, float* a) {
#pragma unroll 2
    for (int d = 0; d < 64; d += 8) { const u32x4 kw = *(const u32x4*)(key + d); const float kf[8] = {bflo(kw.x), bfhi(kw.x), bflo(kw.y), bfhi(kw.y), bflo(kw.z), bfhi(kw.z), bflo(kw.w), bfhi(kw.w)};
#pragma unroll
        for (int r = 0; r < 4; ++r) { const f32x4 q0 = *(const f32x4*)(q + r * 64 + d), q1 = *(const f32x4*)(q + r * 64 + d + 4);
            a[r] += kf[0] * q0[0] + kf[1] * q0[1] + kf[2] * q0[2] + kf[3] * q0[3] + kf[4] * q1[0] + kf[5] * q1[1] + kf[6] * q1[2] + kf[7] * q1[3]; } }
}
struct Slot { const float* kf; const float* vf; const bf16_t* kb; const bf16_t* vb; int dist; bool valid; };
template <int BR>
__device__ __forceinline__ Slot sa_slot(const Params& p, int b, int g, int slot, const int* sel, const int* selb) {
    Slot s; s.kf = nullptr; s.vf = nullptr; s.kb = nullptr; s.vb = nullptr; s.valid = true; s.dist = 0;
    const size_t row = (size_t)MP + b;
    if (BR == 0) { const size_t off = ((size_t)(b * 1024 + slot) * 2 + g) * 64; s.kb = (const bf16_t*)(p.ws + WS_CKCS) + off; s.vb = (const bf16_t*)(p.ws + WS_CVCS) + off; s.dist = PAST - (16 * slot + 31); }
    else if (BR == 1) { const int blk = sel[slot >> 6], kk = slot & 63, pos = 64 * blk + kk;
        if (blk == 256) { s.valid = (kk == 0); s.kb = (const bf16_t*)(p.ws + WS_KS) + row * 128 + g * 64; s.vb = (const bf16_t*)(p.ws + WS_VS) + row * 128 + g * 64; s.dist = 0; }
        else { const size_t off = (size_t)selb[slot >> 6] + (size_t)kk * 128; s.kf = p.in[4] + off; s.vf = p.in[5] + off; s.dist = PAST - pos; } }
    else { const int j = slot + 1;
        if (j == 512) { s.kb = (const bf16_t*)(p.ws + WS_KW) + row * 128 + g * 64; s.vb = (const bf16_t*)(p.ws + WS_VW) + row * 128 + g * 64; s.dist = 0; }
        else { const size_t off = (((size_t)b * 512 + j) * 2 + g) * 64; s.kf = p.in[6] + off; s.vf = p.in[7] + off; s.dist = 512 - j; } }
    return s;
}
template <int BR>
__device__ __forceinline__ void sa_branch(const Params& p, float* L, int b, int g, int nslots, const float* btg, const float* gates  ) {
    const int tid = threadIdx.x, lane = tid & 63, w = tid >> 6;
    float* q = L + SA_Q; float* sc = L + SA_SC; float* ml = L + SA_ML; float* ob = L + SA_OB; float* ot = L + SA_OT; const int* sel = (const int*)(L + SA_SEL);
    for (int slot = tid; slot < nslots; slot += 512) {
        const Slot s = sa_slot<BR>(p, b, g, slot, sel, (const int*)(L + SA_IMPS)); float a[4] = {0.f, 0.f, 0.f, 0.f};
        if (s.valid) { if (s.kf) dot4_f32(s.kf, q, a); else dot4_bf16(s.kb, q, a); }
        const int di = s.dist > 127 ? 127 : s.dist;
#pragma unroll
        for (int r = 0; r < 4; ++r) sc[r * 1024 + slot] = s.valid ? a[r] + btg[r * 128 + di] : -1e30f;
    }
    __syncthreads();
    if (w < 4) { float mx = -1e30f;
        for (int s = lane; s < nslots; s += 64) mx = fmaxf(mx, sc[w * 1024 + s]);
#pragma unroll
        for (int of = 1; of < 64; of <<= 1) mx = fmaxf(mx, __shfl_xor(mx, of));
        float sum = 0.f;
        for (int s = lane; s < nslots; s += 64) { const float v = sc[w * 1024 + s]; const float e = v > -1e29f ? exp2f(v - mx) : 0.f; sc[w * 1024 + s] = e; sum += e; }
#pragma unroll
        for (int of = 1; of < 64; of <<= 1) sum += __shfl_xor(sum, of);
        const float inv = sum > 0.f ? 1.f / sum : 0.f;
        for (int s = lane; s < nslots; s += 64) sc[w * 1024 + s] *= inv;
    }
    __syncthreads();
    { const int sl = tid >> 3, e0 = (tid & 7) * 8; float acc[4][8];
#pragma unroll
      for (int r = 0; r < 4; ++r)
#pragma unroll
          for (int e = 0; e < 8; ++e) acc[r][e] = 0.f;
      const size_t row = (size_t)MP + b;
      const int* selb = (const int*)(L + SA_IMPS);
#pragma unroll 4
      for (int slot = sl; slot < nslots; slot += 64) {
          float pr[4];
#pragma unroll
          for (int r = 0; r < 4; ++r) pr[r] = sc[r * 1024 + slot];
          const float* vf = nullptr; const bf16_t* vb = nullptr;
          if (BR == 0) vb = (const bf16_t*)(p.ws + WS_CVCS) + ((size_t)(b * 1024 + slot) * 2 + g) * 64;
          else if (BR == 1) { const int si = slot >> 6, kk = slot & 63; if (sel[si] == 256) vb = (const bf16_t*)(p.ws + WS_VS) + row * 128 + g * 64; else vf = p.in[5] + (size_t)selb[si] + (size_t)kk * 128; }
          else { if (slot == 511) vb = (const bf16_t*)(p.ws + WS_VW) + row * 128 + g * 64; else vf = p.in[7] + (((size_t)b * 512 + slot + 1) * 2 + g) * 64; }
          float vv[8];
          if (vf) { const f32x4 a0 = *(const f32x4*)(vf + e0), a1 = *(const f32x4*)(vf + e0 + 4); vv[0] = a0[0]; vv[1] = a0[1]; vv[2] = a0[2]; vv[3] = a0[3]; vv[4] = a1[0]; vv[5] = a1[1]; vv[6] = a1[2]; vv[7] = a1[3]; }
          else { const u32x4 w = *(const u32x4*)(vb + e0); vv[0] = bflo(w.x); vv[1] = bfhi(w.x); vv[2] = bflo(w.y); vv[3] = bfhi(w.y); vv[4] = bflo(w.z); vv[5] = bfhi(w.z); vv[6] = bflo(w.w); vv[7] = bfhi(w.w); }
#pragma unroll
          for (int r = 0; r < 4; ++r)
#pragma unroll
              for (int e = 0; e < 8; ++e) acc[r][e] += pr[r] * vv[e];
      }
      float* part = L + SA_PART;
#pragma unroll
      for (int r = 0; r < 4; ++r) { *(f32x4*)(part + sl * 256 + r * 64 + e0) = (f32x4){acc[r][0], acc[r][1], acc[r][2], acc[r][3]}; *(f32x4*)(part + sl * 256 + r * 64 + e0 + 4) = (f32x4){acc[r][4], acc[r][5], acc[r][6], acc[r][7]}; }
    }
    __syncthreads();
    if (tid < 256) { float a = 0.f; const float* part = L + SA_PART;
#pragma unroll 8
        for (int q = 0; q < 64; ++q) a += part[q * 256 + tid];
        ob[tid] = a; ob[256 + tid] = 0.f; }
    if (tid < 256) { const int r = tid >> 6; ot[tid] += gates[r] * (ob[tid] + ob[256 + tid]); }
    __syncthreads();
    (void)ml;
}
__device__ __forceinline__ void attn_sample_unit(const Params& p, unsigned char* lds, int b, int g) {
    const int tid = threadIdx.x;
    float* L = (float*)lds; float* q = L + SA_Q; float* sc = L + SA_SC; float* imp = L + SA_IMP; float* imps = L + SA_IMPS; int* sel = (int*)(L + SA_SEL); float* ot = L + SA_OT; float* gsh = L + SA_ML;
    const size_t row = (size_t)MP + b;
    if (tid < 256) { q[tid] = bf1(((const bf16_t*)(p.ws + WS_Q))[row * 512 + g * 256 + tid]); ot[tid] = 0.f; }
    __syncthreads();
    const float* btg = (const float*)(p.ws + WS_BTAB) + (g * 4) * 128;
    const float* GT = (const float*)(p.ws + WS_GATE) + row * 24 + g * 4;
    sa_branch<0>(p, L, b, g, NC_S, btg, GT);
    for (int c = tid; c < NC_S; c += 512) imp[c] = sc[c] + sc[1024 + c] + sc[2048 + c] + sc[3072 + c];
    __syncthreads();
    if (tid >= 1 && tid <= 254) { const int j = tid; imps[j] = 0.5f * imp[4 * j - 1] + imp[4 * j] + imp[4 * j + 1] + imp[4 * j + 2] + 0.5f * imp[4 * j + 3]; }
    if (tid == 0) { sel[0] = 0; sel[1] = 255; sel[2] = 256; }
    __syncthreads();
    if (tid >= 1 && tid <= 254) { const float vj = imps[tid]; int cnt = 0;
        for (int k = 1; k <= 254; ++k) { const float vk = imps[k]; cnt += (vk > vj || (vk == vj && k < tid)) ? 1 : 0; }
        if (cnt < 13) sel[3 + cnt] = tid; }
    __syncthreads();
    if (tid < 16) { const int blk = sel[tid]; int off = 0;
        if (blk < 256) { const int page = p.page_table[b * NPAGES + (blk >> 1)]; off = ((page * PAGE + (blk & 1) * 64) * 2 + g) * 64; }
        ((int*)imps)[tid] = off; }
    __syncthreads();
    sa_branch<1>(p, L, b, g, 1024, btg, GT + 8);
    sa_branch<2>(p, L, b, g, 512, btg, GT + 16);
    if (tid < 256) { const unsigned pk = pk2(ot[tid], 0.f); ((bf16_t*)(p.ws + WS_AO))[row * 1024 + g * 256 + tid] = (bf16_t)(pk & 0xffffu); }
    __syncthreads();
    (void)gsh;
}

__device__ __forceinline__ void st4bf_(bf16_t* dst, const float* v) { u32x2 o; o.x = pk2(v[0], v[1]); o.y = pk2(v[2], v[3]); *(u32x2*)dst = o; }
constexpr int CF_ASTR = 272, CF_WSTR = 144, CF_ASZ = 35328, CF_WSZ = 36864, CF_A = 0, CF_W = 2 * CF_ASZ, CF_PG = CF_W + 2 * CF_WSZ, CF_BIAS = CF_PG + 128, CF_END = CF_BIAS + 512;
static_assert(CF_END <= LDS_MAIN, "fused compress LDS map");
struct CfRegs { f32x4 a[8]; f32x4 ah; u32x4 w[4]; };
template <bool SRC_BF16>
__device__ __forceinline__ void cf_load(CfRegs& R, const Params& p, const unsigned char* lds, int c, int b, int i0, int s, int tmax, int tid) {
    const int* pg = (const int*)(lds + CF_PG);
#pragma unroll
    for (int q = 0; q < 9; ++q) {
        if (q == 8 && tid >= 32) break;
        const int idx = q * 512 + tid, ii = q == 8 ? 128 : (idx >> 5), c4 = (q == 8 ? tid : (idx & 31)) * 4;
        int t = 16 * (i0 + ii) + s; if (t > tmax) t = tmax;
        f32x4 v;
        if (SRC_BF16) { const u32x2 x = *(const u32x2*)((const bf16_t*)(p.ws + (c ? WS_VC : WS_KC)) + ((size_t)b * SEQ + t) * 128 + c4); v[0] = __uint_as_float(x.x); v[1] = __uint_as_float(x.y); v[2] = 0.f; v[3] = 0.f; }
        else { const int lp = (t >> 7) - (i0 >> 3); v = *(const f32x4*)(p.in[2 + c] + ((size_t)pg[lp] * PAGE + (t & 127)) * 128 + c4); }
        if (q == 8) R.ah = v; else R.a[q] = v;
    }
    const bf16_t* W = (const bf16_t*)(p.ws + WS_W1C) + (size_t)c * 256 * 1024;
#pragma unroll
    for (int q = 0; q < 4; ++q) { const int idx = q * 512 + tid, rw = idx >> 3, ch = idx & 7; R.w[q] = *(const u32x4*)(W + (size_t)rw * 1024 + s * 64 + ch * 8); }
}
template <bool SRC_BF16>
__device__ __forceinline__ void cf_store(const CfRegs& R, unsigned char* Ab, unsigned char* Wb, int tid) {
#pragma unroll
    for (int q = 0; q < 9; ++q) {
        if (q == 8 && tid >= 32) break;
        const int idx = q * 512 + tid, ii = q == 8 ? 128 : (idx >> 5), c4 = (q == 8 ? tid : (idx & 31)) * 4;
        const f32x4 v = q == 8 ? R.ah : R.a[q]; u32x2 o;
        if (SRC_BF16) { o.x = __float_as_uint(v[0]); o.y = __float_as_uint(v[1]); } else { o.x = pk2(v[0], v[1]); o.y = pk2(v[2], v[3]); }
        *(u32x2*)(Ab + ii * CF_ASTR + c4 * 2) = o;
    }
#pragma unroll
    for (int q = 0; q < 4; ++q) { const int idx = q * 512 + tid, rw = idx >> 3, ch = idx & 7; *(u32x4*)(Wb + rw * CF_WSTR + ch * 16) = R.w[q]; }
}
template <bool SRC_BF16>
__device__ __forceinline__ void compress_fused_unit(const Params& p, unsigned char* lds, int c, int b, int i0, int nseg, int nc, bf16_t* dstbase) {
    const int tid = threadIdx.x, lane = tid & 63, w = __builtin_amdgcn_readfirstlane(tid >> 6), r32 = lane & 31, hi = lane >> 5;
    const int g = w & 1, iblk = w >> 1;
    const int tmax = 16 * nseg - 1;
    if (tid < 17) { int pi = (i0 >> 3) + tid; if (pi > NPAGES - 1) pi = NPAGES - 1; ((int*)(lds + CF_PG))[tid] = SRC_BF16 ? 0 : p.page_table[b * NPAGES + pi]; }
    if (tid >= 64 && tid < 192) { const float* bp = (const float*)(p.ws + WS_BIASP) + c * 128 + tid - 64; float a = 0.f;
#pragma unroll 8
        for (int q = 0; q < 32; ++q) a += bp[q * 256];
        ((float*)(lds + CF_BIAS))[tid - 64] = a; }
    __syncthreads();
    CfRegs R;
    cf_load<SRC_BF16>(R, p, lds, c, b, i0, 0, tmax, tid);
    cf_store<SRC_BF16>(R, lds + CF_A, lds + CF_W, tid);
    f32x16 acc[4];
#pragma unroll
    for (int hb = 0; hb < 4; ++hb) acc[hb] = f32x16{};
#pragma unroll 1
    for (int s = 0; s < 16; ++s) {
        __syncthreads();
        if (s + 1 < 16) cf_load<SRC_BF16>(R, p, lds, c, b, i0, s + 1, tmax, tid);
        const unsigned char* Ab = lds + CF_A + (s & 1) * CF_ASZ; const unsigned char* Wb = lds + CF_W + (s & 1) * CF_WSZ;
#pragma unroll 1
        for (int j = 0; j < 2; ++j)
#pragma unroll 2
            for (int ks = 0; ks < 4; ++ks) {
                const bf16x8 tf = *(const bf16x8*)(Ab + (32 * iblk + r32 + j) * CF_ASTR + (g * 64 + 16 * ks + 8 * hi) * 2);
#pragma unroll
                for (int hb = 0; hb < 4; ++hb) { const bf16x8 wf = *(const bf16x8*)(Wb + (j * 128 + 32 * hb + r32) * CF_WSTR + (16 * ks + 8 * hi) * 2);
                    acc[hb] = __builtin_amdgcn_mfma_f32_32x32x16_bf16(wf, tf, acc[hb], 0, 0, 0); }
            }
        if (s + 1 < 16) cf_store<SRC_BF16>(R, lds + CF_A + ((s + 1) & 1) * CF_ASZ, lds + CF_W + ((s + 1) & 1) * CF_WSZ, tid);
    }
    const float* bias = (const float*)(lds + CF_BIAS);
    const bf16_t* W2 = (const bf16_t*)(p.ws + WS_W2C) + (size_t)c * 64 * 128;
    f32x16 o2[2]; o2[0] = f32x16{}; o2[1] = f32x16{};
#pragma unroll
    for (int hb = 0; hb < 4; ++hb) {
        float sv[16];
#pragma unroll
        for (int r = 0; r < 16; ++r) sv[r] = siluf_(acc[hb][r] + bias[32 * hb + crow(r, hi)]);
#pragma unroll
        for (int s2 = 0; s2 < 2; ++s2) { const u32x4 pk = pack8(sv + 8 * s2); const bf16x8 sf = __builtin_bit_cast(bf16x8, pk);
#pragma unroll
            for (int eb = 0; eb < 2; ++eb) { const bf16_t* wp = W2 + (size_t)(32 * eb + r32) * 128 + 32 * hb + 16 * s2 + 4 * hi;
                const u32x2 lo = *(const u32x2*)wp, hh = *(const u32x2*)(wp + 8); const u32x4 wq = {lo.x, lo.y, hh.x, hh.y};
                o2[eb] = __builtin_amdgcn_mfma_f32_32x32x16_bf16(__builtin_bit_cast(bf16x8, wq), sf, o2[eb], 0, 0, 0); } }
    }
    float rs = 1.f;
    if (c == 0) { float ss = 0.f;
#pragma unroll
        for (int eb = 0; eb < 2; ++eb)
#pragma unroll
            for (int r = 0; r < 16; ++r) ss += o2[eb][r] * o2[eb][r];
        ss = xhalf_sum(ss); rs = rsqrtf(ss * (1.f / 64.f) + EPS); }
    const int i = i0 + 32 * iblk + r32;
    if (i < nc) { bf16_t* dst = dstbase + ((size_t)(b * nseg + i) * 2 + g) * 64;
#pragma unroll
        for (int eb = 0; eb < 2; ++eb)
#pragma unroll
            for (int a = 0; a < 4; ++a) { const int e0 = 32 * eb + 8 * a + 4 * hi; float v[4];
#pragma unroll
                for (int e = 0; e < 4; ++e) { v[e] = o2[eb][4 * a + e] * rs; if (c == 0) v[e] *= p.in[15][e0 + e]; }
                st4bf_(dst + e0, v); } }
    __syncthreads();
}

__device__ __forceinline__ void skinny_tile(const bf16_t* X, int lda, const bf16_t* Wt, int K, int rowA, int rowB, float* red, float* T) {
    const int tid = threadIdx.x, lane = tid & 63, w = __builtin_amdgcn_readfirstlane(tid >> 6), r32 = lane & 31, hi = lane >> 5;
    const int kw = K >> 3;
    f32x16 acc0 = f32x16{}, acc1 = f32x16{};
    const bf16_t* xp = X + (size_t)r32 * lda + w * kw + 8 * hi;
    const bf16_t* wa = Wt + (size_t)(rowA + r32) * K + w * kw + 8 * hi;
    const bf16_t* wb = Wt + (size_t)(rowB + r32) * K + w * kw + 8 * hi;
#pragma unroll 4
    for (int k = 0; k < kw; k += 16) { const bf16x8 xf = *(const bf16x8*)(xp + k), fa = *(const bf16x8*)(wa + k), fb = *(const bf16x8*)(wb + k);
        acc0 = __builtin_amdgcn_mfma_f32_32x32x16_bf16(fa, xf, acc0, 0, 0, 0); acc1 = __builtin_amdgcn_mfma_f32_32x32x16_bf16(fb, xf, acc1, 0, 0, 0); }
#pragma unroll
    for (int r = 0; r < 16; ++r) { red[((w * 2 + 0) * 16 + r) * 64 + lane] = acc0[r]; red[((w * 2 + 1) * 16 + r) * 64 + lane] = acc1[r]; }
    __syncthreads();
#pragma unroll
    for (int q = 0; q < 4; ++q) { const int idx = tid + 512 * q, l2 = idx & 63, br = idx >> 6, blk = br >> 4, r = br & 15; float a = 0.f;
#pragma unroll
        for (int ww = 0; ww < 8; ++ww) a += red[((ww * 2 + blk) * 16 + r) * 64 + l2];
        T[(l2 & 31) * 65 + 32 * blk + crow(r, l2 >> 5)] = a; }
    __syncthreads();
}
__device__ __forceinline__ float grp16_sum(float v) { v += __shfl_xor(v, 1); v += __shfl_xor(v, 2); v += __shfl_xor(v, 4); v += __shfl_xor(v, 8); return v; }
__device__ __forceinline__ void st4bf(bf16_t* dst, const float* v) { st4bf_(dst, v); }
__device__ __forceinline__ void st4f(float* dst, const float* v) { *(f32x4*)dst = (f32x4){v[0], v[1], v[2], v[3]}; }
template <int WHICH> __device__ __forceinline__ void skinny_phase(const Params& p, unsigned char* lds) {
    const int tid = threadIdx.x, bid = blockIdx.x, G = gridDim.x;
    unsigned char* ws = p.ws;
    float* red = (float*)lds; float* T = (float*)(lds + 65536);
    const int row = tid >> 4, c4 = (tid & 15) * 4, bj = c4 >> 5, tt = c4 & 31; const size_t grow = (size_t)MP + row;
    const bf16_t* X; const bf16_t* Wt; int lda, K, nitems;
    if (WHICH == 1) { X = (const bf16_t*)(ws + WS_XB); lda = DM; Wt = (const bf16_t*)(ws + WS_W1); K = DM; nitems = 53; }
    else if (WHICH == 5) { X = (const bf16_t*)(ws + WS_AO); lda = DM; Wt = (const bf16_t*)(ws + WS_WO); K = DM; nitems = 16; }
    else if (WHICH == 6) { X = (const bf16_t*)(ws + WS_HB); lda = DM; Wt = (const bf16_t*)(ws + WS_WGU); K = DM; nitems = 88; }
    else if (WHICH == 7) { X = (const bf16_t*)(ws + WS_ACT); lda = DFF; Wt = (const bf16_t*)(ws + WS_WD); K = DFF; nitems = 16; }
    else if (WHICH == 9) { X = (const bf16_t*)(ws + WS_PB); lda = PLE; Wt = (const bf16_t*)(ws + WS_WPP); K = PLE; nitems = 16; }
    else { X = (const bf16_t*)(ws + WS_H2B); lda = DM; Wt = (const bf16_t*)(ws + WS_WPG); K = DM; nitems = 16; }
    X += (size_t)MP * lda;
    for (int it = bid; it < nitems; it += G) {
        const int pn = it >> 2, wc = it & 3;
        skinny_tile(X, lda, Wt, K, pn * 256 + wc * 32, pn * 256 + 128 + wc * 32, red, T);
        float x[4];
#pragma unroll
        for (int e = 0; e < 4; ++e) x[e] = T[row * 65 + c4 + e];
        if (WHICH == 1) {
            const float s1 = ((const float*)(ws + WS_SS1))[grow];
            if (pn < 2 || pn == 3) {
                float v[4], ss = 0.f;
#pragma unroll
                for (int e = 0; e < 4; ++e) { v[e] = x[e] * s1; ss += v[e] * v[e]; }
                ss = grp16_sum(ss);
                const float* nw = (pn < 2) ? p.in[14] : p.in[15]; const float rs = rsqrtf(ss * (1.f / 64.f) + EPS) * ((pn < 2) ? 0.125f * LOG2E : 1.f);
                const int d0 = 32 * bj + tt;
#pragma unroll
                for (int e = 0; e < 4; ++e) v[e] *= rs * nw[d0 + e];
                if (pn < 2) st4bf((bf16_t*)(ws + WS_Q) + grow * 512 + (pn * 4 + wc) * 64 + d0, v);
                else { const int col = (wc & 1) * 64 + d0;
                    if (wc < 2) { st4bf((bf16_t*)(ws + WS_KS) + grow * 128 + col, v); st4f(p.out + O_SSK + (size_t)row * 128 + col, v); }
                    else { st4bf((bf16_t*)(ws + WS_KW) + grow * 128 + col, v); st4f(p.out + O_SWK + ((size_t)row * 512 + 511) * 128 + col, v); } }
            } else if (pn == 2 || pn == 4) {
                float v[4];
#pragma unroll
                for (int e = 0; e < 4; ++e) v[e] = x[e] * s1;
                const int col = 32 * wc + tt;
                if (pn == 2) st4f(p.out + (bj ? O_SCV : O_SCK) + (size_t)row * 128 + col, v);
                else if (bj == 0) { st4bf((bf16_t*)(ws + WS_VS) + grow * 128 + col, v); st4f(p.out + O_SSV + (size_t)row * 128 + col, v); }
                else { st4bf((bf16_t*)(ws + WS_VW) + grow * 128 + col, v); st4f(p.out + O_SWV + ((size_t)row * 512 + 511) * 128 + col, v); }
            } else if (pn <= 8) {
                const int isk = (pn >= 7) ? 1 : 0, head = ((pn - 5) & 1) * 2 + (wc >> 1), j0 = 32 * (wc & 1) + tt;
                const float sc = s1 * (isk ? 0.08838834764831845f : 1.f);
                const float* rp = (const float*)(ws + WS_ROT) + ((size_t)2048 * 64 + j0) * 2;
                float v[4];
#pragma unroll
                for (int e = 0; e < 4; ++e) { const float x1 = T[row * 65 + tt + e] * sc, x2 = T[row * 65 + 32 + tt + e] * sc, c = rp[2 * e], sn = rp[2 * e + 1];
                    v[e] = bj ? (x1 * sn + x2 * c) : (x1 * c - x2 * sn); }
                st4bf((bf16_t*)(ws + (isk ? WS_RK : WS_RQ)) + grow * 512 + head * 128 + 64 * bj + j0, v);
            } else if (pn <= 12) {
                const int isg = pn >= 11; float v[4];
#pragma unroll
                for (int e = 0; e < 4; ++e) { const float y = x[e] * s1; v[e] = isg ? siluf_(y) : y; }
                st4bf((bf16_t*)(ws + (isg ? WS_RG : WS_RV)) + grow * 512 + ((pn - 9) & 1) * 256 + 128 * bj + 32 * wc + tt, v);
            } else {
                if (bj == 0 && tt < 24) { float v[4];
#pragma unroll
                    for (int e = 0; e < 4; ++e) v[e] = sigmoidf_(x[e] * s1);
                    st4f((float*)(ws + WS_GATE) + grow * 24 + tt, v); }
            }
        } else {
            const int col = pn * 256 + 128 * bj + 32 * wc + tt; const size_t off = grow * DM + col;
            if (WHICH == 5) { float v[4], ss = 0.f; const f32x4 xs = *(const f32x4*)(p.in[1] + (size_t)row * DM + col);
#pragma unroll
                for (int e = 0; e < 4; ++e) { v[e] = x[e] + xs[e]; ss += v[e] * v[e]; }
                st4f((float*)(ws + WS_H) + off, v); st4bf((bf16_t*)(ws + WS_HB) + off, v);
                ss = grp16_sum(ss); if ((tid & 15) == 0) atomicAdd((float*)(ws + WS_SS2) + grow, ss);
            } else if (WHICH == 6) {
                if (bj == 0) { const float s2 = rsqrtf(((const float*)(ws + WS_SS2))[grow] * (1.f / 1024.f) + EPS); float v[4];
#pragma unroll
                    for (int e = 0; e < 4; ++e) v[e] = siluf_(x[e] * s2) * (T[row * 65 + 32 + tt + e] * s2);
                    st4bf((bf16_t*)(ws + WS_ACT) + grow * DFF + pn * 128 + 32 * wc + tt, v); }
            } else if (WHICH == 7) { float v[4]; const f32x4 h = *(const f32x4*)((const float*)(ws + WS_H) + off);
#pragma unroll
                for (int e = 0; e < 4; ++e) v[e] = x[e] + h[e];
                st4f((float*)(ws + WS_H2) + off, v); st4bf((bf16_t*)(ws + WS_H2B) + off, v);
            } else if (WHICH == 9) { st4f((float*)(ws + WS_VP) + off, x);
            } else { float v[4]; const f32x4 h = *(const f32x4*)((const float*)(ws + WS_H2) + off), vp = *(const f32x4*)((const float*)(ws + WS_VP) + off);
#pragma unroll
                for (int e = 0; e < 4; ++e) v[e] = h[e] + sigmoidf_(x[e]) * vp[e];
                st4f(p.out + O_YS + (size_t)row * DM + col, v); }
        }
        __syncthreads();
    }
}

constexpr int LDS_BYTES = LDS_MAIN + 256;
constexpr int NPHASE = 9;
#ifndef REPEAT_PHASE
#define REPEAT_PHASE -1
#endif
template <int K, int REPI = 0> __device__ __forceinline__ void phase_body(const Params& p, unsigned char* lds) {
    const int tid = threadIdx.x, bid = blockIdx.x, G = gridDim.x;
    const int wv = __builtin_amdgcn_readfirstlane(tid >> 6);
    unsigned char* ws = p.ws;
    if constexpr (K == 0) phase_prologue(p, lds);
    if constexpr (K == 1) {
        pg8::Gemm g{(const bf16_t*)(ws + WS_XB), (const bf16_t*)(ws + WS_W1), MP, N1, DM};
        {   SubsetOrder S; S.init(MP, 7 * 256, G, bid); S.set = 0;
            EpiProj<0> E; E.ss1 = (const float*)(ws + WS_SS1); E.qn = p.in[14]; E.kn = p.in[15]; E.rot = (const float*)(ws + WS_ROT);
            E.Q = (bf16_t*)(ws + WS_Q); E.CA = (bf16_t*)(ws + WS_CA); E.KS = (bf16_t*)(ws + WS_KS); E.VS = (bf16_t*)(ws + WS_VS); E.KW = (bf16_t*)(ws + WS_KW); E.VW = (bf16_t*)(ws + WS_VW);
            E.RQ = (bf16_t*)(ws + WS_RQ); E.RK = (bf16_t*)(ws + WS_RK); E.RV = (bf16_t*)(ws + WS_RV); E.RG = (bf16_t*)(ws + WS_RG); E.GATE = (float*)(ws + WS_GATE); E.out = p.out;
            pg8::gemm_phase((LAS unsigned char*)lds, g, S, E); }
        {   SubsetOrder S; S.init(MP, 7 * 256, G, bid); S.set = 1;
            EpiProj<1> E; E.ss1 = (const float*)(ws + WS_SS1); E.qn = p.in[14]; E.kn = p.in[15]; E.rot = (const float*)(ws + WS_ROT);
            E.Q = (bf16_t*)(ws + WS_Q); E.CA = (bf16_t*)(ws + WS_CA); E.KS = (bf16_t*)(ws + WS_KS); E.VS = (bf16_t*)(ws + WS_VS); E.KW = (bf16_t*)(ws + WS_KW); E.VW = (bf16_t*)(ws + WS_VW);
            E.RQ = (bf16_t*)(ws + WS_RQ); E.RK = (bf16_t*)(ws + WS_RK); E.RV = (bf16_t*)(ws + WS_RV); E.RG = (bf16_t*)(ws + WS_RG); E.GATE = (float*)(ws + WS_GATE); E.out = p.out;
            pg8::gemm_phase((LAS unsigned char*)lds, g, S, E); }
        skinny_phase<1>(p, lds);
    }
    if constexpr (K == 2) {
        unsigned* qh = (unsigned*)(ws + WS_QUEUE) + 64 + 128 * REPI;
        volatile LAS unsigned* qs = (volatile LAS unsigned*)(lds + LDS_MAIN + 16);
        for (;;) {
            if (tid == 0) *qs = __hip_atomic_fetch_add(qh, 1u, __ATOMIC_RELAXED, __HIP_MEMORY_SCOPE_AGENT);
            __syncthreads();
            const int it = (int)*qs;
            __syncthreads();
            if (it >= 512 + 16) break;
            if (it < 512) { const int c = it >> 8, b = (it >> 3) & 31, sg = it & 7;
                compress_fused_unit<false>(p, lds, c, b, sg * 128, NSEG_S, NC_S, (bf16_t*)(ws + (c ? WS_CVCS : WS_CKCS))); }
            else { const int q = it - 512, c = q >> 3, b = q & 7;
                compress_fused_unit<true>(p, lds, c, b, 0, NSEG_P, NC_P, (bf16_t*)(ws + (c ? WS_CVCP : WS_CKCP))); }
        }
        for (int u = G - 1 - bid; u < NB * 4 * 16; u += G) ret_r1_unit(p, lds, u >> 6, (u >> 4) & 3, u & 15);
        for (int u = G - 1 - bid; u < DB * 4; u += G) ret_sample_unit(p, lds, u >> 2, u & 3);
    }
    if constexpr (K == 3) {
        for (int u = bid; u < NB * 4 * 16; u += G) ret_r2_unit(p, lds, u >> 6, (u >> 4) & 3, u & 15);
        pret_job(p);
    }
    if constexpr (K == 4) {
        unsigned* qh = (unsigned*)(ws + WS_QUEUE) + 128 * REPI;
        volatile LAS unsigned* qs = (volatile LAS unsigned*)(lds + LDS_MAIN + 16);
        for (;;) {
            if (tid == 0) *qs = __hip_atomic_fetch_add(qh, 1u, __ATOMIC_RELAXED, __HIP_MEMORY_SCOPE_AGENT);
            __syncthreads();
            const unsigned it = *qs;
            __syncthreads();
            if (it >= 576u) break;
            if (it < 64u) attn_sample_unit(p, lds, (int)(it >> 1), (int)(it & 1));
            else { const int q = (int)it - 64, bg = q & 15; attn_prompt_unit(p, lds, bg >> 1, bg & 1, 31 - (q >> 4)); }
        }
    }
    if constexpr (K == 5) {
        pg8::Gemm g{(const bf16_t*)(ws + WS_AO), (const bf16_t*)(ws + WS_WO), MP, DM, DM};
        pg8::StaticOrder S; S.init(MP, DM, G, bid);
        EpiOut E; E.xp = p.in[0]; E.xs = p.in[1]; E.H = (float*)(ws + WS_H); E.HB = (bf16_t*)(ws + WS_HB); E.SS2 = (float*)(ws + WS_SS2);
        pg8::gemm_phase((LAS unsigned char*)lds, g, S, E);
        skinny_phase<5>(p, lds);
    }
    if constexpr (K == 6) {
        pg8::Gemm g{(const bf16_t*)(ws + WS_HB), (const bf16_t*)(ws + WS_WGU), MP, NGU, DM};
        pg8::StaticOrder S; S.init(MP, NGU, G, bid);
        EpiGU E; E.SS2 = (const float*)(ws + WS_SS2); E.ACT = (bf16_t*)(ws + WS_ACT);
        pg8::gemm_phase((LAS unsigned char*)lds, g, S, E);
        skinny_phase<6>(p, lds);
    }
    if constexpr (K == 7) {
        { pg8::Gemm g{(const bf16_t*)(ws + WS_ACT), (const bf16_t*)(ws + WS_WD), MP, DM, DFF};
          pg8::StaticOrder S; S.init(MP, DM, G, bid);
          EpiDown E; E.H = (const float*)(ws + WS_H); E.H2 = (float*)(ws + WS_H2); E.H2B = (bf16_t*)(ws + WS_H2B);
          pg8::gemm_phase((LAS unsigned char*)lds, g, S, E); }
        { pg8::Gemm g{(const bf16_t*)(ws + WS_PB), (const bf16_t*)(ws + WS_WPP), MP, DM, PLE};
          pg8::StaticOrder S; S.init(MP, DM, G, bid);
          EpiF32 E; E.C = (float*)(ws + WS_VP); E.ld = DM;
          pg8::gemm_phase((LAS unsigned char*)lds, g, S, E); }
        skinny_phase<7>(p, lds);
        skinny_phase<9>(p, lds);
    }
    if constexpr (K == 8) {
        pg8::Gemm g{(const bf16_t*)(ws + WS_H2B), (const bf16_t*)(ws + WS_WPG), MP, DM, DM};
        pg8::StaticOrder S; S.init(MP, DM, G, bid);
        EpiFinal E; E.H2 = (const float*)(ws + WS_H2); E.VP = (const float*)(ws + WS_VP); E.out = p.out;
        pg8::gemm_phase((LAS unsigned char*)lds, g, S, E);
        skinny_phase<8>(p, lds);
    }
}
__global__ void __launch_bounds__(512, 2) nsa_ret_fwd(Params p) {
    extern __shared__ __attribute__((aligned(16))) unsigned char lds[];
    const int tid = threadIdx.x;
    unsigned char* ws = p.ws;
    if (tid < 4) ((LAS unsigned*)(lds + LDS_MAIN))[tid] = 0u;
    __syncthreads();
    const bool fused = (p.ph_hi - p.ph_lo) > 1;
    XcdBarrier bar; bar.bar = (unsigned*)(ws + WS_CTL); bar.x = 0; bar.st = (volatile LAS unsigned*)(lds + LDS_MAIN);
    if (fused) bar = xcd_barrier_post((unsigned*)(ws + WS_CTL), (volatile LAS unsigned*)(lds + LDS_MAIN));
#ifdef ONLY_PHASE
#define PH_ON(k) ((k) == ONLY_PHASE && p.ph_lo <= (k) && (k) < p.ph_hi)
#else
#define PH_ON(k) (p.ph_lo <= (k) && (k) < p.ph_hi)
#endif
#define SEAM(k) do { if (PH_ON(k) && PH_ON((k) + 1)) xcd_barrier(bar); } while (0)
#define PHASE(k) do { if (PH_ON(k)) { phase_body<k>(p, lds); if (REPEAT_PHASE == (k)) { __syncthreads(); phase_body<k, 1>(p, lds); } } } while (0)
    PHASE(0); SEAM(0);
    PHASE(1); SEAM(1);
    PHASE(2); SEAM(2);
    PHASE(3); SEAM(3);
    PHASE(4); SEAM(4);
    PHASE(5); SEAM(5);
    PHASE(6); SEAM(6);
    PHASE(7); SEAM(7);
    PHASE(8);
}

extern "C" void kernel_launch(void* const* d_in, const int* in_sizes, int n_in, void* d_out, int out_size, void* d_ws, size_t ws_size, hipStream_t stream) {
    static int grid = 0;
    if (grid == 0) {
        if (n_in != 31 || (size_t)out_size != O_END || ws_size < WS_END) { fprintf(stderr, "kernel_launch: unexpected shapes: n_in %d out %d ws %zu (need %zu)\n", n_in, out_size, ws_size, (size_t)WS_END); grid = -1; return; }
        int dev = 0, cus = 0;
        if (hipGetDevice(&dev) != hipSuccess || hipDeviceGetAttribute(&cus, hipDeviceAttributeMultiprocessorCount, dev) != hipSuccess) { grid = -1; return; }
        if (hipFuncSetAttribute((const void*)nsa_ret_fwd, hipFuncAttributeMaxDynamicSharedMemorySize, LDS_BYTES) != hipSuccess) { fprintf(stderr, "kernel_launch: hipFuncSetAttribute failed\n"); grid = -1; return; }
        int per_cu = 0;
        if (hipOccupancyMaxActiveBlocksPerMultiprocessor(&per_cu, (const void*)nsa_ret_fwd, 512, LDS_BYTES) != hipSuccess || per_cu < 1) { fprintf(stderr, "kernel_launch: occupancy query says %d blocks per CU\n", per_cu); }
        (void)hipGetLastError();
        grid = cus;
    }
    if (grid < 0) return;
    (void)hipMemsetAsync((char*)d_ws + WS_CTL, 0, CTL_BYTES, stream);
    Params p; memset(&p, 0, sizeof(p));
    for (int i = 0; i < 31; ++i) p.in[i] = (const float*)d_in[i];
    p.page_table = (const int*)d_in[9]; p.out = (float*)d_out; p.ws = (unsigned char*)d_ws;
#if MK_PER_PHASE_LAUNCH
    for (int ph = 0; ph < NPHASE; ++ph) { p.ph_lo = ph; p.ph_hi = ph + 1; hipLaunchKernelGGL(nsa_ret_fwd, dim3(grid), dim3(512), LDS_BYTES, stream, p); }
#else
    p.ph_lo = 0; p.ph_hi = NPHASE; hipLaunchKernelGGL(nsa_ret_fwd, dim3(grid), dim3(512), LDS_BYTES, stream, p);
#endif
}
```

```cpp
#include <hip/hip_runtime.h>
#include <cstdio>
#include <cstdint>
#include <cstring>

#ifndef MK_PER_PHASE_LAUNCH
#define MK_PER_PHASE_LAUNCH 0
#endif

constexpr int DM = 1024, NB = 8, SEQ = 2048, DB = 32, PAST = 16384, PAGE = 128, NPAGES = 128;
constexpr int MP = NB * SEQ;
constexpr int MV = MP + DB;
constexpr int MR = 16640;
constexpr int INC = 3352, N1 = 3584, DFF = 2816, NGU = 5632, PLE = 256;
constexpr int NSEG_S = 1024, NSEG_P = 128;
constexpr int CROWS_S = DB * NSEG_S * 2;
constexpr int CROWS_P = NB * NSEG_P * 2;
constexpr int CROWS = CROWS_S + CROWS_P;
constexpr int NC_P = 127, NC_S = 1023;
constexpr float EPS = 1e-6f;
constexpr float LOG2E = 1.4426950408889634f;

constexpr size_t O_YP = 0, O_YS = O_YP + (size_t)MP * DM, O_PCK = O_YS + (size_t)DB * DM, O_PCV = O_PCK + (size_t)MP * 128, O_PSK = O_PCV + (size_t)MP * 128,
                 O_PSV = O_PSK + (size_t)MP * 128, O_PWK = O_PSV + (size_t)MP * 128, O_PWV = O_PWK + (size_t)NB * 512 * 128, O_PRET = O_PWV + (size_t)NB * 512 * 128,
                 O_SCK = O_PRET + (size_t)NB * 4 * 128 * 128, O_SCV = O_SCK + DB * 128, O_SSK = O_SCV + DB * 128, O_SSV = O_SSK + DB * 128, O_SWK = O_SSV + DB * 128,
                 O_SWV = O_SWK + (size_t)DB * 512 * 128, O_SRET = O_SWV + (size_t)DB * 512 * 128, O_END = O_SRET + (size_t)DB * 4 * 128 * 128;

constexpr size_t al256(size_t x) { return (x + 255) & ~(size_t)255; }
constexpr size_t WS_CTL = 0, CTL_BYTES = 16384;
constexpr size_t WS_W1 = WS_CTL + CTL_BYTES;
constexpr size_t WS_WO = WS_W1 + (size_t)N1 * DM * 2;
constexpr size_t WS_WGU = WS_WO + (size_t)DM * DM * 2;
constexpr size_t WS_WD = WS_WGU + (size_t)NGU * DM * 2;
constexpr size_t WS_WPG = WS_WD + (size_t)DM * DFF * 2;
constexpr size_t WS_WPP = WS_WPG + (size_t)DM * DM * 2;
constexpr size_t WS_W1C = WS_WPP + (size_t)DM * PLE * 2;
constexpr size_t WS_W2C = WS_W1C + (size_t)2 * 256 * 1024 * 2;
constexpr size_t WS_BIASC = WS_CTL + 14336;
constexpr size_t WS_QUEUE = WS_CTL + 15360;
constexpr size_t WS_BIASP = WS_W2C + (size_t)2 * 64 * 128 * 2;
constexpr size_t WS_BTAB = WS_BIASP + 32 * 256 * 4;
constexpr size_t WS_ROT = WS_BTAB + 4096;
constexpr size_t WS_SS1 = al256(WS_ROT + (size_t)2049 * 64 * 8);
constexpr size_t WS_SS2 = WS_SS1 + (size_t)MR * 4;
constexpr size_t WS_XB = al256(WS_SS2 + (size_t)MR * 4);
constexpr size_t WS_PB = WS_XB + (size_t)MR * DM * 2;
constexpr size_t WS_Q = WS_PB + (size_t)MR * PLE * 2;
constexpr size_t WS_KS = WS_Q + (size_t)MR * 512 * 2;
constexpr size_t WS_VS = WS_KS + (size_t)MR * 128 * 2;
constexpr size_t WS_KW = WS_VS + (size_t)MR * 128 * 2;
constexpr size_t WS_VW = WS_KW + (size_t)MR * 128 * 2;
constexpr size_t WS_RQ = WS_VW + (size_t)MR * 128 * 2;
constexpr size_t WS_RK = WS_RQ + (size_t)MR * 512 * 2;
constexpr size_t WS_RV = WS_RK + (size_t)MR * 512 * 2;
constexpr size_t WS_RG = WS_RV + (size_t)MR * 512 * 2;
constexpr size_t WS_GATE = WS_RG + (size_t)MR * 512 * 2;
constexpr size_t WS_CA = al256(WS_GATE + (size_t)MR * 24 * 4);
constexpr size_t WS_KC = WS_CA, WS_VC = WS_CA + (size_t)MR * 128 * 2;
constexpr size_t WS_CP = WS_CA + (size_t)2 * CROWS * 1024 * 2;
constexpr size_t WS_CKCP = WS_CP + (size_t)2 * CROWS * 256 * 4;
constexpr size_t WS_CVCP = WS_CKCP + (size_t)NB * 128 * 128 * 2;
constexpr size_t WS_CKCS = WS_CVCP + (size_t)NB * 128 * 128 * 2;
constexpr size_t WS_CVCS = WS_CKCS + (size_t)DB * 1024 * 128 * 2;
constexpr size_t WS_KVT = WS_CVCS + (size_t)DB * 1024 * 128 * 2;
constexpr size_t WS_AO = WS_KVT + (size_t)NB * 4 * 16 * 16384 * 4;
constexpr size_t WS_H = WS_AO + (size_t)MR * DM * 2;
constexpr size_t WS_HB = WS_H + (size_t)MR * DM * 4;
constexpr size_t WS_ACT = WS_HB + (size_t)MR * DM * 2;
constexpr size_t WS_H2 = WS_ACT + (size_t)MR * DFF * 2;
constexpr size_t WS_H2B = WS_H2 + (size_t)MR * DM * 4;
constexpr size_t WS_VP = WS_H2B + (size_t)MR * DM * 2;
constexpr size_t WS_END = WS_VP + (size_t)MR * DM * 4;

constexpr int LDS_MAIN = 147456;
typedef unsigned short bf16_t;
typedef short bf16x8 __attribute__((ext_vector_type(8)));
typedef short s16x4 __attribute__((ext_vector_type(4)));
typedef float f32x4 __attribute__((ext_vector_type(4)));
typedef float f32x16 __attribute__((ext_vector_type(16)));
typedef unsigned u32x4 __attribute__((ext_vector_type(4)));
typedef unsigned u32x2 __attribute__((ext_vector_type(2)));
typedef float f32x2_t __attribute__((ext_vector_type(2)));
typedef __bf16 bf16x2_t __attribute__((ext_vector_type(2)));
#define LAS __attribute__((address_space(3)))

__device__ __forceinline__ unsigned pk2(float lo, float hi) { f32x2_t v = {lo, hi}; bf16x2_t b = __builtin_convertvector(v, bf16x2_t); return __builtin_bit_cast(unsigned, b); }
__device__ __forceinline__ float bflo(unsigned w) { return __uint_as_float(w << 16); }
__device__ __forceinline__ float bfhi(unsigned w) { return __uint_as_float(w & 0xffff0000u); }
__device__ __forceinline__ float bf1(bf16_t b) { return __uint_as_float(((unsigned)b) << 16); }
__device__ __forceinline__ float sigmoidf_(float x) { return 1.f / (1.f + __expf(-x)); }
__device__ __forceinline__ float siluf_(float x) { return x / (1.f + __expf(-x)); }
__device__ __forceinline__ int crow(int r, int hi) { return (r & 3) + 8 * (r >> 2) + 4 * hi; }
__device__ __forceinline__ float xhalf_max(float v) { auto rr = __builtin_amdgcn_permlane32_swap(__float_as_uint(v), __float_as_uint(v), false, false); return fmaxf(__uint_as_float(rr[0]), __uint_as_float(rr[1])); }
__device__ __forceinline__ float xhalf_sum(float v) { auto rr = __builtin_amdgcn_permlane32_swap(__float_as_uint(v), __float_as_uint(v), false, false); return __uint_as_float(rr[0]) + __uint_as_float(rr[1]); }

struct Params {
    const float* in[31];
    const int* page_table;
    float* out;
    unsigned char* ws;
    int ph_lo, ph_hi;
};

#define XB_TMO      128
#define XB_XCNT(j)  (256  + 64 * (j))
#define XB_XSUB(j)  (1280 + 64 * (j))
#define XB_XGEN(j)  (2304 + 64 * (j))
#define XB_TOP      3328
#define XB_TOPGEN   3392
#define XCD_BAR_WORDS 3456
#define XB_SPIN_CAP (1u << 18)
__device__ __forceinline__ unsigned xb_ld(unsigned* p)              { return __hip_atomic_load(p, __ATOMIC_RELAXED, __HIP_MEMORY_SCOPE_AGENT); }
__device__ __forceinline__ unsigned xb_add(unsigned* p, unsigned v) { return __hip_atomic_fetch_add(p, v, __ATOMIC_RELAXED, __HIP_MEMORY_SCOPE_AGENT); }
__device__ __forceinline__ unsigned xb_xcc_id() { return (unsigned)__builtin_amdgcn_s_getreg((3 << 11) | 20) & 0xFu; }
#define XB_SPIN(cond, bar) do { unsigned _sp = 0; while (cond) { __builtin_amdgcn_s_sleep(1); \
    if ((++_sp & 255u) == 0u) { if (xb_ld(&(bar)[XB_TMO])) break; if (_sp > XB_SPIN_CAP) { atomicAdd(&(bar)[XB_TMO], 1u); break; } } } } while (0)
struct XcdBarrier { unsigned* bar; unsigned x; volatile LAS unsigned* st; };
__device__ __forceinline__ XcdBarrier xcd_barrier_post(unsigned* bar, volatile LAS unsigned* st) {
    XcdBarrier b; b.bar = bar; b.x = xb_xcc_id(); b.st = st;
    if (threadIdx.x == 0) (void)xb_add(&bar[XB_XCNT(b.x)], 1u);
    return b;
}
__device__ __forceinline__ void xcd_barrier_complete(unsigned* bar, unsigned x, unsigned& nloc, unsigned& nx) {
    const unsigned G = gridDim.x * gridDim.y * gridDim.z;
    unsigned sum, cnt, mine, sp = 0u;
    for (;;) {
        sum = 0u; cnt = 0u; mine = 0u;
#pragma unroll
        for (unsigned j = 0; j < 16; ++j) { const unsigned c = xb_ld(&bar[XB_XCNT(j)]); sum += c; cnt += (c > 0u) ? 1u : 0u; mine = (j == x) ? c : mine; }
        if (sum == G) break;
        __builtin_amdgcn_s_sleep(1);
        if ((++sp & 255u) == 0u) { if (xb_ld(&bar[XB_TMO])) break; if (sp > XB_SPIN_CAP) { atomicAdd(&bar[XB_TMO], 1u); break; } }
    }
    nloc = mine > 0u ? mine : 1u; nx = cnt > 0u ? cnt : 1u;
}
__device__ __forceinline__ void xcd_barrier(const XcdBarrier& b) {
    asm volatile("s_waitcnt vmcnt(0)" ::: "memory");
    __syncthreads();
    if (threadIdx.x == 0) {
        unsigned* bar = b.bar;
        __builtin_amdgcn_s_waitcnt(0);
        unsigned nloc = b.st[0], nx = b.st[1];
        if (nloc == 0u) { xcd_barrier_complete(bar, b.x, nloc, nx); b.st[0] = nloc; b.st[1] = nx; }
        const unsigned old = xb_add(&bar[XB_XSUB(b.x)], 1u);
        const unsigned gen = old / nloc;
        if (old + 1u == (gen + 1u) * nloc) {
            __builtin_amdgcn_fence(__ATOMIC_RELEASE, "agent");
            asm volatile("s_waitcnt vmcnt(0)" ::: "memory");
            const unsigned og = xb_add(&bar[XB_TOP], 1u);
            const unsigned tg = og / nx;
            if (og + 1u == (tg + 1u) * nx) xb_add(&bar[XB_TOPGEN], 1u);
            else XB_SPIN(xb_ld(&bar[XB_TOPGEN]) == tg, bar);
            __builtin_amdgcn_fence(__ATOMIC_ACQUIRE, "agent");
            xb_add(&bar[XB_XGEN(b.x)], 1u);
            asm volatile("s_waitcnt vmcnt(0)" ::: "memory");
        } else {
            XB_SPIN(xb_ld(&bar[XB_XGEN(b.x)]) == gen, bar);
            __builtin_amdgcn_fence(__ATOMIC_ACQUIRE, "agent");
            asm volatile("s_waitcnt vmcnt(0)" ::: "memory");
        }
    }
    __syncthreads();
}

namespace pg8 {
constexpr int BM = 256, BK = 64, HALF = 128, HTB = HALF * BK * 2, STAGE_BYTES = 8 * HTB, NXCD = 8, WGM = 8;
__host__ __device__ __forceinline__ int lds_byte(int r, int c) { const int st = (r >> 4) * 2 + (c >> 5), rr = r & 15, cc = c & 31, ob = rr * 64 + cc * 2; return st * 1024 + (ob ^ (((ob >> 9) & 1) << 5)); }
__host__ __device__ __forceinline__ void stage_rc(int b, int& R, int& C) { const int st = b / 1024, sb = b % 1024, swz = sb ^ (((sb >> 9) & 1) << 5); R = (st >> 1) * 16 + swz / 64; C = (st & 1) * 32 + (swz % 64) / 2; }
__host__ __device__ __forceinline__ int perm32(int rho) { const int n = rho >> 4, i = rho & 15; return 8 * (i >> 2) + 4 * n + (i & 3); }
struct Unit { int pm, pn; };
struct Gemm { const bf16_t* A; const bf16_t* Bt; int M, N, K; };
struct StaticOrder {
    int nM, nN, nwg, G, c;
    __host__ __device__ void init(int M, int N, int G_, int c_) { nM = M / BM; nN = N / BM; nwg = nM * nN; G = G_; c = c_; }
    __host__ __device__ bool next(int i, Unit& u) const {
        const long L = (long)i * G + c; if (L >= nwg) return false;
        int wgid = (int)L; { const int q = nwg / NXCD, r = nwg % NXCD, xcd = wgid % NXCD, off = wgid / NXCD; wgid = (xcd < r ? xcd * (q + 1) : r * (q + 1) + (xcd - r) * q) + off; }
        const int nig = WGM * nN, gid = wgid / nig, fm = gid * WGM, gsz = (nM - fm) < WGM ? (nM - fm) : WGM;
        u.pm = fm + ((wgid % nig) % gsz); u.pn = (wgid % nig) / gsz; return true;
    }
    __device__ __forceinline__ void a_ready(const Unit&) const {}
    __device__ __forceinline__ void done(const Unit&) const {}
};
template <class Epi, class Sched>
__device__ __forceinline__ void gemm_phase(LAS unsigned char* lds, const Gemm g, const Sched& S, const Epi& E) {
    const int tid = threadIdx.x, wid = __builtin_amdgcn_readfirstlane(tid >> 6), lane = tid & 63, wr = wid >> 2, wc = wid & 3, fr = lane & 15, fq = lane >> 4;
    const int K = g.K, nt = K / BK;
    unsigned voffA[2], voffB[2];
#pragma unroll
    for (int i = 0; i < 2; ++i) { int R, C; stage_rc(tid * 16 + i * 8192, R, C); const int Rb = Epi::PERM ? ((R & ~31) + perm32(R & 31)) : R;
        voffA[i] = (unsigned)(R * K + C) * 2u; voffB[i] = (unsigned)(Rb * K + C) * 2u; }
    const size_t kstep = (size_t)(BK * 2);
    const size_t hstep = (size_t)HALF * K * 2;
    const size_t tstep = 2 * hstep;
    const unsigned ldsw = (unsigned)wid * 1024u;
    const int aoff = lds_byte(wr * 64 + fr, fq * 8), boff = lds_byte(wc * 32 + fr, fq * 8);
#define PG8_SA(b, h) (((b) * 2 + (h)) * HTB)
#define PG8_SB(b, h) ((4 + (b) * 2 + (h)) * HTB)
#define PG8_STAGE(bufoff, gbase, voff) do { _Pragma("unroll") for (int _i = 0; _i < 2; ++_i) \
        __builtin_amdgcn_global_load_lds((const unsigned*)((const char*)(gbase) + (voff)[_i]), (LAS unsigned*)(lds + (bufoff) + ldsw + _i * 8192), 16, 0, 0); } while (0)
#define PG8_LDA(dst, b, h) do { _Pragma("unroll") for (int m = 0; m < 4; ++m) _Pragma("unroll") for (int k = 0; k < 2; ++k) dst[m][k] = *(const LAS bf16x8*)(lds + PG8_SA(b, h) + aoff + m * 2048 + k * 1024); } while (0)
#define PG8_LDB(dst, b, h) do { _Pragma("unroll") for (int n = 0; n < 2; ++n) _Pragma("unroll") for (int k = 0; k < 2; ++k) dst[n][k] = *(const LAS bf16x8*)(lds + PG8_SB(b, h) + boff + n * 2048 + k * 1024); } while (0)
#define PG8_MMA(ai, bj, At, Bt) do { __builtin_amdgcn_s_setprio(1); _Pragma("unroll") for (int m = 0; m < 4; ++m) _Pragma("unroll") for (int n = 0; n < 2; ++n) _Pragma("unroll") for (int k = 0; k < 2; ++k) \
        acc[ai][bj][m][n] = __builtin_amdgcn_mfma_f32_16x16x32_bf16(Bt[n][k], At[m][k], acc[ai][bj][m][n], 0, 0, 0); __builtin_amdgcn_s_setprio(0); } while (0)
#define PG8_WAIT_V(n) asm volatile("s_waitcnt vmcnt(" #n ")" ::: "memory")
#define PG8_WAIT_L(n) asm volatile("s_waitcnt lgkmcnt(" #n ")" ::: "memory")
#define PG8_BAR __builtin_amdgcn_s_barrier()
#define PG8_SCHED __builtin_amdgcn_sched_barrier(0)
    Unit cur, nxt; int ui = 0;
    if (!S.next(0, cur)) return;
    f32x4 acc[2][2][4][2];
#pragma unroll
    for (int a = 0; a < 2; ++a)
#pragma unroll
        for (int b = 0; b < 2; ++b)
#pragma unroll
            for (int m = 0; m < 4; ++m)
#pragma unroll
                for (int n = 0; n < 2; ++n) acc[a][b][m][n] = (f32x4){0.f, 0.f, 0.f, 0.f};
    bf16x8 At[4][2], B0[2][2], B1[2][2];
    const char* cA = (const char*)g.A + (size_t)cur.pm * tstep; const char* cB = (const char*)g.Bt + (size_t)cur.pn * tstep;
    S.a_ready(cur);
    PG8_STAGE(PG8_SB(0, 0), cB, voffB); PG8_STAGE(PG8_SA(0, 0), cA, voffA); PG8_STAGE(PG8_SB(0, 1), cB + hstep, voffB); PG8_STAGE(PG8_SA(0, 1), cA + hstep, voffA);
    if (wr == 1) PG8_BAR;
    PG8_WAIT_V(4); PG8_BAR;
    PG8_STAGE(PG8_SB(1, 0), cB + kstep, voffB); PG8_STAGE(PG8_SA(1, 0), cA + kstep, voffA); PG8_STAGE(PG8_SB(1, 1), cB + hstep + kstep, voffB);
    PG8_WAIT_V(6); PG8_BAR;
    for (;;) {
        const bool has_next = S.next(ui + 1, nxt);
        const char* nA = has_next ? (const char*)g.A + (size_t)nxt.pm * tstep : cA; const char* nB = has_next ? (const char*)g.Bt + (size_t)nxt.pn * tstep : cB;
        for (int t = 0; t < nt; t += 2) {
            const bool last = (t == nt - 2);
            const char* a1 = cA + (size_t)(t + 1) * kstep;
            const char* a2 = last ? nA : cA + (size_t)(t + 2) * kstep; const char* b2 = last ? nB : cB + (size_t)(t + 2) * kstep;
            const char* a3 = a2 + kstep; const char* b3 = b2 + kstep;
            if (last && has_next) S.a_ready(nxt);
            PG8_LDB(B0, 0, 0); PG8_SCHED; PG8_LDA(At, 0, 0); PG8_STAGE(PG8_SA(1, 1), a1 + hstep, voffA);
            PG8_WAIT_L(8); PG8_BAR; PG8_WAIT_L(0); PG8_MMA(0, 0, At, B0); PG8_BAR; PG8_SCHED;
            PG8_LDB(B1, 0, 1); PG8_STAGE(PG8_SB(0, 0), b2, voffB);
            PG8_BAR; PG8_WAIT_L(0); PG8_MMA(0, 1, At, B1); PG8_BAR;
            PG8_LDA(At, 0, 1); PG8_STAGE(PG8_SA(0, 0), a2, voffA);
            PG8_BAR; PG8_WAIT_L(0); PG8_MMA(1, 0, At, B0); PG8_BAR; PG8_SCHED;
            PG8_STAGE(PG8_SB(0, 1), b2 + hstep, voffB);
            PG8_WAIT_V(6); PG8_BAR; PG8_MMA(1, 1, At, B1); PG8_BAR;
            PG8_LDB(B0, 1, 0); PG8_SCHED; PG8_LDA(At, 1, 0); PG8_STAGE(PG8_SA(0, 1), a2 + hstep, voffA);
            PG8_WAIT_L(8); PG8_BAR; PG8_WAIT_L(0); PG8_MMA(0, 0, At, B0); PG8_BAR; PG8_SCHED;
            PG8_LDB(B1, 1, 1); PG8_STAGE(PG8_SB(1, 0), b3, voffB);
            PG8_BAR; PG8_WAIT_L(0); PG8_MMA(0, 1, At, B1); PG8_BAR;
            PG8_LDA(At, 1, 1); PG8_STAGE(PG8_SA(1, 0), a3, voffA);
            PG8_BAR; PG8_WAIT_L(0); PG8_MMA(1, 0, At, B0); PG8_BAR; PG8_SCHED;
            PG8_STAGE(PG8_SB(1, 1), b3 + hstep, voffB);
            PG8_WAIT_V(6); PG8_BAR; PG8_MMA(1, 1, At, B1); PG8_BAR;
        }
        E(acc, cur, wr, wc, fr, fq);
        if (!has_next) break;
#pragma unroll
        for (int a = 0; a < 2; ++a)
#pragma unroll
            for (int b = 0; b < 2; ++b)
#pragma unroll
                for (int m = 0; m < 4; ++m)
#pragma unroll
                    for (int n = 0; n < 2; ++n) acc[a][b][m][n] = (f32x4){0.f, 0.f, 0.f, 0.f};
        cur = nxt; cA = nA; cB = nB; ++ui;
    }
    PG8_WAIT_V(0);
    if (wr == 0) PG8_BAR;
    PG8_BAR;
#undef PG8_SA
#undef PG8_SB
#undef PG8_STAGE
#undef PG8_LDA
#undef PG8_LDB
#undef PG8_MMA
#undef PG8_WAIT_V
#undef PG8_WAIT_L
#undef PG8_BAR
#undef PG8_SCHED
}
}

typedef f32x4 Acc[2][2][4][2];
#define EPI_ROWS(...) _Pragma("unroll") for (int ai = 0; ai < 2; ++ai) _Pragma("unroll") for (int m = 0; m < 4; ++m) { const int row = u.pm * 256 + ai * 128 + wr * 64 + m * 16 + fr; __VA_ARGS__ }
__device__ __forceinline__ u32x4 pack8(const float* v) { u32x4 w; w.x = pk2(v[0], v[1]); w.y = pk2(v[2], v[3]); w.z = pk2(v[4], v[5]); w.w = pk2(v[6], v[7]); return w; }

template <int SET> struct EpiProj {
    static constexpr bool PERM = true;
    const float* ss1; const float* qn; const float* kn; const float* rot;
    bf16_t *Q, *CA, *KS, *VS, *KW, *VW, *RQ, *RK, *RV, *RG; float* GATE; float* out;
    __device__ __forceinline__ void operator()(const Acc& acc, const pg8::Unit& u, int wr, int wc, int fr, int fq) const {
        const int pn = u.pn, c8 = 8 * fq;
        if (SET == 0 && (pn < 2 || pn == 3)) {
            const float* nw = (pn < 2) ? qn : kn; const float post = (pn < 2) ? 0.125f * LOG2E : 1.f;
            EPI_ROWS(
                const float s1 = ss1[row]; float v[2][8]; float ss = 0.f;
                _Pragma("unroll") for (int bj = 0; bj < 2; ++bj) _Pragma("unroll") for (int e = 0; e < 8; ++e) { v[bj][e] = acc[ai][bj][m][e >> 2][e & 3] * s1; ss += v[bj][e] * v[bj][e]; }
                ss += __shfl_xor(ss, 16); ss += __shfl_xor(ss, 32);
                const float rs = rsqrtf(ss * (1.f / 64.f) + EPS) * post;
                _Pragma("unroll") for (int bj = 0; bj < 2; ++bj) {
                    const int d0 = 32 * bj + c8;
                    const f32x4 w0 = *(const f32x4*)(nw + d0), w1 = *(const f32x4*)(nw + d0 + 4);
                    _Pragma("unroll") for (int e = 0; e < 4; ++e) { v[bj][e] *= rs * w0[e]; v[bj][4 + e] *= rs * w1[e]; }
                    if (pn < 2) { *(u32x4*)(Q + (size_t)row * 512 + (pn * 4 + wc) * 64 + d0) = pack8(v[bj]); }
                    else {
                        const int col = (wc & 1) * 64 + d0;
                        if (wc < 2) {
                            *(u32x4*)(KS + (size_t)row * 128 + col) = pack8(v[bj]);
                            float* o = row < MP ? out + O_PSK + (size_t)row * 128 + col : out + O_SSK + (size_t)(row - MP) * 128 + col;
                            if (row < MV) { *(f32x4*)o = (f32x4){v[bj][0], v[bj][1], v[bj][2], v[bj][3]}; *(f32x4*)(o + 4) = (f32x4){v[bj][4], v[bj][5], v[bj][6], v[bj][7]}; }
                        } else {
                            *(u32x4*)(KW + (size_t)row * 128 + col) = pack8(v[bj]);
                            float* o = nullptr; const int t = row & 2047;
                            if (row < MP) { if (t >= 1536) o = out + O_PWK + ((size_t)(row >> 11) * 512 + (t - 1536)) * 128 + col; }
                            else if (row < MV) o = out + O_SWK + ((size_t)(row - MP) * 512 + 511) * 128 + col;
                            if (o) { *(f32x4*)o = (f32x4){v[bj][0], v[bj][1], v[bj][2], v[bj][3]}; *(f32x4*)(o + 4) = (f32x4){v[bj][4], v[bj][5], v[bj][6], v[bj][7]}; }
                        }
                    }
                }
            )
        } else if (SET == 1 && (pn == 2 || pn == 4)) {
            EPI_ROWS(
                const float s1 = ss1[row];
                _Pragma("unroll") for (int bj = 0; bj < 2; ++bj) {
                    float v[8]; _Pragma("unroll") for (int e = 0; e < 8; ++e) v[e] = acc[ai][bj][m][e >> 2][e & 3] * s1;
                    const int col = 32 * wc + c8;
                    float* o = nullptr;
                    if (pn == 2) {
                        if (row < MP) { *(u32x4*)(CA + (size_t)bj * MR * 128 + (size_t)row * 128 + col) = pack8(v);
                            o = out + (bj ? O_PCV : O_PCK) + (size_t)row * 128 + col; }
                        else if (row < MV) o = out + (bj ? O_SCV : O_SCK) + (size_t)(row - MP) * 128 + col;
                    } else if (bj == 0) {
                        *(u32x4*)(VS + (size_t)row * 128 + col) = pack8(v);
                        if (row < MP) o = out + O_PSV + (size_t)row * 128 + col; else if (row < MV) o = out + O_SSV + (size_t)(row - MP) * 128 + col;
                    } else {
                        *(u32x4*)(VW + (size_t)row * 128 + col) = pack8(v);
                        const int t = row & 2047;
                        if (row < MP) { if (t >= 1536) o = out + O_PWV + ((size_t)(row >> 11) * 512 + (t - 1536)) * 128 + col; }
                        else if (row < MV) o = out + O_SWV + ((size_t)(row - MP) * 512 + 511) * 128 + col;
                    }
                    if (o) { *(f32x4*)o = (f32x4){v[0], v[1], v[2], v[3]}; *(f32x4*)(o + 4) = (f32x4){v[4], v[5], v[6], v[7]}; }
                }
            )
        } else if (SET == 0) {
            const int isk = (pn >= 7) ? 1 : 0, head = ((pn - 5) & 1) * 2 + (wc >> 1), j0 = 32 * (wc & 1) + c8;
            bf16_t* dst = isk ? RK : RQ; const float post = isk ? 0.08838834764831845f : 1.f;
            EPI_ROWS(
                const float s1 = ss1[row] * post; const int pidx = row < MP ? (row & 2047) : 2048;
                const float* rp = rot + ((size_t)pidx * 64 + j0) * 2;
                float y1[8], y2[8];
                _Pragma("unroll") for (int e2 = 0; e2 < 4; ++e2) { const f32x4 cs = *(const f32x4*)(rp + 4 * e2);
                    _Pragma("unroll") for (int t = 0; t < 2; ++t) { const int e = 2 * e2 + t; const float x1 = acc[ai][0][m][e >> 2][e & 3] * s1, x2 = acc[ai][1][m][e >> 2][e & 3] * s1, c = cs[2 * t], s = cs[2 * t + 1];
                        y1[e] = x1 * c - x2 * s; y2[e] = x1 * s + x2 * c; } }
                *(u32x4*)(dst + (size_t)row * 512 + head * 128 + j0) = pack8(y1);
                *(u32x4*)(dst + (size_t)row * 512 + head * 128 + 64 + j0) = pack8(y2);
            )
        } else if (SET == 1 && pn <= 12) {
            const int isg = pn >= 11; bf16_t* dst = isg ? RG : RV; const int cb = ((pn - 9) & 1) * 256;
            EPI_ROWS(
                const float s1 = ss1[row];
                _Pragma("unroll") for (int bj = 0; bj < 2; ++bj) { float v[8];
                    _Pragma("unroll") for (int e = 0; e < 8; ++e) { const float x = acc[ai][bj][m][e >> 2][e & 3] * s1; v[e] = isg ? siluf_(x) : x; }
                    *(u32x4*)(dst + (size_t)row * 512 + cb + 128 * bj + 32 * wc + c8) = pack8(v); }
            )
        } else if (SET == 1) {
            if (wc == 0 && fq < 3) {
                EPI_ROWS(
                    const float s1 = ss1[row]; float v[8];
                    _Pragma("unroll") for (int e = 0; e < 8; ++e) v[e] = sigmoidf_(acc[ai][0][m][e >> 2][e & 3] * s1);
                    float* o = GATE + (size_t)row * 24 + c8;
                    *(f32x4*)o = (f32x4){v[0], v[1], v[2], v[3]}; *(f32x4*)(o + 4) = (f32x4){v[4], v[5], v[6], v[7]};
                )
            }
        }
    }
};

struct SubsetOrder : pg8::StaticOrder {
    int set;
    __device__ __forceinline__ bool next(int i, pg8::Unit& u) const { if (!pg8::StaticOrder::next(i, u)) return false; const int k = u.pn;
        u.pn = set == 0 ? (k < 2 ? k : (k == 2 ? 3 : k + 2)) : (k == 0 ? 2 : (k == 1 ? 4 : k + 7)); return true; }
};
struct EpiF32 {
    static constexpr bool PERM = true;
    float* C; int ld;
    __device__ __forceinline__ void operator()(const Acc& acc, const pg8::Unit& u, int wr, int wc, int fr, int fq) const {
        EPI_ROWS(
            _Pragma("unroll") for (int bj = 0; bj < 2; ++bj) { float* o = C + (size_t)row * ld + u.pn * 256 + 128 * bj + 32 * wc + 8 * fq;
                *(f32x4*)o = acc[ai][bj][m][0]; *(f32x4*)(o + 4) = acc[ai][bj][m][1]; }
        )
    }
};
struct EpiCmp {
    static constexpr bool PERM = true;
    float* C;
    __device__ __forceinline__ void operator()(const Acc& acc, const pg8::Unit& u, int wr, int wc, int fr, int fq) const {
        EPI_ROWS(
            _Pragma("unroll") for (int bj = 0; bj < 2; ++bj) { float* o = C + (size_t)row * 256 + 128 * bj + 32 * wc + 8 * fq;
                *(f32x4*)o = acc[ai][bj][m][0]; *(f32x4*)(o + 4) = acc[ai][bj][m][1]; }
        )
    }
};
struct CmpOrder {
    int G, c;
    __device__ __forceinline__ bool next(int i, pg8::Unit& u) const { const int L = i * G + c; if (L >= 2 * (CROWS / 256)) return false; u.pm = L; u.pn = L / (CROWS / 256); return true; }
    __device__ __forceinline__ void a_ready(const pg8::Unit&) const {}
    __device__ __forceinline__ void done(const pg8::Unit&) const {}
};

struct EpiOut {
    static constexpr bool PERM = true;
    const float* xp; const float* xs; float* H; bf16_t* HB; float* SS2;
    __device__ __forceinline__ void operator()(const Acc& acc, const pg8::Unit& u, int wr, int wc, int fr, int fq) const {
        EPI_ROWS(
            float ss = 0.f;
            _Pragma("unroll") for (int bj = 0; bj < 2; ++bj) { const int col = u.pn * 256 + 128 * bj + 32 * wc + 8 * fq; float v[8];
                f32x4 x0 = (f32x4){0.f, 0.f, 0.f, 0.f}, x1 = x0;
                if (row < MV) { const float* xr = row < MP ? xp + (size_t)row * DM + col : xs + (size_t)(row - MP) * DM + col; x0 = *(const f32x4*)xr; x1 = *(const f32x4*)(xr + 4); }
                _Pragma("unroll") for (int e = 0; e < 4; ++e) { v[e] = acc[ai][bj][m][0][e] + x0[e]; v[4 + e] = acc[ai][bj][m][1][e] + x1[e]; }
                _Pragma("unroll") for (int e = 0; e < 8; ++e) ss += v[e] * v[e];
                float* o = H + (size_t)row * DM + col; *(f32x4*)o = (f32x4){v[0], v[1], v[2], v[3]}; *(f32x4*)(o + 4) = (f32x4){v[4], v[5], v[6], v[7]};
                *(u32x4*)(HB + (size_t)row * DM + col) = pack8(v); }
            ss += __shfl_xor(ss, 16); ss += __shfl_xor(ss, 32);
            if (fq == 0 && row < MV) atomicAdd(SS2 + row, ss);
        )
    }
};
struct EpiGU {
    static constexpr bool PERM = true;
    const float* SS2; bf16_t* ACT;
    __device__ __forceinline__ void operator()(const Acc& acc, const pg8::Unit& u, int wr, int wc, int fr, int fq) const {
        EPI_ROWS(
            const float s2 = rsqrtf(SS2[row] * (1.f / 1024.f) + EPS); float v[8];
            _Pragma("unroll") for (int e = 0; e < 8; ++e) { const float gt = acc[ai][0][m][e >> 2][e & 3] * s2, up = acc[ai][1][m][e >> 2][e & 3] * s2; v[e] = siluf_(gt) * up; }
            *(u32x4*)(ACT + (size_t)row * DFF + u.pn * 128 + 32 * wc + 8 * fq) = pack8(v);
        )
    }
};
struct EpiDown {
    static constexpr bool PERM = true;
    const float* H; float* H2; bf16_t* H2B;
    __device__ __forceinline__ void operator()(const Acc& acc, const pg8::Unit& u, int wr, int wc, int fr, int fq) const {
        EPI_ROWS(
            _Pragma("unroll") for (int bj = 0; bj < 2; ++bj) { const size_t off = (size_t)row * DM + u.pn * 256 + 128 * bj + 32 * wc + 8 * fq; float v[8];
                const f32x4 h0 = *(const f32x4*)(H + off), h1 = *(const f32x4*)(H + off + 4);
                _Pragma("unroll") for (int e = 0; e < 4; ++e) { v[e] = acc[ai][bj][m][0][e] + h0[e]; v[4 + e] = acc[ai][bj][m][1][e] + h1[e]; }
                *(f32x4*)(H2 + off) = (f32x4){v[0], v[1], v[2], v[3]}; *(f32x4*)(H2 + off + 4) = (f32x4){v[4], v[5], v[6], v[7]};
                *(u32x4*)(H2B + off) = pack8(v); }
        )
    }
};
struct EpiFinal {
    static constexpr bool PERM = true;
    const float* H2; const float* VP; float* out;
    __device__ __forceinline__ void operator()(const Acc& acc, const pg8::Unit& u, int wr, int wc, int fr, int fq) const {
        EPI_ROWS(
            if (row < MV) {
                _Pragma("unroll") for (int bj = 0; bj < 2; ++bj) { const int col = u.pn * 256 + 128 * bj + 32 * wc + 8 * fq; const size_t off = (size_t)row * DM + col; float v[8];
                    const f32x4 h0 = *(const f32x4*)(H2 + off), h1 = *(const f32x4*)(H2 + off + 4), p0 = *(const f32x4*)(VP + off), p1 = *(const f32x4*)(VP + off + 4);
                    _Pragma("unroll") for (int e = 0; e < 4; ++e) { v[e] = h0[e] + sigmoidf_(acc[ai][bj][m][0][e]) * p0[e]; v[4 + e] = h1[e] + sigmoidf_(acc[ai][bj][m][1][e]) * p1[e]; }
                    float* o = row < MP ? out + O_YP + off : out + O_YS + (size_t)(row - MP) * DM + col;
                    *(f32x4*)o = (f32x4){v[0], v[1], v[2], v[3]}; *(f32x4*)(o + 4) = (f32x4){v[4], v[5], v[6], v[7]}; }
            }
        )
    }
};

__device__ __forceinline__ int rel_bucket(int dist) {
    const int n = dist < 0 ? 0 : dist;
    if (n < 16) return n;
    const int large = 16 + (int)(logf((float)n / 16.f) / 2.0794415416798357f * 16.f);
    return large < 31 ? large : 31;
}
struct WSrc { const float* src; int ld, vt; const float* ks; };
__device__ __forceinline__ WSrc wsrc(const Params& p, int wid, int n0) {
    WSrc w; w.vt = 32; w.ks = nullptr;
    if (wid == 0) {
        const int tile = n0 >> 8, c = n0 & 255, bj = c >> 7, wc = (c >> 5) & 3; int col;
        if (tile < 2) col = (tile * 4 + wc) * 64 + 32 * bj;
        else if (tile == 2) col = 512 + c;
        else if (tile == 3) col = (wc < 2 ? 768 : 1024) + (wc & 1) * 64 + 32 * bj;
        else if (tile == 4) col = (bj ? 1152 : 896) + (c & 127);
        else if (tile <= 8) col = (tile >= 7 ? 1816 : 1304) + ((((tile - 5) & 1) * 2 + (wc >> 1)) * 128) + 64 * bj + 32 * (wc & 1);
        else if (tile <= 10) col = 2328 + (tile - 9) * 256 + c;
        else if (tile <= 12) col = 2840 + (tile - 11) * 256 + c;
        else { col = 1280; w.vt = (c == 0) ? 24 : 0; }
        w.src = p.in[13] + col; w.ld = INC; w.ks = p.in[12];
    } else if (wid == 1) { w.src = p.in[23] + n0; w.ld = DM; }
    else if (wid == 2) { const int pn = n0 >> 8, bj = (n0 >> 7) & 1, c7 = n0 & 127; w.src = (bj ? p.in[26] : p.in[25]) + pn * 128 + c7; w.ld = DFF; w.ks = p.in[24]; }
    else if (wid == 3) { w.src = p.in[27] + n0; w.ld = DM; }
    else if (wid == 4) { w.src = p.in[28] + n0; w.ld = DM; }
    else if (wid == 5) { w.src = p.in[29] + n0; w.ld = DM; }
    else if (wid == 6 || wid == 7) { const int j = n0 >> 7, h0 = n0 & 127; w.src = p.in[wid == 6 ? 17 : 20] + (size_t)j * 1024 * 128 + h0; w.ld = 128; }
    else { w.src = p.in[wid == 8 ? 18 : 21] + n0; w.ld = 64; }
    return w;
}
__device__ __forceinline__ void phase_prologue(const Params& p, unsigned char* lds) {
    const int tid = threadIdx.x, lane = tid & 63, wid = tid >> 6, G = gridDim.x, bid = blockIdx.x;
    unsigned char* ws = p.ws;
    {
        const int tn[10] = {112, 32, 176, 32, 32, 32, 8, 8, 2, 2}, tk[10] = {16, 16, 16, 44, 16, 4, 16, 16, 2, 2};
        const size_t dsto[10] = {WS_W1, WS_WO, WS_WGU, WS_WD, WS_WPG, WS_WPP, WS_W1C, WS_W1C + (size_t)256 * 1024 * 2, WS_W2C, WS_W2C + (size_t)64 * 128 * 2};
        int total = 0;
#pragma unroll
        for (int i = 0; i < 10; ++i) total += tn[i] * tk[i];
        float* tl = (float*)lds;
        int total4 = 0;
#pragma unroll
        for (int i = 0; i < 10; ++i) total4 += ((tn[i] + 3) / 4) * tk[i];
        for (int t = bid; t < total4; t += G) {
            int wsel = 0, rem = t;
#pragma unroll
            for (int i = 0; i < 9; ++i) { const int cnt = ((tn[i] + 3) / 4) * tk[i]; if (wsel == i && rem >= cnt) { rem -= cnt; wsel = i + 1; } }
            int tkk = 16, tnn = 4; size_t doff = 0;
#pragma unroll
            for (int i = 0; i < 10; ++i) if (wsel == i) { tkk = tk[i]; tnn = tn[i]; doff = dsto[i]; }
            const int K = tkk * 64;
            const int n0 = (rem / tkk) * 128, k0 = (rem % tkk) * 64;
            const int nch = (tnn - n0 / 32) < 4 ? (tnn - n0 / 32) : 4;
            float v[4][4];
#pragma unroll
            for (int ch = 0; ch < 4; ++ch) { if (ch < nch) { const WSrc w = wsrc(p, wsel, n0 + 32 * ch);
#pragma unroll
                for (int it = 0; it < 4; ++it) { const int kk = it * 16 + (tid >> 5), tt = tid & 31; float x = 0.f;
                    if (tt < w.vt) { x = w.src[(size_t)(k0 + kk) * w.ld + tt]; if (w.ks) x *= w.ks[k0 + kk]; }
                    v[ch][it] = x; } } }
#pragma unroll
            for (int ch = 0; ch < 4; ++ch) if (ch < nch) {
#pragma unroll
                for (int it = 0; it < 4; ++it) tl[ch * 2112 + (it * 16 + (tid >> 5)) * 33 + (tid & 31)] = v[ch][it]; }
            __syncthreads();
#pragma unroll
            for (int ch = 0; ch < 4; ++ch) if (ch < nch) { const int nt = tid >> 4, kq = (tid & 15) * 4; const float* tc = tl + ch * 2112;
              u32x2 o; o.x = pk2(tc[(kq + 0) * 33 + nt], tc[(kq + 1) * 33 + nt]); o.y = pk2(tc[(kq + 2) * 33 + nt], tc[(kq + 3) * 33 + nt]);
              *(u32x2*)((bf16_t*)(ws + doff) + (size_t)(n0 + 32 * ch + nt) * K + k0 + kq) = o; }
            __syncthreads();
        }
    }
    {
        bf16_t* XB = (bf16_t*)(ws + WS_XB); float* SS1 = (float*)(ws + WS_SS1); bf16_t* PB = (bf16_t*)(ws + WS_PB);
        for (int row = bid * 8 + wid; row < MR; row += G * 8) {
            const float* xr = row < MP ? p.in[0] + (size_t)row * DM : p.in[1] + (size_t)(row - MP) * DM;
            const float* pr = row < MP ? p.in[10] + (size_t)row * PLE : p.in[11] + (size_t)(row - MP) * PLE;
            f32x4 v[4]; float ss = 0.f;
#pragma unroll
            for (int i = 0; i < 4; ++i) { v[i] = row < MV ? *(const f32x4*)(xr + i * 256 + lane * 4) : (f32x4){0.f, 0.f, 0.f, 0.f}; ss += v[i][0] * v[i][0] + v[i][1] * v[i][1] + v[i][2] * v[i][2] + v[i][3] * v[i][3]; }
#pragma unroll
            for (int o = 1; o < 64; o <<= 1) ss += __shfl_xor(ss, o);
#pragma unroll
            for (int i = 0; i < 4; ++i) { u32x2 o; o.x = pk2(v[i][0], v[i][1]); o.y = pk2(v[i][2], v[i][3]); *(u32x2*)(XB + (size_t)row * DM + i * 256 + lane * 4) = o; }
            if (lane == 0) SS1[row] = rsqrtf(ss * (1.f / 1024.f) + EPS);
            const f32x4 pv = row < MV ? *(const f32x4*)(pr + lane * 4) : (f32x4){0.f, 0.f, 0.f, 0.f};
            u32x2 o; o.x = pk2(pv[0], pv[1]); o.y = pk2(pv[2], pv[3]); *(u32x2*)(PB + (size_t)row * PLE + lane * 4) = o;
        }
    }
    const int gtid = bid * 512 + tid, gsz = G * 512;
    {
        float* rot = (float*)(ws + WS_ROT);
        for (int idx = gtid; idx < 2049 * 64; idx += gsz) { const int pidx = idx >> 6, j = idx & 63; const float pos = pidx < 2048 ? (float)pidx : 16384.f;
            const float inv = powf(10000.f, -(float)j / 64.f); const float ang = pos * inv; const double a = (double)ang;
            rot[(size_t)idx * 2] = (float)cos(a); rot[(size_t)idx * 2 + 1] = (float)sin(a); }
        float* btab = (float*)(ws + WS_BTAB);
        for (int idx = gtid; idx < 8 * 128; idx += gsz) { const int head = idx >> 7, dist = idx & 127; btab[idx] = p.in[30][rel_bucket(dist) * 8 + head] * LOG2E; }
        float* SS2 = (float*)(ws + WS_SS2);
        for (int idx = gtid; idx < MR; idx += gsz) SS2[idx] = 0.f;
        float* bc = (float*)(ws + WS_BIASP);
        for (int it = bid; it < 32; it += G) if (tid < 256) { const int c = tid >> 7, h = tid & 127; const float* pe = p.in[c ? 19 : 16]; const float* w1 = p.in[c ? 20 : 17]; float a = 0.f;
#pragma unroll 8
            for (int k = it * 64; k < it * 64 + 64; ++k) a += pe[k] * w1[(size_t)k * 128 + h];
            bc[it * 256 + tid] = a; }
    }
    {
        const int total = 2 * DB * 511 * 32;
        for (int idx = gtid; idx < total; idx += gsz) { const int c4 = (idx & 31) * 4; int r = idx >> 5; const int j = r % 511; r /= 511; const int b = r & 31, c = r >> 5;
            const f32x4 v = *(const f32x4*)(p.in[6 + c] + ((size_t)b * 512 + j + 1) * 128 + c4);
            *(f32x4*)(p.out + (c ? O_SWV : O_SWK) + ((size_t)b * 512 + j) * 128 + c4) = v; }
    }
}

__device__ __forceinline__ s16x4 tr16(const unsigned char* p) { typedef short v4i16_t __attribute__((ext_vector_type(4))); return __builtin_bit_cast(s16x4, __builtin_amdgcn_ds_read_tr16_b64_v4i16((LAS v4i16_t*)p)); }
__device__ __forceinline__ bf16x8 cat8(s16x4 lo, s16x4 hi) { return (bf16x8){lo[0], lo[1], lo[2], lo[3], hi[0], hi[1], hi[2], hi[3]}; }
constexpr int RSTR = 272;
__device__ __forceinline__ float ret_lgam(int h) { return log2f(1.f - exp2f(-5.f - (float)h)); }
__device__ __forceinline__ bf16x8 tr_frag(const unsigned char* tile, int row0, int cb, int lane) {
    const int hi = lane >> 5;
    const unsigned char* a = tile + (size_t)(row0 + 4 * hi + ((lane & 15) >> 2)) * RSTR + (cb * 32 + 16 * ((lane >> 4) & 1) + 4 * (lane & 3)) * 2;
    return cat8(tr16(a), tr16(a + 8 * RSTR));
}
__device__ __forceinline__ void stage128(unsigned char* dst, const bf16_t* src, int tid, bool decay, float lg) {
    const int r = tid >> 2, q4 = tid & 3;
    float sc = decay ? exp2f((float)(127 - r) * lg) : 1.f;
#pragma unroll
    for (int i = 0; i < 4; ++i) { const int col = q4 * 32 + i * 8; u32x4 v = *(const u32x4*)(src + (size_t)r * 512 + col);
        if (decay) { v.x = pk2(bflo(v.x) * sc, bfhi(v.x) * sc); v.y = pk2(bflo(v.y) * sc, bfhi(v.y) * sc); v.z = pk2(bflo(v.z) * sc, bfhi(v.z) * sc); v.w = pk2(bflo(v.w) * sc, bfhi(v.w) * sc); }
        *(u32x4*)(dst + (size_t)r * RSTR + col * 2) = v; }
}
__device__ __forceinline__ void ret_r1_unit(const Params& p, unsigned char* lds, int b, int h, int c) {
    const int tid = threadIdx.x, lane = tid & 63, w = __builtin_amdgcn_readfirstlane(tid >> 6), r32 = lane & 31, hi = lane >> 5;
    const size_t row0 = (size_t)b * SEQ + c * 128;
    const float lg = ret_lgam(h);
    unsigned char* Kt = lds; unsigned char* Vt = lds + 128 * RSTR;
    stage128(Kt, (const bf16_t*)(p.ws + WS_RK) + row0 * 512 + h * 128, tid, true, lg);
    stage128(Vt, (const bf16_t*)(p.ws + WS_RV) + row0 * 512 + h * 128, tid, false, 0.f);
    __syncthreads();
    const int eb = w & 3, dp = w >> 2;
    f32x16 acc[2]; acc[0] = f32x16{}; acc[1] = f32x16{};
#pragma unroll
    for (int s = 0; s < 8; ++s) {
        const bf16x8 vf = tr_frag(Vt, 16 * s, eb, lane);
#pragma unroll
        for (int di = 0; di < 2; ++di) { const bf16x8 kf = tr_frag(Kt, 16 * s, 2 * dp + di, lane); acc[di] = __builtin_amdgcn_mfma_f32_32x32x16_bf16(vf, kf, acc[di], 0, 0, 0); }
    }
    float* KVT = (float*)(p.ws + WS_KVT) + ((size_t)((b * 4 + h) * 16 + c)) * 16384;
#pragma unroll
    for (int di = 0; di < 2; ++di)
#pragma unroll
        for (int r = 0; r < 16; ++r) KVT[(size_t)(32 * eb + crow(r, hi)) * 128 + 32 * (2 * dp + di) + r32] = acc[di][r];
    __syncthreads();
}
__device__ __forceinline__ void ret_r2_unit(const Params& p, unsigned char* lds, int b, int h, int c) {
    const int tid = threadIdx.x, lane = tid & 63, w = __builtin_amdgcn_readfirstlane(tid >> 6), r32 = lane & 31, hi = lane >> 5;
    const size_t row0 = (size_t)b * SEQ + c * 128;
    const float lg = ret_lgam(h);
    unsigned char* Qt = lds; unsigned char* Kt = lds + 128 * RSTR; unsigned char* Vt = lds + 2 * 128 * RSTR; float* st = (float*)(lds + 3 * 128 * RSTR);
    stage128(Qt, (const bf16_t*)(p.ws + WS_RQ) + row0 * 512 + h * 128, tid, false, 0.f);
    stage128(Kt, (const bf16_t*)(p.ws + WS_RK) + row0 * 512 + h * 128, tid, false, 0.f);
    stage128(Vt, (const bf16_t*)(p.ws + WS_RV) + row0 * 512 + h * 128, tid, false, 0.f);
    __syncthreads();
    const int eb = w & 3, ps = w >> 2;
    bf16x8 sf[8];
    if (c > 0) {
        const float* KV0 = (const float*)(p.ws + WS_KVT) + ((size_t)((b * 4 + h) * 16)) * 16384 + (size_t)(32 * eb + r32) * 128 + 8 * hi;
        float a[8][8];
#pragma unroll
        for (int s = 0; s < 8; ++s)
#pragma unroll
            for (int e = 0; e < 8; ++e) a[s][e] = 0.f;
        float wj = exp2f(128.f * (float)(c - 1) * lg); const float winv = exp2f(-128.f * lg);
#pragma unroll 1
        for (int j = 0; j < c; ++j) { const float* src = KV0 + (size_t)j * 16384;
            f32x4 x[16];
#pragma unroll
            for (int s = 0; s < 8; ++s) { x[2 * s] = *(const f32x4*)(src + 16 * s); x[2 * s + 1] = *(const f32x4*)(src + 16 * s + 4); }
#pragma unroll
            for (int s = 0; s < 8; ++s)
#pragma unroll
                for (int e = 0; e < 4; ++e) { a[s][e] += wj * x[2 * s][e]; a[s][4 + e] += wj * x[2 * s + 1][e]; }
            wj *= winv; }
#pragma unroll
        for (int s = 0; s < 8; ++s) { const u32x4 pk = pack8(a[s]); sf[s] = __builtin_bit_cast(bf16x8, pk); }
    }
    f32x16 accs[2];
#pragma unroll
    for (int ni = 0; ni < 2; ++ni) {
        const int nb = ps ? (1 + ni) : (ni ? 3 : 0);
        const int n = 32 * nb + r32;
        bf16x8 qf[8];
#pragma unroll
        for (int s = 0; s < 8; ++s) qf[s] = *(const bf16x8*)(Qt + (size_t)n * RSTR + (16 * s + 8 * hi) * 2);
        f32x16 acc = f32x16{};
        if (c > 0) {
#pragma unroll
            for (int s = 0; s < 8; ++s) acc = __builtin_amdgcn_mfma_f32_32x32x16_bf16(sf[s], qf[s], acc, 0, 0, 0);
            const float dn = exp2f((float)(n + 1) * lg);
#pragma unroll
            for (int r = 0; r < 16; ++r) acc[r] *= dn;
        }
        for (int mb = 0; mb <= nb; ++mb) {
            f32x16 x = f32x16{};
#pragma unroll
            for (int s = 0; s < 8; ++s) { const bf16x8 kf = *(const bf16x8*)(Kt + (size_t)(32 * mb + r32) * RSTR + (16 * s + 8 * hi) * 2); x = __builtin_amdgcn_mfma_f32_32x32x16_bf16(kf, qf[s], x, 0, 0, 0); }
            float pv[16];
#pragma unroll
            for (int r = 0; r < 16; ++r) { const int dm = n - (32 * mb + crow(r, hi)); pv[r] = dm >= 0 ? x[r] * exp2f((float)dm * lg) : 0.f; }
#pragma unroll
            for (int s2 = 0; s2 < 2; ++s2) { const u32x4 pk = pack8(pv + 8 * s2); const bf16x8 vf = tr_frag(Vt, 32 * mb + 16 * s2, eb, lane);
                acc = __builtin_amdgcn_mfma_f32_32x32x16_bf16(vf, __builtin_bit_cast(bf16x8, pk), acc, 0, 0, 0); }
        }
        float s1 = 0.f, s2 = 0.f;
#pragma unroll
        for (int r = 0; r < 16; ++r) { s1 += acc[r]; s2 += acc[r] * acc[r]; }
        s1 = xhalf_sum(s1); s2 = xhalf_sum(s2);
        if (hi == 0) { st[(eb * 128 + n) * 2] = s1; st[(eb * 128 + n) * 2 + 1] = s2; }
        accs[ni] = acc;
    }
    __syncthreads();
    const float* gn = p.in[22] + h * 128; const bf16_t* RG = (const bf16_t*)(p.ws + WS_RG); bf16_t* AO = (bf16_t*)(p.ws + WS_AO);
#pragma unroll
    for (int ni = 0; ni < 2; ++ni) {
        const int nb = ps ? (1 + ni) : (ni ? 3 : 0); const int n = 32 * nb + r32;
        float s1 = 0.f, s2 = 0.f;
#pragma unroll
        for (int q = 0; q < 4; ++q) { s1 += st[(q * 128 + n) * 2]; s2 += st[(q * 128 + n) * 2 + 1]; }
        const float mu = s1 * (1.f / 128.f), var = s2 * (1.f / 128.f) - mu * mu, rs = rsqrtf(var + EPS);
        const size_t row = row0 + n;
#pragma unroll
        for (int a = 0; a < 4; ++a) { const int e0 = 32 * eb + 8 * a + 4 * hi;
            const f32x4 gw = *(const f32x4*)(gn + e0); const u32x2 gg = *(const u32x2*)(RG + row * 512 + h * 128 + e0);
            const float g0 = bflo(gg.x), g1 = bfhi(gg.x), g2 = bflo(gg.y), g3 = bfhi(gg.y);
            u32x2 o; o.x = pk2((accs[ni][4 * a] - mu) * rs * gw[0] * g0, (accs[ni][4 * a + 1] - mu) * rs * gw[1] * g1);
            o.y = pk2((accs[ni][4 * a + 2] - mu) * rs * gw[2] * g2, (accs[ni][4 * a + 3] - mu) * rs * gw[3] * g3);
            *(u32x2*)(AO + row * 1024 + 512 + h * 128 + e0) = o; }
    }
    __syncthreads();
}
__device__ __forceinline__ void ret_sample_unit(const Params& p, unsigned char* lds, int b, int h) {
    const int tid = threadIdx.x;
    float* qv = (float*)lds; float* kv = qv + 128; float* vv = kv + 128; float* part = vv + 128; float* red = part + 512;
    const size_t row = (size_t)MP + b;
    if (tid < 384) { const int which = tid >> 7, d = tid & 127; const bf16_t* src = (const bf16_t*)(p.ws + (which == 0 ? WS_RQ : which == 1 ? WS_RK : WS_RV)) + row * 512 + h * 128 + d; qv[tid] = bf1(*src); }
    __syncthreads();
    const float gam = 1.f - exp2f(-5.f - (float)h);
    const int dq = tid >> 7, e = tid & 127;
    const float* st = p.in[8] + ((size_t)(b * 4 + h)) * 16384; float* so = p.out + O_SRET + ((size_t)(b * 4 + h)) * 16384;
    float acc = 0.f, qk = 0.f; const float ve = vv[e];
#pragma unroll 4
    for (int i = 0; i < 32; ++i) { const int d = dq + 4 * i; const float s = st[d * 128 + e]; acc += qv[d] * s; so[d * 128 + e] = gam * s + kv[d] * ve; }
#pragma unroll 4
    for (int d = 0; d < 128; ++d) qk += qv[d] * kv[d];
    part[dq * 128 + e] = acc;
    __syncthreads();
    float o = 0.f;
    if (tid < 128) { o = qk * ve + gam * (part[e] + part[128 + e] + part[256 + e] + part[384 + e]); }
    float s1 = tid < 128 ? o : 0.f, s2 = tid < 128 ? o * o : 0.f;
#pragma unroll
    for (int of = 1; of < 64; of <<= 1) { s1 += __shfl_xor(s1, of); s2 += __shfl_xor(s2, of); }
    if ((tid & 63) == 0 && tid < 128) { red[(tid >> 6) * 2] = s1; red[(tid >> 6) * 2 + 1] = s2; }
    __syncthreads();
    if (tid < 128) { const float t1 = red[0] + red[2], t2 = red[1] + red[3]; const float mu = t1 * (1.f / 128.f), var = t2 * (1.f / 128.f) - mu * mu, rs = rsqrtf(var + EPS);
        const float g = bf1(((const bf16_t*)(p.ws + WS_RG))[row * 512 + h * 128 + e]);
        const unsigned pk = pk2((o - mu) * rs * p.in[22][h * 128 + e] * g, 0.f);
        ((bf16_t*)(p.ws + WS_AO))[row * 1024 + 512 + h * 128 + e] = (bf16_t)(pk & 0xffffu); }
    __syncthreads();
}

__device__ __forceinline__ void compress2_task(const Params& p, int c, int task, int lane) {
    const int r32 = lane & 31, hi = lane >> 5;
    const int R = task * 32 + r32;
    const float* P0 = (const float*)(p.ws + WS_CP) + ((size_t)c * CROWS + R) * 256;
    const int R2 = (R + 2 < CROWS) ? R + 2 : CROWS - 1;
    const float* P1 = (const float*)(p.ws + WS_CP) + ((size_t)c * CROWS + R2) * 256 + 128;
    const float* bc = (const float*)(p.ws + WS_BIASC) + c * 128;
    const bf16_t* W2 = (const bf16_t*)(p.ws + WS_W2C) + (size_t)c * 64 * 128;
    f32x16 acc[2]; acc[0] = f32x16{}; acc[1] = f32x16{};
#pragma unroll
    for (int s = 0; s < 8; ++s) {
        const int k0 = 16 * s + 8 * hi; float hv[8];
#pragma unroll
        for (int q = 0; q < 2; ++q) { const f32x4 a = *(const f32x4*)(P0 + k0 + 4 * q), b = *(const f32x4*)(P1 + k0 + 4 * q), bb = *(const f32x4*)(bc + k0 + 4 * q);
#pragma unroll
            for (int e = 0; e < 4; ++e) hv[4 * q + e] = siluf_(a[e] + b[e] + bb[e]); }
        const u32x4 pk = pack8(hv); const bf16x8 hf = __builtin_bit_cast(bf16x8, pk);
#pragma unroll
        for (int eb = 0; eb < 2; ++eb) { const bf16x8 wf = *(const bf16x8*)(W2 + (size_t)(32 * eb + r32) * 128 + k0); acc[eb] = __builtin_amdgcn_mfma_f32_32x32x16_bf16(wf, hf, acc[eb], 0, 0, 0); }
    }
    float rs = 1.f;
    if (c == 0) { float ss = 0.f;
#pragma unroll
        for (int eb = 0; eb < 2; ++eb)
#pragma unroll
            for (int r = 0; r < 16; ++r) ss += acc[eb][r] * acc[eb][r];
        ss = xhalf_sum(ss); rs = rsqrtf(ss * (1.f / 64.f) + EPS); }
    bool valid; bf16_t* dst;
    if (R < CROWS_S) { valid = ((R >> 1) & 1023) < NC_S; dst = (bf16_t*)(p.ws + (c ? WS_CVCS : WS_CKCS)) + (size_t)R * 64; }
    else { const int Rp = R - CROWS_S; valid = ((Rp >> 1) & 127) < NC_P; dst = (bf16_t*)(p.ws + (c ? WS_CVCP : WS_CKCP)) + (size_t)Rp * 64; }
    if (valid) {
#pragma unroll
        for (int eb = 0; eb < 2; ++eb)
#pragma unroll
            for (int a = 0; a < 4; ++a) { const int e0 = 32 * eb + 8 * a + 4 * hi; float v[4];
#pragma unroll
                for (int e = 0; e < 4; ++e) { v[e] = acc[eb][4 * a + e] * rs; if (c == 0) v[e] *= p.in[15][e0 + e]; }
                u32x2 o; o.x = pk2(v[0], v[1]); o.y = pk2(v[2], v[3]); *(u32x2*)(dst + e0) = o; }
    }
}
__device__ __forceinline__ void pret_job(const Params& p) {
    const int gtid = blockIdx.x * 512 + threadIdx.x, gsz = gridDim.x * 512;
    for (int idx = gtid; idx < NB * 4 * 16384; idx += gsz) { const int d = idx & 127, e = (idx >> 7) & 127, bh = idx >> 14; const float lg = ret_lgam(bh & 3);
        const float* src = (const float*)(p.ws + WS_KVT) + (size_t)bh * 16 * 16384 + e * 128 + d; float a = 0.f;
#pragma unroll
        for (int j = 0; j < 16; ++j) a += exp2f(128.f * (float)(15 - j) * lg) * src[(size_t)j * 16384];
        p.out[O_PRET + (size_t)bh * 16384 + d * 128 + e] = a; }
}

constexpr int AT_K = 0, AT_V = 16384, AT_IMP = 32768, AT_IMPS = AT_IMP + 64 * 129 * 4, AT_MASK = AT_IMPS + 64 * 33 * 4, AT_BTAB = AT_MASK + 256, AT_END = AT_BTAB + 2048;
struct KVregs { u32x4 k, v; };
__device__ __forceinline__ KVregs kv_load(const bf16_t* Kg, const bf16_t* Vg, size_t rowbase, int rmax, int ld, int colg, int tid) {
    KVregs r; { int key = tid & 63; if (key > rmax) key = rmax; r.k = *(const u32x4*)(Kg + (rowbase + key) * ld + colg + (tid >> 6) * 8); }
    { int row = (tid >> 2) & 63; if (row > rmax) row = rmax; r.v = *(const u32x4*)(Vg + (rowbase + row) * ld + colg + (tid >> 8) * 32 + (tid & 3) * 8); }
    return r;
}
__device__ __forceinline__ void kv_store(unsigned char* Kb, unsigned char* Vb, const KVregs& r, int tid) {
    *(u32x4*)(Kb + (tid >> 6) * 1024 + (tid & 63) * 16) = r.k;
    *(u32x4*)(Vb + (tid >> 8) * 4096 + ((tid >> 2) & 63) * 64 + (tid & 3) * 16) = r.v;
}
__device__ __forceinline__ f32x16 qk_sub(const unsigned char* Kb, const bf16x8* qr, int sub, int r32, int hi) {
    f32x16 s = f32x16{};
#pragma unroll
    for (int d0 = 0; d0 < 4; ++d0) { const bf16x8 kf = *(const bf16x8*)(Kb + d0 * 2048 + hi * 1024 + (sub * 32 + r32) * 16); s = __builtin_amdgcn_mfma_f32_32x32x16_bf16(kf, qr[d0], s, 0, 0, 0); }
    return s;
}
__device__ __forceinline__ void pv_sub(f32x16* o, const unsigned char* Vb, const float* pv, int sub, int lane) {
    const int hi = lane >> 5;
    const unsigned char* vb = Vb + ((lane >> 4) & 1) * 32 + (lane & 3) * 8 + (4 * hi + ((lane & 15) >> 2)) * 64;
#pragma unroll
    for (int s2 = 0; s2 < 2; ++s2) { const u32x4 pk = pack8(pv + 8 * s2); const bf16x8 pf = __builtin_bit_cast(bf16x8, pk);
#pragma unroll
        for (int eb = 0; eb < 2; ++eb) { const unsigned char* a = vb + eb * 4096 + (2 * sub + s2) * 1024; const bf16x8 vf = cat8(tr16(a), tr16(a + 512));
            o[eb] = __builtin_amdgcn_mfma_f32_32x32x16_bf16(vf, pf, o[eb], 0, 0, 0); } }
}
constexpr float NEGBIG = -3.0e38f;
__device__ __forceinline__ int imed3(int d) { return min(max(d, 0), 127); }
__device__ __forceinline__ float ex2(float x) { return __builtin_amdgcn_exp2f(x); }
template <int KIND>
__device__ __forceinline__ void attn_tile(const unsigned char* Kb, const unsigned char* Vb, const bf16x8* qr, const float* bt, int kp0, int qpos, bool lane_ok, float& m, float& l, f32x16* o, int lane) {
    const int r32 = lane & 31, hi = lane >> 5;
    const float c127 = bt[127];
    const float cl = lane_ok ? c127 : NEGBIG;
#pragma unroll 1
    for (int sub = 0; sub < 2; ++sub) {
        const int dist0 = qpos - kp0 - 32 * sub - 4 * hi;
        bool any;
        if (KIND == 0) any = lane_ok && dist0 >= 0; else if (KIND == 1) any = lane_ok; else any = (dist0 - 27) <= 511;
        if (__ballot(any) == 0ull) continue;
        f32x16 s = qk_sub(Kb, qr, sub, r32, hi);
        float mx = NEGBIG;
        if (KIND == 0) { const int lim = lane_ok ? 0 : 0x7fffffff;
#pragma unroll
            for (int r = 0; r < 16; ++r) { const int dist = dist0 - ((r & 3) + 8 * (r >> 2)); const int di = imed3(dist);
                const float bv = bt[di]; const float sv = dist >= lim ? s[r] + bv : NEGBIG; s[r] = sv; mx = fmaxf(mx, sv); } }
        else if (KIND == 1) {
#pragma unroll
            for (int r = 0; r < 16; ++r) { const float sv = s[r] + cl; s[r] = sv; mx = fmaxf(mx, sv); } }
        else {
#pragma unroll
            for (int r = 0; r < 16; ++r) { const int dist = dist0 - ((r & 3) + 8 * (r >> 2)); const float sv = dist <= 511 ? s[r] + c127 : NEGBIG; s[r] = sv; mx = fmaxf(mx, sv); } }
        mx = xhalf_max(mx);
        const float mn = fmaxf(m, mx), alpha = ex2(m - mn);
        float pv[16]; float ps = 0.f;
#pragma unroll
        for (int r = 0; r < 16; ++r) { pv[r] = ex2(s[r] - mn); ps += pv[r]; }
        l = l * alpha + ps; m = mn;
        if (__ballot(alpha != 1.f) != 0ull) {
#pragma unroll
            for (int r = 0; r < 16; ++r) { o[0][r] *= alpha; o[1][r] *= alpha; } }
        pv_sub(o, Vb, pv, sub, lane);
    }
}
__device__ __forceinline__ void attn_prompt_unit(const Params& p, unsigned char* lds, int b, int g, int i) {
    const int tid = threadIdx.x, lane = tid & 63, w = __builtin_amdgcn_readfirstlane(tid >> 6), r32 = lane & 31, hi = lane >> 5;
    const int hr = w >> 1, ql = (w & 1) * 32 + r32, qpos = 64 * i + ql, head = g * 4 + hr;
    const size_t row = (size_t)b * SEQ + qpos;
    float* imp = (float*)(lds + AT_IMP); float* imps = (float*)(lds + AT_IMPS); unsigned* mask = (unsigned*)(lds + AT_MASK); float* btab = (float*)(lds + AT_BTAB);
    const bf16_t* Qg = (const bf16_t*)(p.ws + WS_Q);
    for (int x = tid; x < 64 * 129; x += 512) imp[x] = 0.f;
    if (tid < 64) mask[tid] = (i < 16) ? 0xFFFFFFFFu : ((1u << 0) | (1u << i) | (1u << (i - 1)));
    btab[tid] = ((const float*)(p.ws + WS_BTAB))[(g * 4) * 128 + tid];
    bf16x8 qr[4];
#pragma unroll
    for (int d0 = 0; d0 < 4; ++d0) qr[d0] = *(const bf16x8*)(Qg + row * 512 + head * 64 + d0 * 16 + hi * 8);
    const float* gp = (const float*)(p.ws + WS_GATE) + row * 24 + head;
    const float g0 = gp[0], g1 = gp[8], g2 = gp[16];
    const float* bt = btab + hr * 128;
    f32x16 ot[2]; ot[0] = f32x16{}; ot[1] = f32x16{};
    unsigned char* Kb0 = lds + AT_K; unsigned char* Vb0 = lds + AT_V;
    {
        const bf16_t* CK = (const bf16_t*)(p.ws + WS_CKCP); const bf16_t* CV = (const bf16_t*)(p.ws + WS_CVCP);
#pragma unroll
        for (int t = 0; t < 2; ++t) { const KVregs kv = kv_load(CK, CV, (size_t)b * 128 + 64 * t, t ? 62 : 63, 128, g * 64, tid); kv_store(Kb0 + t * 8192, Vb0 + t * 8192, kv, tid); }
        __syncthreads();
        auto cmp_scores = [&](int t4) -> f32x16 {
            f32x16 sv = qk_sub(Kb0 + (t4 >> 1) * 8192, qr, t4 & 1, r32, hi);
#pragma unroll
            for (int r = 0; r < 16; ++r) { const int c = 32 * t4 + crow(r, hi); const int dist = qpos - (16 * c + 31); const int di = imed3(dist);
                const float bv = bt[di]; sv[r] = (dist >= 0 && c < NC_P) ? sv[r] + bv : NEGBIG; }
            return sv; };
        float mx = -1e30f;
#pragma unroll 1
        for (int t4 = 0; t4 < 4; ++t4) { const f32x16 sv = cmp_scores(t4);
#pragma unroll
            for (int r = 0; r < 16; ++r) mx = fmaxf(mx, sv[r]); }
        mx = xhalf_max(mx);
        float ps = 0.f;
#pragma unroll 1
        for (int t4 = 0; t4 < 4; ++t4) { const f32x16 sv = cmp_scores(t4);
#pragma unroll
            for (int r = 0; r < 16; ++r) ps += ex2(sv[r] - mx); }
        ps = xhalf_sum(ps);
        const float inv = ps > 0.f ? 1.f / ps : 0.f;
#pragma unroll 1
        for (int t4 = 0; t4 < 4; ++t4) { const f32x16 sv = cmp_scores(t4);
            float pv[16];
#pragma unroll
            for (int r = 0; r < 16; ++r) { const float pn = ex2(sv[r] - mx) * inv; if (i >= 16 && pn > 0.f) atomicAdd(&imp[ql * 129 + 32 * t4 + crow(r, hi)], pn); pv[r] = pn * g0; }
            pv_sub(ot, Vb0 + (t4 >> 1) * 8192, pv, t4 & 1, lane);
        }
    }
    __syncthreads();
    if (i >= 16) {
        const int q = tid >> 3, jj = tid & 7, jmax = i - 2;
        for (int j = 1 + jj; j <= jmax; j += 8) { const float* ip = imp + q * 129 + 4 * j;
            imps[q * 33 + j] = 0.5f * ip[-1] + ip[0] + ip[1] + ip[2] + 0.5f * ip[3]; }
        __syncthreads();
        for (int j = 1 + jj; j <= jmax; j += 8) { const float vj = imps[q * 33 + j]; int cnt = 0;
            for (int k = 1; k <= jmax; ++k) { const float vk = imps[q * 33 + k]; cnt += (vk > vj || (vk == vj && k < j)) ? 1 : 0; }
            if (cnt < 13) atomicOr(&mask[q], 1u << j); }
        __syncthreads();
    }
    const unsigned selm = mask[ql];
    {
        const bf16_t* KSg = (const bf16_t*)(p.ws + WS_KS); const bf16_t* VSg = (const bf16_t*)(p.ws + WS_VS);
        const bf16_t* KWg = (const bf16_t*)(p.ws + WS_KW); const bf16_t* VWg = (const bf16_t*)(p.ws + WS_VW);
        const int nts = i + 1, t0w = i > 8 ? i - 8 : 0, NT = nts + (i - t0w + 1);
        float m = -1e30f, l = 0.f; f32x16 o[2]; o[0] = f32x16{}; o[1] = f32x16{};
        { const KVregs kv = kv_load(KSg, VSg, (size_t)b * SEQ, 63, 128, g * 64, tid); kv_store(Kb0, Vb0, kv, tid); }
#pragma unroll 1
        for (int t = 0; t < NT; ++t) {
            __syncthreads();
            KVregs nx; const bool more = t + 1 < NT;
            if (more) { const int tn = t + 1; const bool wn = tn >= nts; const int jn = wn ? t0w + tn - nts : tn;
                nx = kv_load(wn ? KWg : KSg, wn ? VWg : VSg, (size_t)b * SEQ + 64 * jn, 63, 128, g * 64, tid); }
            const bool isw = t >= nts; const int j = isw ? t0w + t - nts : t;
            if (t == nts) { l = xhalf_sum(l); const float sc = l > 0.f ? g1 / l : 0.f;
#pragma unroll
                for (int r = 0; r < 16; ++r) { ot[0][r] += sc * o[0][r]; ot[1][r] += sc * o[1][r]; o[0][r] = 0.f; o[1][r] = 0.f; }
                m = -1e30f; l = 0.f; }
            { const unsigned char* Kt_ = Kb0 + (t & 1) * 8192; const unsigned char* Vt_ = Vb0 + (t & 1) * 8192; const bool lok = isw ? true : (((selm >> (j & 31)) & 1u) != 0u); const int dj = i - j;
              if (dj <= 2) attn_tile<0>(Kt_, Vt_, qr, bt, 64 * j, qpos, lok, m, l, o, lane);
              else if (isw && dj == 8) attn_tile<2>(Kt_, Vt_, qr, bt, 64 * j, qpos, lok, m, l, o, lane);
              else attn_tile<1>(Kt_, Vt_, qr, bt, 64 * j, qpos, lok, m, l, o, lane); }
            if (more) kv_store(Kb0 + ((t + 1) & 1) * 8192, Vb0 + ((t + 1) & 1) * 8192, nx, tid);
        }
        l = xhalf_sum(l); const float sc = l > 0.f ? g2 / l : 0.f;
#pragma unroll
        for (int r = 0; r < 16; ++r) { ot[0][r] += sc * o[0][r]; ot[1][r] += sc * o[1][r]; }
    }
    bf16_t* AO = (bf16_t*)(p.ws + WS_AO) + row * 1024 + head * 64;
#pragma unroll
    for (int eb = 0; eb < 2; ++eb)
#pragma unroll
        for (int a = 0; a < 4; ++a) { u32x2 ov; ov.x = pk2(ot[eb][4 * a], ot[eb][4 * a + 1]); ov.y = pk2(ot[eb][4 * a + 2], ot[eb][4 * a + 3]); *(u32x2*)(AO + 32 * eb + 8 * a + 4 * hi) = ov; }
    __syncthreads();
}

constexpr int SA_Q = 0, SA_SC = 256, SA_IMP = SA_SC + 4096, SA_IMPS = SA_IMP + 1024, SA_SEL = SA_IMPS + 256, SA_ML = SA_SEL + 16, SA_OB = SA_ML + 8, SA_OT = SA_OB + 512, SA_PART = SA_OT + 256, SA_END = SA_PART + 64 * 256;
__device__ __forceinline__ void dot4_f32(const float* key, const float* q, float* a) {
#pragma unroll 2
    for (int d = 0; d < 64; d += 4) { const f32x4 kv = *(const f32x4*)(key + d);
#pragma unroll
        for (int r = 0; r < 4; ++r) { const f32x4 qv = *(const f32x4*)(q + r * 64 + d); a[r] += kv[0] * qv[0] + kv[1] * qv[1] + kv[2] * qv[2] + kv[3] * qv[3]; } }
}
__device__ __forceinline__ void dot4_bf16(const bf16_t* key, const float* q, float* a) {
#pragma unroll 2
    for (int d = 0; d < 64; d += 8) { const u32x4 kw = *(const u32x4*)(key + d); const float kf[8] = {bflo(kw.x), bfhi(kw.x), bflo(kw.y), bfhi(kw.y), bflo(kw.z), bfhi(kw.z), bflo(kw.w), bfhi(kw.w)};
#pragma unroll
        for (int r = 0; r < 4; ++r) { const f32x4 q0 = *(const f32x4*)(q + r * 64 + d), q1 = *(const f32x4*)(q + r * 64 + d + 4);
            a[r] += kf[0] * q0[0] + kf[1] * q0[1] + kf[2] * q0[2] + kf[3] * q0[3] + kf[4] * q1[0] + kf[5] * q1[1] + kf[6] * q1[2] + kf[7] * q1[3]; } }
}
struct Slot { const float* kf; const float* vf; const bf16_t* kb; const bf16_t* vb; int dist; bool valid; };
template <int BR>
__device__ __forceinline__ Slot sa_slot(const Params& p, int b, int g, int slot, const int* sel, const int* selb) {
    Slot s; s.kf = nullptr; s.vf = nullptr; s.kb = nullptr; s.vb = nullptr; s.valid = true; s.dist = 0;
    const size_t row = (size_t)MP + b;
    if (BR == 0) { const size_t off = ((size_t)(b * 1024 + slot) * 2 + g) * 64; s.kb = (const bf16_t*)(p.ws + WS_CKCS) + off; s.vb = (const bf16_t*)(p.ws + WS_CVCS) + off; s.dist = PAST - (16 * slot + 31); }
    else if (BR == 1) { const int blk = sel[slot >> 6], kk = slot & 63, pos = 64 * blk + kk;
        if (blk == 256) { s.valid = (kk == 0); s.kb = (const bf16_t*)(p.ws + WS_KS) + row * 128 + g * 64; s.vb = (const bf16_t*)(p.ws + WS_VS) + row * 128 + g * 64; s.dist = 0; }
        else { const size_t off = (size_t)selb[slot >> 6] + (size_t)kk * 128; s.kf = p.in[4] + off; s.vf = p.in[5] + off; s.dist = PAST - pos; } }
    else { const int j = slot + 1;
        if (j == 512) { s.kb = (const bf16_t*)(p.ws + WS_KW) + row * 128 + g * 64; s.vb = (const bf16_t*)(p.ws + WS_VW) + row * 128 + g * 64; s.dist = 0; }
        else { const size_t off = (((size_t)b * 512 + j) * 2 + g) * 64; s.kf = p.in[6] + off; s.vf = p.in[7] + off; s.dist = 512 - j; } }
    return s;
}
template <int BR>
__device__ __forceinline__ void sa_branch(const Params& p, float* L, int b, int g, int nslots, const float* btg, const float* gates  ) {
    const int tid = threadIdx.x, lane = tid & 63, w = tid >> 6;
    float* q = L + SA_Q; float* sc = L + SA_SC; float* ml = L + SA_ML; float* ob = L + SA_OB; float* ot = L + SA_OT; const int* sel = (const int*)(L + SA_SEL);
    for (int slot = tid; slot < nslots; slot += 512) {
        const Slot s = sa_slot<BR>(p, b, g, slot, sel, (const int*)(L + SA_IMPS)); float a[4] = {0.f, 0.f, 0.f, 0.f};
        if (s.valid) { if (s.kf) dot4_f32(s.kf, q, a); else dot4_bf16(s.kb, q, a); }
        const int di = s.dist > 127 ? 127 : s.dist;
#pragma unroll
        for (int r = 0; r < 4; ++r) sc[r * 1024 + slot] = s.valid ? a[r] + btg[r * 128 + di] : -1e30f;
    }
    __syncthreads();
    if (w < 4) { float mx = -1e30f;
        for (int s = lane; s < nslots; s += 64) mx = fmaxf(mx, sc[w * 1024 + s]);
#pragma unroll
        for (int of = 1; of < 64; of <<= 1) mx = fmaxf(mx, __shfl_xor(mx, of));
        float sum = 0.f;
        for (int s = lane; s < nslots; s += 64) { const float v = sc[w * 1024 + s]; const float e = v > -1e29f ? exp2f(v - mx) : 0.f; sc[w * 1024 + s] = e; sum += e; }
#pragma unroll
        for (int of = 1; of < 64; of <<= 1) sum += __shfl_xor(sum, of);
        const float inv = sum > 0.f ? 1.f / sum : 0.f;
        for (int s = lane; s < nslots; s += 64) sc[w * 1024 + s] *= inv;
    }
    __syncthreads();
    { const int sl = tid >> 3, e0 = (tid & 7) * 8; float acc[4][8];
#pragma unroll
      for (int r = 0; r < 4; ++r)
#pragma unroll
          for (int e = 0; e < 8; ++e) acc[r][e] = 0.f;
      const size_t row = (size_t)MP + b;
      const int* selb = (const int*)(L + SA_IMPS);
#pragma unroll 4
      for (int slot = sl; slot < nslots; slot += 64) {
          float pr[4];
#pragma unroll
          for (int r = 0; r < 4; ++r) pr[r] = sc[r * 1024 + slot];
          const float* vf = nullptr; const bf16_t* vb = nullptr;
          if (BR == 0) vb = (const bf16_t*)(p.ws + WS_CVCS) + ((size_t)(b * 1024 + slot) * 2 + g) * 64;
          else if (BR == 1) { const int si = slot >> 6, kk = slot & 63; if (sel[si] == 256) vb = (const bf16_t*)(p.ws + WS_VS) + row * 128 + g * 64; else vf = p.in[5] + (size_t)selb[si] + (size_t)kk * 128; }
          else { if (slot == 511) vb = (const bf16_t*)(p.ws + WS_VW) + row * 128 + g * 64; else vf = p.in[7] + (((size_t)b * 512 + slot + 1) * 2 + g) * 64; }
          float vv[8];
          if (vf) { const f32x4 a0 = *(const f32x4*)(vf + e0), a1 = *(const f32x4*)(vf + e0 + 4); vv[0] = a0[0]; vv[1] = a0[1]; vv[2] = a0[2]; vv[3] = a0[3]; vv[4] = a1[0]; vv[5] = a1[1]; vv[6] = a1[2]; vv[7] = a1[3]; }
          else { const u32x4 w = *(const u32x4*)(vb + e0); vv[0] = bflo(w.x); vv[1] = bfhi(w.x); vv[2] = bflo(w.y); vv[3] = bfhi(w.y); vv[4] = bflo(w.z); vv[5] = bfhi(w.z); vv[6] = bflo(w.w); vv[7] = bfhi(w.w); }
#pragma unroll
          for (int r = 0; r < 4; ++r)
#pragma unroll
              for (int e = 0; e < 8; ++e) acc[r][e] += pr[r] * vv[e];
      }
      float* part = L + SA_PART;
#pragma unroll
      for (int r = 0; r < 4; ++r) { *(f32x4*)(part + sl * 256 + r * 64 + e0) = (f32x4){acc[r][0], acc[r][1], acc[r][2], acc[r][3]}; *(f32x4*)(part + sl * 256 + r * 64 + e0 + 4) = (f32x4){acc[r][4], acc[r][5], acc[r][6], acc[r][7]}; }
    }
    __syncthreads();
    if (tid < 256) { float a = 0.f; const float* part = L + SA_PART;
#pragma unroll 8
        for (int q = 0; q < 64; ++q) a += part[q * 256 + tid];
        ob[tid] = a; ob[256 + tid] = 0.f; }
    if (tid < 256) { const int r = tid >> 6; ot[tid] += gates[r] * (ob[tid] + ob[256 + tid]); }
    __syncthreads();
    (void)ml;
}
__device__ __forceinline__ void attn_sample_unit(const Params& p, unsigned char* lds, int b, int g) {
    const int tid = threadIdx.x;
    float* L = (float*)lds; float* q = L + SA_Q; float* sc = L + SA_SC; float* imp = L + SA_IMP; float* imps = L + SA_IMPS; int* sel = (int*)(L + SA_SEL); float* ot = L + SA_OT; float* gsh = L + SA_ML;
    const size_t row = (size_t)MP + b;
    if (tid < 256) { q[tid] = bf1(((const bf16_t*)(p.ws + WS_Q))[row * 512 + g * 256 + tid]); ot[tid] = 0.f; }
    __syncthreads();
    const float* btg = (const float*)(p.ws + WS_BTAB) + (g * 4) * 128;
    const float* GT = (const float*)(p.ws + WS_GATE) + row * 24 + g * 4;
    sa_branch<0>(p, L, b, g, NC_S, btg, GT);
    for (int c = tid; c < NC_S; c += 512) imp[c] = sc[c] + sc[1024 + c] + sc[2048 + c] + sc[3072 + c];
    __syncthreads();
    if (tid >= 1 && tid <= 254) { const int j = tid; imps[j] = 0.5f * imp[4 * j - 1] + imp[4 * j] + imp[4 * j + 1] + imp[4 * j + 2] + 0.5f * imp[4 * j + 3]; }
    if (tid == 0) { sel[0] = 0; sel[1] = 255; sel[2] = 256; }
    __syncthreads();
    if (tid >= 1 && tid <= 254) { const float vj = imps[tid]; int cnt = 0;
        for (int k = 1; k <= 254; ++k) { const float vk = imps[k]; cnt += (vk > vj || (vk == vj && k < tid)) ? 1 : 0; }
        if (cnt < 13) sel[3 + cnt] = tid; }
    __syncthreads();
    if (tid < 16) { const int blk = sel[tid]; int off = 0;
        if (blk < 256) { const int page = p.page_table[b * NPAGES + (blk >> 1)]; off = ((page * PAGE + (blk & 1) * 64) * 2 + g) * 64; }
        ((int*)imps)[tid] = off; }
    __syncthreads();
    sa_branch<1>(p, L, b, g, 1024, btg, GT + 8);
    sa_branch<2>(p, L, b, g, 512, btg, GT + 16);
    if (tid < 256) { const unsigned pk = pk2(ot[tid], 0.f); ((bf16_t*)(p.ws + WS_AO))[row * 1024 + g * 256 + tid] = (bf16_t)(pk & 0xffffu); }
    __syncthreads();
    (void)gsh;
}

__device__ __forceinline__ void st4bf_(bf16_t* dst, const float* v) { u32x2 o; o.x = pk2(v[0], v[1]); o.y = pk2(v[2], v[3]); *(u32x2*)dst = o; }
constexpr int CF_ASTR = 272, CF_WSTR = 144, CF_ASZ = 35328, CF_WSZ = 36864, CF_A = 0, CF_W = 2 * CF_ASZ, CF_PG = CF_W + 2 * CF_WSZ, CF_BIAS = CF_PG + 128, CF_END = CF_BIAS + 512;
static_assert(CF_END <= LDS_MAIN, "fused compress LDS map");
struct CfRegs { f32x4 a[8]; f32x4 ah; u32x4 w[4]; };
template <bool SRC_BF16>
__device__ __forceinline__ void cf_load(CfRegs& R, const Params& p, const unsigned char* lds, int c, int b, int i0, int s, int tmax, int tid) {
    const int* pg = (const int*)(lds + CF_PG);
#pragma unroll
    for (int q = 0; q < 9; ++q) {
        if (q == 8 && tid >= 32) break;
        const int idx = q * 512 + tid, ii = q == 8 ? 128 : (idx >> 5), c4 = (q == 8 ? tid : (idx & 31)) * 4;
        int t = 16 * (i0 + ii) + s; if (t > tmax) t = tmax;
        f32x4 v;
        if (SRC_BF16) { const u32x2 x = *(const u32x2*)((const bf16_t*)(p.ws + (c ? WS_VC : WS_KC)) + ((size_t)b * SEQ + t) * 128 + c4); v[0] = __uint_as_float(x.x); v[1] = __uint_as_float(x.y); v[2] = 0.f; v[3] = 0.f; }
        else { const int lp = (t >> 7) - (i0 >> 3); v = *(const f32x4*)(p.in[2 + c] + ((size_t)pg[lp] * PAGE + (t & 127)) * 128 + c4); }
        if (q == 8) R.ah = v; else R.a[q] = v;
    }
    const bf16_t* W = (const bf16_t*)(p.ws + WS_W1C) + (size_t)c * 256 * 1024;
#pragma unroll
    for (int q = 0; q < 4; ++q) { const int idx = q * 512 + tid, rw = idx >> 3, ch = idx & 7; R.w[q] = *(const u32x4*)(W + (size_t)rw * 1024 + s * 64 + ch * 8); }
}
template <bool SRC_BF16>
__device__ __forceinline__ void cf_store(const CfRegs& R, unsigned char* Ab, unsigned char* Wb, int tid) {
#pragma unroll
    for (int q = 0; q < 9; ++q) {
        if (q == 8 && tid >= 32) break;
        const int idx = q * 512 + tid, ii = q == 8 ? 128 : (idx >> 5), c4 = (q == 8 ? tid : (idx & 31)) * 4;
        const f32x4 v = q == 8 ? R.ah : R.a[q]; u32x2 o;
        if (SRC_BF16) { o.x = __float_as_uint(v[0]); o.y = __float_as_uint(v[1]); } else { o.x = pk2(v[0], v[1]); o.y = pk2(v[2], v[3]); }
        *(u32x2*)(Ab + ii * CF_ASTR + c4 * 2) = o;
    }
#pragma unroll
    for (int q = 0; q < 4; ++q) { const int idx = q * 512 + tid, rw = idx >> 3, ch = idx & 7; *(u32x4*)(Wb + rw * CF_WSTR + ch * 16) = R.w[q]; }
}
template <bool SRC_BF16>
__device__ __forceinline__ void compress_fused_unit(const Params& p, unsigned char* lds, int c, int b, int i0, int nseg, int nc, bf16_t* dstbase) {
    const int tid = threadIdx.x, lane = tid & 63, w = __builtin_amdgcn_readfirstlane(tid >> 6), r32 = lane & 31, hi = lane >> 5;
    const int g = w & 1, iblk = w >> 1;
    const int tmax = 16 * nseg - 1;
    if (tid < 17) { int pi = (i0 >> 3) + tid; if (pi > NPAGES - 1) pi = NPAGES - 1; ((int*)(lds + CF_PG))[tid] = SRC_BF16 ? 0 : p.page_table[b * NPAGES + pi]; }
    if (tid >= 64 && tid < 192) { const float* bp = (const float*)(p.ws + WS_BIASP) + c * 128 + tid - 64; float a = 0.f;
#pragma unroll 8
        for (int q = 0; q < 32; ++q) a += bp[q * 256];
        ((float*)(lds + CF_BIAS))[tid - 64] = a; }
    __syncthreads();
    CfRegs R;
    cf_load<SRC_BF16>(R, p, lds, c, b, i0, 0, tmax, tid);
    cf_store<SRC_BF16>(R, lds + CF_A, lds + CF_W, tid);
    f32x16 acc[4];
#pragma unroll
    for (int hb = 0; hb < 4; ++hb) acc[hb] = f32x16{};
#pragma unroll 1
    for (int s = 0; s < 16; ++s) {
        __syncthreads();
        if (s + 1 < 16) cf_load<SRC_BF16>(R, p, lds, c, b, i0, s + 1, tmax, tid);
        const unsigned char* Ab = lds + CF_A + (s & 1) * CF_ASZ; const unsigned char* Wb = lds + CF_W + (s & 1) * CF_WSZ;
#pragma unroll 1
        for (int j = 0; j < 2; ++j)
#pragma unroll 2
            for (int ks = 0; ks < 4; ++ks) {
                const bf16x8 tf = *(const bf16x8*)(Ab + (32 * iblk + r32 + j) * CF_ASTR + (g * 64 + 16 * ks + 8 * hi) * 2);
#pragma unroll
                for (int hb = 0; hb < 4; ++hb) { const bf16x8 wf = *(const bf16x8*)(Wb + (j * 128 + 32 * hb + r32) * CF_WSTR + (16 * ks + 8 * hi) * 2);
                    acc[hb] = __builtin_amdgcn_mfma_f32_32x32x16_bf16(wf, tf, acc[hb], 0, 0, 0); }
            }
        if (s + 1 < 16) cf_store<SRC_BF16>(R, lds + CF_A + ((s + 1) & 1) * CF_ASZ, lds + CF_W + ((s + 1) & 1) * CF_WSZ, tid);
    }
    const float* bias = (const float*)(lds + CF_BIAS);
    const bf16_t* W2 = (const bf16_t*)(p.ws + WS_W2C) + (size_t)c * 64 * 128;
    f32x16 o2[2]; o2[0] = f32x16{}; o2[1] = f32x16{};
#pragma unroll
    for (int hb = 0; hb < 4; ++hb) {
        float sv[16];
#pragma unroll
        for (int r = 0; r < 16; ++r) sv[r] = siluf_(acc[hb][r] + bias[32 * hb + crow(r, hi)]);
#pragma unroll
        for (int s2 = 0; s2 < 2; ++s2) { const u32x4 pk = pack8(sv + 8 * s2); const bf16x8 sf = __builtin_bit_cast(bf16x8, pk);
#pragma unroll
            for (int eb = 0; eb < 2; ++eb) { const bf16_t* wp = W2 + (size_t)(32 * eb + r32) * 128 + 32 * hb + 16 * s2 + 4 * hi;
                const u32x2 lo = *(const u32x2*)wp, hh = *(const u32x2*)(wp + 8); const u32x4 wq = {lo.x, lo.y, hh.x, hh.y};
                o2[eb] = __builtin_amdgcn_mfma_f32_32x32x16_bf16(__builtin_bit_cast(bf16x8, wq), sf, o2[eb], 0, 0, 0); } }
    }
    float rs = 1.f;
    if (c == 0) { float ss = 0.f;
#pragma unroll
        for (int eb = 0; eb < 2; ++eb)
#pragma unroll
            for (int r = 0; r < 16; ++r) ss += o2[eb][r] * o2[eb][r];
        ss = xhalf_sum(ss); rs = rsqrtf(ss * (1.f / 64.f) + EPS); }
    const int i = i0 + 32 * iblk + r32;
    if (i < nc) { bf16_t* dst = dstbase + ((size_t)(b * nseg + i) * 2 + g) * 64;
#pragma unroll
        for (int eb = 0; eb < 2; ++eb)
#pragma unroll
            for (int a = 0; a < 4; ++a) { const int e0 = 32 * eb + 8 * a + 4 * hi; float v[4];
#pragma unroll
                for (int e = 0; e < 4; ++e) { v[e] = o2[eb][4 * a + e] * rs; if (c == 0) v[e] *= p.in[15][e0 + e]; }
                st4bf_(dst + e0, v); } }
    __syncthreads();
}

__device__ __forceinline__ void skinny_tile(const bf16_t* X, int lda, const bf16_t* Wt, int K, int rowA, int rowB, float* red, float* T) {
    const int tid = threadIdx.x, lane = tid & 63, w = __builtin_amdgcn_readfirstlane(tid >> 6), r32 = lane & 31, hi = lane >> 5;
    const int kw = K >> 3;
    f32x16 acc0 = f32x16{}, acc1 = f32x16{};
    const bf16_t* xp = X + (size_t)r32 * lda + w * kw + 8 * hi;
    const bf16_t* wa = Wt + (size_t)(rowA + r32) * K + w * kw + 8 * hi;
    const bf16_t* wb = Wt + (size_t)(rowB + r32) * K + w * kw + 8 * hi;
#pragma unroll 4
    for (int k = 0; k < kw; k += 16) { const bf16x8 xf = *(const bf16x8*)(xp + k), fa = *(const bf16x8*)(wa + k), fb = *(const bf16x8*)(wb + k);
        acc0 = __builtin_amdgcn_mfma_f32_32x32x16_bf16(fa, xf, acc0, 0, 0, 0); acc1 = __builtin_amdgcn_mfma_f32_32x32x16_bf16(fb, xf, acc1, 0, 0, 0); }
#pragma unroll
    for (int r = 0; r < 16; ++r) { red[((w * 2 + 0) * 16 + r) * 64 + lane] = acc0[r]; red[((w * 2 + 1) * 16 + r) * 64 + lane] = acc1[r]; }
    __syncthreads();
#pragma unroll
    for (int q = 0; q < 4; ++q) { const int idx = tid + 512 * q, l2 = idx & 63, br = idx >> 6, blk = br >> 4, r = br & 15; float a = 0.f;
#pragma unroll
        for (int ww = 0; ww < 8; ++ww) a += red[((ww * 2 + blk) * 16 + r) * 64 + l2];
        T[(l2 & 31) * 65 + 32 * blk + crow(r, l2 >> 5)] = a; }
    __syncthreads();
}
__device__ __forceinline__ float grp16_sum(float v) { v += __shfl_xor(v, 1); v += __shfl_xor(v, 2); v += __shfl_xor(v, 4); v += __shfl_xor(v, 8); return v; }
__device__ __forceinline__ void st4bf(bf16_t* dst, const float* v) { st4bf_(dst, v); }
__device__ __forceinline__ void st4f(float* dst, const float* v) { *(f32x4*)dst = (f32x4){v[0], v[1], v[2], v[3]}; }
template <int WHICH> __device__ __forceinline__ void skinny_phase(const Params& p, unsigned char* lds) {
    const int tid = threadIdx.x, bid = blockIdx.x, G = gridDim.x;
    unsigned char* ws = p.ws;
    float* red = (float*)lds; float* T = (float*)(lds + 65536);
    const int row = tid >> 4, c4 = (tid & 15) * 4, bj = c4 >> 5, tt = c4 & 31; const size_t grow = (size_t)MP + row;
    const bf16_t* X; const bf16_t* Wt; int lda, K, nitems;
    if (WHICH == 1) { X = (const bf16_t*)(ws + WS_XB); lda = DM; Wt = (const bf16_t*)(ws + WS_W1); K = DM; nitems = 53; }
    else if (WHICH == 5) { X = (const bf16_t*)(ws + WS_AO); lda = DM; Wt = (const bf16_t*)(ws + WS_WO); K = DM; nitems = 16; }
    else if (WHICH == 6) { X = (const bf16_t*)(ws + WS_HB); lda = DM; Wt = (const bf16_t*)(ws + WS_WGU); K = DM; nitems = 88; }
    else if (WHICH == 7) { X = (const bf16_t*)(ws + WS_ACT); lda = DFF; Wt = (const bf16_t*)(ws + WS_WD); K = DFF; nitems = 16; }
    else if (WHICH == 9) { X = (const bf16_t*)(ws + WS_PB); lda = PLE; Wt = (const bf16_t*)(ws + WS_WPP); K = PLE; nitems = 16; }
    else { X = (const bf16_t*)(ws + WS_H2B); lda = DM; Wt = (const bf16_t*)(ws + WS_WPG); K = DM; nitems = 16; }
    X += (size_t)MP * lda;
    for (int it = bid; it < nitems; it += G) {
        const int pn = it >> 2, wc = it & 3;
        skinny_tile(X, lda, Wt, K, pn * 256 + wc * 32, pn * 256 + 128 + wc * 32, red, T);
        float x[4];
#pragma unroll
        for (int e = 0; e < 4; ++e) x[e] = T[row * 65 + c4 + e];
        if (WHICH == 1) {
            const float s1 = ((const float*)(ws + WS_SS1))[grow];
            if (pn < 2 || pn == 3) {
                float v[4], ss = 0.f;
#pragma unroll
                for (int e = 0; e < 4; ++e) { v[e] = x[e] * s1; ss += v[e] * v[e]; }
                ss = grp16_sum(ss);
                const float* nw = (pn < 2) ? p.in[14] : p.in[15]; const float rs = rsqrtf(ss * (1.f / 64.f) + EPS) * ((pn < 2) ? 0.125f * LOG2E : 1.f);
                const int d0 = 32 * bj + tt;
#pragma unroll
                for (int e = 0; e < 4; ++e) v[e] *= rs * nw[d0 + e];
                if (pn < 2) st4bf((bf16_t*)(ws + WS_Q) + grow * 512 + (pn * 4 + wc) * 64 + d0, v);
                else { const int col = (wc & 1) * 64 + d0;
                    if (wc < 2) { st4bf((bf16_t*)(ws + WS_KS) + grow * 128 + col, v); st4f(p.out + O_SSK + (size_t)row * 128 + col, v); }
                    else { st4bf((bf16_t*)(ws + WS_KW) + grow * 128 + col, v); st4f(p.out + O_SWK + ((size_t)row * 512 + 511) * 128 + col, v); } }
            } else if (pn == 2 || pn == 4) {
                float v[4];
#pragma unroll
                for (int e = 0; e < 4; ++e) v[e] = x[e] * s1;
                const int col = 32 * wc + tt;
                if (pn == 2) st4f(p.out + (bj ? O_SCV : O_SCK) + (size_t)row * 128 + col, v);
                else if (bj == 0) { st4bf((bf16_t*)(ws + WS_VS) + grow * 128 + col, v); st4f(p.out + O_SSV + (size_t)row * 128 + col, v); }
                else { st4bf((bf16_t*)(ws + WS_VW) + grow * 128 + col, v); st4f(p.out + O_SWV + ((size_t)row * 512 + 511) * 128 + col, v); }
            } else if (pn <= 8) {
                const int isk = (pn >= 7) ? 1 : 0, head = ((pn - 5) & 1) * 2 + (wc >> 1), j0 = 32 * (wc & 1) + tt;
                const float sc = s1 * (isk ? 0.08838834764831845f : 1.f);
                const float* rp = (const float*)(ws + WS_ROT) + ((size_t)2048 * 64 + j0) * 2;
                float v[4];
#pragma unroll
                for (int e = 0; e < 4; ++e) { const float x1 = T[row * 65 + tt + e] * sc, x2 = T[row * 65 + 32 + tt + e] * sc, c = rp[2 * e], sn = rp[2 * e + 1];
                    v[e] = bj ? (x1 * sn + x2 * c) : (x1 * c - x2 * sn); }
                st4bf((bf16_t*)(ws + (isk ? WS_RK : WS_RQ)) + grow * 512 + head * 128 + 64 * bj + j0, v);
            } else if (pn <= 12) {
                const int isg = pn >= 11; float v[4];
#pragma unroll
                for (int e = 0; e < 4; ++e) { const float y = x[e] * s1; v[e] = isg ? siluf_(y) : y; }
                st4bf((bf16_t*)(ws + (isg ? WS_RG : WS_RV)) + grow * 512 + ((pn - 9) & 1) * 256 + 128 * bj + 32 * wc + tt, v);
            } else {
                if (bj == 0 && tt < 24) { float v[4];
#pragma unroll
                    for (int e = 0; e < 4; ++e) v[e] = sigmoidf_(x[e] * s1);
                    st4f((float*)(ws + WS_GATE) + grow * 24 + tt, v); }
            }
        } else {
            const int col = pn * 256 + 128 * bj + 32 * wc + tt; const size_t off = grow * DM + col;
            if (WHICH == 5) { float v[4], ss = 0.f; const f32x4 xs = *(const f32x4*)(p.in[1] + (size_t)row * DM + col);
#pragma unroll
                for (int e = 0; e < 4; ++e) { v[e] = x[e] + xs[e]; ss += v[e] * v[e]; }
                st4f((float*)(ws + WS_H) + off, v); st4bf((bf16_t*)(ws + WS_HB) + off, v);
                ss = grp16_sum(ss); if ((tid & 15) == 0) atomicAdd((float*)(ws + WS_SS2) + grow, ss);
            } else if (WHICH == 6) {
                if (bj == 0) { const float s2 = rsqrtf(((const float*)(ws + WS_SS2))[grow] * (1.f / 1024.f) + EPS); float v[4];
#pragma unroll
                    for (int e = 0; e < 4; ++e) v[e] = siluf_(x[e] * s2) * (T[row * 65 + 32 + tt + e] * s2);
                    st4bf((bf16_t*)(ws + WS_ACT) + grow * DFF + pn * 128 + 32 * wc + tt, v); }
            } else if (WHICH == 7) { float v[4]; const f32x4 h = *(const f32x4*)((const float*)(ws + WS_H) + off);
#pragma unroll
                for (int e = 0; e < 4; ++e) v[e] = x[e] + h[e];
                st4f((float*)(ws + WS_H2) + off, v); st4bf((bf16_t*)(ws + WS_H2B) + off, v);
            } else if (WHICH == 9) { st4f((float*)(ws + WS_VP) + off, x);
            } else { float v[4]; const f32x4 h = *(const f32x4*)((const float*)(ws + WS_H2) + off), vp = *(const f32x4*)((const float*)(ws + WS_VP) + off);
#pragma unroll
                for (int e = 0; e < 4; ++e) v[e] = h[e] + sigmoidf_(x[e]) * vp[e];
                st4f(p.out + O_YS + (size_t)row * DM + col, v); }
        }
        __syncthreads();
    }
}

constexpr int LDS_BYTES = LDS_MAIN + 256;
constexpr int NPHASE = 9;
#ifndef REPEAT_PHASE
#define REPEAT_PHASE -1
#endif
template <int K, int REPI = 0> __device__ __forceinline__ void phase_body(const Params& p, unsigned char* lds) {
    const int tid = threadIdx.x, bid = blockIdx.x, G = gridDim.x;
    const int wv = __builtin_amdgcn_readfirstlane(tid >> 6);
    unsigned char* ws = p.ws;
    if constexpr (K == 0) phase_prologue(p, lds);
    if constexpr (K == 1) {
        pg8::Gemm g{(const bf16_t*)(ws + WS_XB), (const bf16_t*)(ws + WS_W1), MP, N1, DM};
        {   SubsetOrder S; S.init(MP, 7 * 256, G, bid); S.set = 0;
            EpiProj<0> E; E.ss1 = (const float*)(ws + WS_SS1); E.qn = p.in[14]; E.kn = p.in[15]; E.rot = (const float*)(ws + WS_ROT);
            E.Q = (bf16_t*)(ws + WS_Q); E.CA = (bf16_t*)(ws + WS_CA); E.KS = (bf16_t*)(ws + WS_KS); E.VS = (bf16_t*)(ws + WS_VS); E.KW = (bf16_t*)(ws + WS_KW); E.VW = (bf16_t*)(ws + WS_VW);
            E.RQ = (bf16_t*)(ws + WS_RQ); E.RK = (bf16_t*)(ws + WS_RK); E.RV = (bf16_t*)(ws + WS_RV); E.RG = (bf16_t*)(ws + WS_RG); E.GATE = (float*)(ws + WS_GATE); E.out = p.out;
            pg8::gemm_phase((LAS unsigned char*)lds, g, S, E); }
        {   SubsetOrder S; S.init(MP, 7 * 256, G, bid); S.set = 1;
            EpiProj<1> E; E.ss1 = (const float*)(ws + WS_SS1); E.qn = p.in[14]; E.kn = p.in[15]; E.rot = (const float*)(ws + WS_ROT);
            E.Q = (bf16_t*)(ws + WS_Q); E.CA = (bf16_t*)(ws + WS_CA); E.KS = (bf16_t*)(ws + WS_KS); E.VS = (bf16_t*)(ws + WS_VS); E.KW = (bf16_t*)(ws + WS_KW); E.VW = (bf16_t*)(ws + WS_VW);
            E.RQ = (bf16_t*)(ws + WS_RQ); E.RK = (bf16_t*)(ws + WS_RK); E.RV = (bf16_t*)(ws + WS_RV); E.RG = (bf16_t*)(ws + WS_RG); E.GATE = (float*)(ws + WS_GATE); E.out = p.out;
            pg8::gemm_phase((LAS unsigned char*)lds, g, S, E); }
        skinny_phase<1>(p, lds);
    }
    if constexpr (K == 2) {
        unsigned* qh = (unsigned*)(ws + WS_QUEUE) + 64 + 128 * REPI;
        volatile LAS unsigned* qs = (volatile LAS unsigned*)(lds + LDS_MAIN + 16);
        for (;;) {
            if (tid == 0) *qs = __hip_atomic_fetch_add(qh, 1u, __ATOMIC_RELAXED, __HIP_MEMORY_SCOPE_AGENT);
            __syncthreads();
            const int it = (int)*qs;
            __syncthreads();
            if (it >= 512 + 16) break;
            if (it < 512) { const int c = it >> 8, b = (it >> 3) & 31, sg = it & 7;
                compress_fused_unit<false>(p, lds, c, b, sg * 128, NSEG_S, NC_S, (bf16_t*)(ws + (c ? WS_CVCS : WS_CKCS))); }
            else { const int q = it - 512, c = q >> 3, b = q & 7;
                compress_fused_unit<true>(p, lds, c, b, 0, NSEG_P, NC_P, (bf16_t*)(ws + (c ? WS_CVCP : WS_CKCP))); }
        }
        for (int u = G - 1 - bid; u < NB * 4 * 16; u += G) ret_r1_unit(p, lds, u >> 6, (u >> 4) & 3, u & 15);
        for (int u = G - 1 - bid; u < DB * 4; u += G) ret_sample_unit(p, lds, u >> 2, u & 3);
    }
    if constexpr (K == 3) {
        for (int v = bid; v < 512; v += G) { const int u = v < 256 ? v : 256 + ((v - 256) ^ 15); ret_r2_unit(p, lds, u >> 6, (u >> 4) & 3, u & 15); }
        pret_job(p);
    }
    if constexpr (K == 4) {
        unsigned* qh = (unsigned*)(ws + WS_QUEUE) + 128 * REPI;
        volatile LAS unsigned* qs = (volatile LAS unsigned*)(lds + LDS_MAIN + 16);
        for (;;) {
            if (tid == 0) *qs = __hip_atomic_fetch_add(qh, 1u, __ATOMIC_RELAXED, __HIP_MEMORY_SCOPE_AGENT);
            __syncthreads();
            const unsigned it = *qs;
            __syncthreads();
            if (it >= 576u) break;
            if (it < 64u) attn_sample_unit(p, lds, (int)(it >> 1), (int)(it & 1));
            else { const int q = (int)it - 64, bg = q & 15; attn_prompt_unit(p, lds, bg >> 1, bg & 1, 31 - (q >> 4)); }
        }
    }
    if constexpr (K == 5) {
        pg8::Gemm g{(const bf16_t*)(ws + WS_AO), (const bf16_t*)(ws + WS_WO), MP, DM, DM};
        pg8::StaticOrder S; S.init(MP, DM, G, bid);
        EpiOut E; E.xp = p.in[0]; E.xs = p.in[1]; E.H = (float*)(ws + WS_H); E.HB = (bf16_t*)(ws + WS_HB); E.SS2 = (float*)(ws + WS_SS2);
        pg8::gemm_phase((LAS unsigned char*)lds, g, S, E);
        skinny_phase<5>(p, lds);
    }
    if constexpr (K == 6) {
        pg8::Gemm g{(const bf16_t*)(ws + WS_HB), (const bf16_t*)(ws + WS_WGU), MP, NGU, DM};
        pg8::StaticOrder S; S.init(MP, NGU, G, bid);
        EpiGU E; E.SS2 = (const float*)(ws + WS_SS2); E.ACT = (bf16_t*)(ws + WS_ACT);
        pg8::gemm_phase((LAS unsigned char*)lds, g, S, E);
        skinny_phase<6>(p, lds);
    }
    if constexpr (K == 7) {
        { pg8::Gemm g{(const bf16_t*)(ws + WS_ACT), (const bf16_t*)(ws + WS_WD), MP, DM, DFF};
          pg8::StaticOrder S; S.init(MP, DM, G, bid);
          EpiDown E; E.H = (const float*)(ws + WS_H); E.H2 = (float*)(ws + WS_H2); E.H2B = (bf16_t*)(ws + WS_H2B);
          pg8::gemm_phase((LAS unsigned char*)lds, g, S, E); }
        { pg8::Gemm g{(const bf16_t*)(ws + WS_PB), (const bf16_t*)(ws + WS_WPP), MP, DM, PLE};
          pg8::StaticOrder S; S.init(MP, DM, G, bid);
          EpiF32 E; E.C = (float*)(ws + WS_VP); E.ld = DM;
          pg8::gemm_phase((LAS unsigned char*)lds, g, S, E); }
        skinny_phase<7>(p, lds);
        skinny_phase<9>(p, lds);
    }
    if constexpr (K == 8) {
        pg8::Gemm g{(const bf16_t*)(ws + WS_H2B), (const bf16_t*)(ws + WS_WPG), MP, DM, DM};
        pg8::StaticOrder S; S.init(MP, DM, G, bid);
        EpiFinal E; E.H2 = (const float*)(ws + WS_H2); E.VP = (const float*)(ws + WS_VP); E.out = p.out;
        pg8::gemm_phase((LAS unsigned char*)lds, g, S, E);
        skinny_phase<8>(p, lds);
    }
}
__global__ void __launch_bounds__(512, 2) nsa_ret_fwd(Params p) {
    extern __shared__ __attribute__((aligned(16))) unsigned char lds[];
    const int tid = threadIdx.x;
    unsigned char* ws = p.ws;
    if (tid < 4) ((LAS unsigned*)(lds + LDS_MAIN))[tid] = 0u;
    __syncthreads();
    const bool fused = (p.ph_hi - p.ph_lo) > 1;
    XcdBarrier bar; bar.bar = (unsigned*)(ws + WS_CTL); bar.x = 0; bar.st = (volatile LAS unsigned*)(lds + LDS_MAIN);
    if (fused) bar = xcd_barrier_post((unsigned*)(ws + WS_CTL), (volatile LAS unsigned*)(lds + LDS_MAIN));
#ifdef ONLY_PHASE
#define PH_ON(k) ((k) == ONLY_PHASE && p.ph_lo <= (k) && (k) < p.ph_hi)
#else
#define PH_ON(k) (p.ph_lo <= (k) && (k) < p.ph_hi)
#endif
#define SEAM(k) do { if (PH_ON(k) && PH_ON((k) + 1)) xcd_barrier(bar); } while (0)
#define PHASE(k) do { if (PH_ON(k)) { phase_body<k>(p, lds); if (REPEAT_PHASE == (k)) { __syncthreads(); phase_body<k, 1>(p, lds); } } } while (0)
    PHASE(0); SEAM(0);
    PHASE(1); SEAM(1);
    PHASE(2); SEAM(2);
    PHASE(3); SEAM(3);
    PHASE(4); SEAM(4);
    PHASE(5); SEAM(5);
    PHASE(6); SEAM(6);
    PHASE(7); SEAM(7);
    PHASE(8);
}

extern "C" void kernel_launch(void* const* d_in, const int* in_sizes, int n_in, void* d_out, int out_size, void* d_ws, size_t ws_size, hipStream_t stream) {
    static int grid = 0;
    if (grid == 0) {
        if (n_in != 31 || (size_t)out_size != O_END || ws_size < WS_END) { fprintf(stderr, "kernel_launch: unexpected shapes: n_in %d out %d ws %zu (need %zu)\n", n_in, out_size, ws_size, (size_t)WS_END); grid = -1; return; }
        int dev = 0, cus = 0;
        if (hipGetDevice(&dev) != hipSuccess || hipDeviceGetAttribute(&cus, hipDeviceAttributeMultiprocessorCount, dev) != hipSuccess) { grid = -1; return; }
        if (hipFuncSetAttribute((const void*)nsa_ret_fwd, hipFuncAttributeMaxDynamicSharedMemorySize, LDS_BYTES) != hipSuccess) { fprintf(stderr, "kernel_launch: hipFuncSetAttribute failed\n"); grid = -1; return; }
        int per_cu = 0;
        if (hipOccupancyMaxActiveBlocksPerMultiprocessor(&per_cu, (const void*)nsa_ret_fwd, 512, LDS_BYTES) != hipSuccess || per_cu < 1) { fprintf(stderr, "kernel_launch: occupancy query says %d blocks per CU\n", per_cu); }
        (void)hipGetLastError();
        grid = cus;
    }
    if (grid < 0) return;
    (void)hipMemsetAsync((char*)d_ws + WS_CTL, 0, CTL_BYTES, stream);
    Params p; memset(&p, 0, sizeof(p));
    for (int i = 0; i < 31; ++i) p.in[i] = (const float*)d_in[i];
    p.page_table = (const int*)d_in[9]; p.out = (float*)d_out; p.ws = (unsigned char*)d_ws;
#if MK_PER_PHASE_LAUNCH
    for (int ph = 0; ph < NPHASE; ++ph) { p.ph_lo = ph; p.ph_hi = ph + 1; hipLaunchKernelGGL(nsa_ret_fwd, dim3(grid), dim3(512), LDS_BYTES, stream, p); }
#else
    p.ph_lo = 0; p.ph_hi = NPHASE; hipLaunchKernelGGL(nsa_ret_fwd, dim3(grid), dim3(512), LDS_BYTES, stream, p);
#endif
}
```
